# Optimizing an MI355X kernel written in HIP

```python
import math
import jax, jax.numpy as jnp
from jax import lax
import numpy as np

D_MODEL = 1024
BATCH = 8
SEQ = 4096
DEPTH = 1

N_ATTN_HEADS = 4
ATTN_HEAD_DIM = 64
ATTN_V_DIM = 2 * ATTN_HEAD_DIM
ATTN_WIDTH = N_ATTN_HEADS * ATTN_V_DIM
ROPE_THETA = 500000.0
ROPE_DIM = ATTN_HEAD_DIM // 4
Q_BLOCK = 128
SSM_WIDTH = D_MODEL // 2
SSM_GROUP = 16
SSM_GROUPS = SSM_WIDTH // SSM_GROUP
SSM_STATE = 64
DT_MIN = 1e-3
DT_MAX = 1e-1
N_BRANCH = 2
Q_COLS = N_ATTN_HEADS * 2 * ATTN_HEAD_DIM
K_COLS = N_ATTN_HEADS * 2 * ATTN_HEAD_DIM
V_COLS = ATTN_WIDTH
U_COLS = SSM_WIDTH
G_COLS = N_BRANCH * D_MODEL
IN_COLS = Q_COLS + K_COLS + V_COLS + U_COLS + G_COLS
N_EXPERT_GROUPS = 4
EXPERTS_PER_GROUP = 8
TOP_K = 2
D_EXPERT = D_MODEL // 4
EPS = 1e-6

kernel_name = "hybrid_diffattn_s5_hiermoe"


def rms_norm(x, g):
    xf = x.astype(jnp.float32)
    y = xf * lax.rsqrt(jnp.mean(xf * xf, axis=-1, keepdims=True) + EPS)
    return (y * g.astype(jnp.float32)).astype(x.dtype)


def rope_partial(t, positions):
    half = ROPE_DIM // 2
    inv = ROPE_THETA ** (-jnp.arange(0, ROPE_DIM, 2, dtype=jnp.float32) / ROPE_DIM)
    ang = positions.astype(jnp.float32)[..., None] * inv
    cos = jnp.cos(ang)[:, :, None, None, :]
    sin = jnp.sin(ang)[:, :, None, None, :]
    tf = t.astype(jnp.float32)
    r1, r2, rest = tf[..., :half], tf[..., half:ROPE_DIM], tf[..., ROPE_DIM:]
    out = jnp.concatenate([r1 * cos - r2 * sin, r2 * cos + r1 * sin, rest], axis=-1)
    return out.astype(t.dtype)


def diff_attention(q, k, v, lam):
    b, h, _, s, dh = q.shape
    dv = v.shape[-1]
    nb = s // Q_BLOCK
    qb = q.reshape(b, h, 2, nb, Q_BLOCK, dh).transpose(3, 0, 1, 2, 4, 5)
    kpos = jnp.arange(s)
    scale = dh ** -0.5
    neg = jnp.finfo(jnp.float32).min

    def block(args):
        qi, i = args
        sc = jnp.einsum('bhcqd,bhckd->bhcqk', qi, k).astype(jnp.float32) * scale
        qpos = i * Q_BLOCK + jnp.arange(Q_BLOCK)
        mask = kpos[None, :] <= qpos[:, None]
        p = jax.nn.softmax(jnp.where(mask, sc, neg), axis=-1)
        w = p[:, :, 0] - lam * p[:, :, 1]
        return jnp.einsum('bhqk,bhkd->bhqd', w.astype(v.dtype), v)

    out = lax.map(block, (qb, jnp.arange(nb)))
    return out.transpose(1, 2, 0, 3, 4).reshape(b, h, s, dv)


def s5_grouped(u, lam_re, lam_im, log_dt, b_re, b_im, c_re, c_im, d_skip):
    bsz, s, _ = u.shape
    uf = u.astype(jnp.float32).reshape(bsz, s, SSM_GROUPS, SSM_GROUP)
    lam = lax.complex(lam_re.astype(jnp.float32), lam_im.astype(jnp.float32))
    dt = jnp.exp(log_dt.astype(jnp.float32))[:, None]
    lam_bar = jnp.exp(lam * dt)
    bmat = lax.complex(b_re.astype(jnp.float32), b_im.astype(jnp.float32))
    b_bar = ((lam_bar - 1.0) / lam)[..., None] * bmat
    bu = jnp.einsum('gph,bsgh->bsgp', b_bar, uf.astype(jnp.complex64))
    a = jnp.broadcast_to(lam_bar, (1, s) + lam_bar.shape)

    def combine(e1, e2):
        a1, b1 = e1
        a2, b2 = e2
        return a1 * a2, a2 * b1 + b2

    _, states = lax.associative_scan(combine, (a, bu), axis=1)
    cmat = lax.complex(c_re.astype(jnp.float32), c_im.astype(jnp.float32))
    y = jnp.einsum('ghp,bsgp->bsgh', cmat, states).real
    y = y + d_skip.astype(jnp.float32).reshape(SSM_GROUPS, SSM_GROUP) * uf
    return y.reshape(bsz, s, SSM_WIDTH).astype(u.dtype)


def hier_moe(h, w_rg, b_rg, w_re, b_re, w_gate, w_up, w_down):
    bsz, s, d = h.shape
    t = h.reshape(-1, d)
    g_prob = jax.nn.softmax((t @ w_rg).astype(jnp.float32) + b_rg.astype(jnp.float32), axis=-1)
    grp = jnp.argmax(g_prob, axis=-1)
    p_grp = jnp.max(g_prob, axis=-1)
    grp_oh = jax.nn.one_hot(grp, N_EXPERT_GROUPS, dtype=jnp.float32)
    e_logits = jnp.einsum('td,dge->tge', t, w_re).astype(jnp.float32) + b_re.astype(jnp.float32)
    e_sel = jnp.einsum('tge,tg->te', e_logits, grp_oh)
    top_v, top_i = lax.top_k(e_sel, TOP_K)
    top_w = jax.nn.softmax(top_v, axis=-1) * p_grp[:, None]
    expert_w = jnp.sum(jax.nn.one_hot(top_i, EXPERTS_PER_GROUP, dtype=jnp.float32) * top_w[..., None], axis=1)
    comb = (grp_oh[:, :, None] * expert_w[:, None, :]).astype(h.dtype)
    out = jnp.zeros((t.shape[0], d), jnp.float32)
    for gi in range(N_EXPERT_GROUPS):
        hg = jax.nn.silu(jnp.einsum('td,edf->tef', t, w_gate[gi])) * jnp.einsum('td,edf->tef', t, w_up[gi])
        hg = hg * comb[:, gi, :, None]
        out = out + jnp.einsum('tef,efd->td', hg, w_down[gi]).astype(jnp.float32)
    return out.reshape(bsz, s, d).astype(h.dtype)


def setup_inputs(seed: int = 0) -> dict:
    key = jax.random.key(seed)
    ks = jax.random.split(key, 32)
    f32 = jnp.float32
    L = DEPTH
    nrm = lambda k, shp, sc: jax.random.normal(k, shp, f32) * sc
    x = jax.random.normal(ks[0], (BATCH, SEQ, D_MODEL), f32)
    offset = jax.random.randint(ks[1], (BATCH, 1), 0, 1024, dtype=jnp.int32)
    positions = (offset + jnp.arange(SEQ, dtype=jnp.int32)[None, :]).astype(jnp.int32)
    return {
        "x": x,
        "positions": positions,
        "norm_mix_g": 1.0 + nrm(ks[2], (L, D_MODEL), 0.02),
        "w_in": nrm(ks[3], (L, D_MODEL, IN_COLS), D_MODEL ** -0.5),
        "q_norm_g": 1.0 + nrm(ks[4], (L, ATTN_HEAD_DIM), 0.02),
        "k_norm_g": 1.0 + nrm(ks[5], (L, ATTN_HEAD_DIM), 0.02),
        "lambda_q1": nrm(ks[6], (L, ATTN_HEAD_DIM), 0.1),
        "lambda_k1": nrm(ks[7], (L, ATTN_HEAD_DIM), 0.1),
        "lambda_q2": nrm(ks[8], (L, ATTN_HEAD_DIM), 0.1),
        "lambda_k2": nrm(ks[9], (L, ATTN_HEAD_DIM), 0.1),
        "subln_g": 1.0 + nrm(ks[10], (L, ATTN_V_DIM), 0.02),
        "w_o_attn": nrm(ks[11], (L, ATTN_WIDTH, D_MODEL), ATTN_WIDTH ** -0.5),
        "ssm_lambda_re": -0.5 + nrm(ks[12], (L, SSM_GROUPS, SSM_STATE), 0.01),
        "ssm_lambda_im": math.pi * jnp.arange(SSM_STATE, dtype=f32)[None, None, :] + nrm(ks[13], (L, SSM_GROUPS, SSM_STATE), 0.01),
        "ssm_log_dt": jax.random.uniform(ks[14], (L, SSM_GROUPS), f32, math.log(DT_MIN), math.log(DT_MAX)),
        "ssm_b_re": nrm(ks[15], (L, SSM_GROUPS, SSM_STATE, SSM_GROUP), (2 * SSM_GROUP) ** -0.5),
        "ssm_b_im": nrm(ks[16], (L, SSM_GROUPS, SSM_STATE, SSM_GROUP), (2 * SSM_GROUP) ** -0.5),
        "ssm_c_re": nrm(ks[17], (L, SSM_GROUPS, SSM_GROUP, SSM_STATE), SSM_STATE ** -0.5),
        "ssm_c_im": nrm(ks[18], (L, SSM_GROUPS, SSM_GROUP, SSM_STATE), SSM_STATE ** -0.5),
        "ssm_d": nrm(ks[19], (L, SSM_WIDTH), 1.0),
        "w_glu": nrm(ks[20], (L, SSM_WIDTH, 2 * D_MODEL), SSM_WIDTH ** -0.5),
        "w_out": nrm(ks[21], (L, D_MODEL, D_MODEL), D_MODEL ** -0.5),
        "norm_ffn_g": 1.0 + nrm(ks[22], (L, D_MODEL), 0.02),
        "w_router_group": nrm(ks[23], (L, D_MODEL, N_EXPERT_GROUPS), D_MODEL ** -0.5),
        "b_router_group": nrm(ks[24], (L, N_EXPERT_GROUPS), 0.01),
        "w_router_expert": nrm(ks[25], (L, D_MODEL, N_EXPERT_GROUPS, EXPERTS_PER_GROUP), D_MODEL ** -0.5),
        "b_router_expert": nrm(ks[26], (L, N_EXPERT_GROUPS, EXPERTS_PER_GROUP), 0.01),
        "w_expert_gate": nrm(ks[27], (L, N_EXPERT_GROUPS, EXPERTS_PER_GROUP, D_MODEL, D_EXPERT), D_MODEL ** -0.5),
        "w_expert_up": nrm(ks[28], (L, N_EXPERT_GROUPS, EXPERTS_PER_GROUP, D_MODEL, D_EXPERT), D_MODEL ** -0.5),
        "w_expert_down": nrm(ks[29], (L, N_EXPERT_GROUPS, EXPERTS_PER_GROUP, D_EXPERT, D_MODEL), D_EXPERT ** -0.5),
    }


def reference(x, positions, norm_mix_g, w_in, q_norm_g, k_norm_g, lambda_q1, lambda_k1,
              lambda_q2, lambda_k2, subln_g, w_o_attn, ssm_lambda_re, ssm_lambda_im,
              ssm_log_dt, ssm_b_re, ssm_b_im, ssm_c_re, ssm_c_im, ssm_d, w_glu, w_out,
              norm_ffn_g, w_router_group, b_router_group, w_router_expert, b_router_expert,
              w_expert_gate, w_expert_up, w_expert_down):
    bsz, s, _ = x.shape
    splits = [Q_COLS, Q_COLS + K_COLS, Q_COLS + K_COLS + V_COLS, Q_COLS + K_COLS + V_COLS + U_COLS]
    for l in range(DEPTH):
        lam_init = 0.8 - 0.6 * math.exp(-0.3 * l)
        h = rms_norm(x, norm_mix_g[l])
        proj = h @ w_in[l]
        q, k, v, u, gates = jnp.split(proj, splits, axis=-1)

        q = q.reshape(bsz, s, N_ATTN_HEADS, 2, ATTN_HEAD_DIM)
        k = k.reshape(bsz, s, N_ATTN_HEADS, 2, ATTN_HEAD_DIM)
        q = rope_partial(rms_norm(q, q_norm_g[l]), positions).transpose(0, 2, 3, 1, 4)
        k = rope_partial(rms_norm(k, k_norm_g[l]), positions).transpose(0, 2, 3, 1, 4)
        v = v.reshape(bsz, s, N_ATTN_HEADS, ATTN_V_DIM).transpose(0, 2, 1, 3)
        lam = (jnp.exp(jnp.sum(lambda_q1[l].astype(jnp.float32) * lambda_k1[l].astype(jnp.float32)))
               - jnp.exp(jnp.sum(lambda_q2[l].astype(jnp.float32) * lambda_k2[l].astype(jnp.float32)))
               + lam_init)
        o = diff_attention(q, k, v, lam)
        o = rms_norm(o, subln_g[l]) * (1.0 - lam_init)
        o_a = o.transpose(0, 2, 1, 3).reshape(bsz, s, ATTN_WIDTH) @ w_o_attn[l]

        y = s5_grouped(u, ssm_lambda_re[l], ssm_lambda_im[l], ssm_log_dt[l], ssm_b_re[l],
                       ssm_b_im[l], ssm_c_re[l], ssm_c_im[l], ssm_d[l])
        z = jax.nn.gelu(y) @ w_glu[l]
        o_s = z[..., :D_MODEL] * jax.nn.sigmoid(z[..., D_MODEL:])

        g = jax.nn.sigmoid(gates.astype(jnp.float32)).reshape(bsz, s, N_BRANCH, D_MODEL)
        merged = g[..., 0, :] * o_a.astype(jnp.float32) + g[..., 1, :] * o_s.astype(jnp.float32)
        x = x + merged.astype(x.dtype) @ w_out[l]

        x = x + hier_moe(rms_norm(x, norm_ffn_g[l]), w_router_group[l], b_router_group[l],
                         w_router_expert[l], b_router_expert[l], w_expert_gate[l],
                         w_expert_up[l], w_expert_down[l])
    return x
```

```cpp
#include <hip/hip_runtime.h>
#include <hip/hip_bf16.h>
#include <cstdio>
#include <cstdint>
#include <cmath>

constexpr int DM = 1024, BATCH = 8, SEQ = 4096, T = BATCH * SEQ;
constexpr int IN_COLS = 4096;
constexpr float EPS = 1e-6f, ROPE_THETA = 500000.0f, LAM_INIT = 0.2f;
constexpr float QSCALE = 0.125f * 1.4426950408889634f;
typedef unsigned short bf16_t;
__device__ __forceinline__ float bf2f(bf16_t v) { return __uint_as_float(((unsigned)v) << 16); }
__device__ __forceinline__ bf16_t f2bf(float f) { unsigned u = __float_as_uint(f); return (bf16_t)((u + 0x7fffu + ((u >> 16) & 1u)) >> 16); }

constexpr size_t MiB = 1u << 20;
constexpr size_t WS_CTL = 0, CTL_ZERO_BYTES = 1 * MiB;
constexpr size_t WS_SCAL = 1 * MiB, WS_ROPE = 2 * MiB, WS_WIN = 4 * MiB, WS_WO = 12 * MiB, WS_WGLU = 13 * MiB, WS_WOUT = 15 * MiB, WS_WGU = 17 * MiB, WS_WD = 49 * MiB,
                 WS_WR = 65 * MiB, WS_SSMF = 66 * MiB, WS_SSMG = 68 * MiB, WS_SSMH = 76 * MiB, WS_SSMA = 84 * MiB, WS_RINFO = 85 * MiB, WS_LISTS = 86 * MiB;
constexpr size_t WS_XN = 96 * MiB, WS_Q = 160 * MiB, WS_K = 192 * MiB, WS_V = 224 * MiB, WS_U = 256 * MiB, WS_G = 288 * MiB, WS_OA = 416 * MiB, WS_Y2 = 448 * MiB, WS_END = 480 * MiB;
constexpr size_t WS_OB = WS_XN, WS_X1B = WS_XN, WS_MA = WS_Q, WS_MG = WS_V, WS_HB = WS_G;
namespace nv {
__device__ __forceinline__ float wsum(float v) {
#pragma unroll
    for (int o = 1; o < 64; o <<= 1) v += __shfl_xor(v, o);
    return v;
}
__device__ __forceinline__ float wmax(float v) {
#pragma unroll
    for (int o = 1; o < 64; o <<= 1) v = fmaxf(v, __shfl_xor(v, o));
    return v;
}
__global__ void __launch_bounds__(256) k_xn(const float* __restrict__ x, const float* __restrict__ g, bf16_t* __restrict__ XN) {
    const int row = blockIdx.x * 4 + (threadIdx.x >> 6), lane = threadIdx.x & 63;
    const float* xr = x + (size_t)row * DM; float v[16]; float s = 0.f;
#pragma unroll
    for (int j = 0; j < 16; ++j) { v[j] = xr[lane + 64 * j]; s += v[j] * v[j]; }
    const float r = rsqrtf(wsum(s) * (1.f / DM) + EPS);
#pragma unroll
    for (int j = 0; j < 16; ++j) XN[(size_t)row * DM + lane + 64 * j] = f2bf(v[j] * r * g[lane + 64 * j]);
}
__global__ void __launch_bounds__(256) k_gemm(const bf16_t* __restrict__ A, int lda, const float* __restrict__ B, int ldb, float* __restrict__ C, int ldc, int K) {
    __shared__ float sA[16][65]; __shared__ float sB[16][65];
    const int tid = threadIdx.x, tx = tid & 15, ty = tid >> 4; const int m0 = blockIdx.y * 64, n0 = blockIdx.x * 64;
    float acc[4][4];
#pragma unroll
    for (int i = 0; i < 4; ++i)
#pragma unroll
        for (int j = 0; j < 4; ++j) acc[i][j] = 0.f;
    for (int k0 = 0; k0 < K; k0 += 16) {
#pragma unroll
        for (int e = 0; e < 4; ++e) { const int idx = tid + 256 * e; const int r = idx >> 4, c = idx & 15; sA[c][r] = bf2f(A[(size_t)(m0 + r) * lda + k0 + c]); }
#pragma unroll
        for (int e = 0; e < 4; ++e) { const int idx = tid + 256 * e; const int r = idx >> 6, c = idx & 63; sB[r][c] = B[(size_t)(k0 + r) * ldb + n0 + c]; }
        __syncthreads();
#pragma unroll
        for (int k = 0; k < 16; ++k) { float a[4], b[4];
#pragma unroll
            for (int i = 0; i < 4; ++i) { a[i] = sA[k][ty * 4 + i]; b[i] = sB[k][tx * 4 + i]; }
#pragma unroll
            for (int i = 0; i < 4; ++i)
#pragma unroll
                for (int j = 0; j < 4; ++j) acc[i][j] += a[i] * b[j]; }
        __syncthreads();
    }
#pragma unroll
    for (int i = 0; i < 4; ++i)
#pragma unroll
        for (int j = 0; j < 4; ++j) C[(size_t)(m0 + ty * 4 + i) * ldc + n0 + tx * 4 + j] = acc[i][j];
}
__global__ void __launch_bounds__(256) k_post_in(const float* __restrict__ tmp, int jb, const int* __restrict__ pos, const float* __restrict__ qg, const float* __restrict__ kg,
                                                 bf16_t* Qb, bf16_t* Kb, bf16_t* Vb, bf16_t* Ub, bf16_t* Gb) {
    const int row = blockIdx.x * 4 + (threadIdx.x >> 6), lane = threadIdx.x & 63;
    const float* tr = tmp + (size_t)row * 512;
    if (jb <= 1) {
        const float* g = jb == 0 ? qg : kg; bf16_t* O = jb == 0 ? Qb : Kb; const float sc = jb == 0 ? QSCALE : 1.f;
        const float p = (float)pos[row];
        for (int grp = 0; grp < 8; ++grp) {
            float v = tr[grp * 64 + lane]; const float r = rsqrtf(wsum(v * v) * (1.f / 64.f) + EPS); v = v * r * g[lane];
            const float other = __shfl_xor(v, 8);
            if (lane < 16) { const int i = lane & 7; const double ang = (double)p * pow((double)ROPE_THETA, -(double)(2 * i) / 16.0); const float c = (float)cos(ang), s = (float)sin(ang);
                v = lane < 8 ? v * c - other * s : v * c + other * s; }
            O[(size_t)row * 512 + grp * 64 + lane] = f2bf(v * sc);
        }
    } else if (jb <= 3) { bf16_t* O = jb == 2 ? Vb : Ub;
#pragma unroll
        for (int j = 0; j < 8; ++j) O[(size_t)row * 512 + lane + 64 * j] = f2bf(tr[lane + 64 * j]);
    } else {
#pragma unroll
        for (int j = 0; j < 8; ++j) { const float v = tr[lane + 64 * j]; Gb[(size_t)row * 2048 + (jb - 4) * 512 + lane + 64 * j] = f2bf(1.f / (1.f + expf(-v))); }
    }
}
__global__ void k_lam(const float* q1, const float* k1, const float* q2, const float* k2, float* scal) {
    const int lane = threadIdx.x; const float a = wsum(q1[lane] * k1[lane]), b = wsum(q2[lane] * k2[lane]);
    if (lane == 0) scal[0] = expf(a) - expf(b) + LAM_INIT;
}
__global__ void __launch_bounds__(256) k_attn(const bf16_t* __restrict__ Qb, const bf16_t* __restrict__ Kb, const bf16_t* __restrict__ Vb, const float* __restrict__ scal, const float* __restrict__ sg, bf16_t* __restrict__ OAb) {
    __shared__ float sq[4][128];
    const int w = threadIdx.x >> 6, lane = threadIdx.x & 63; const int item = blockIdx.x * 4 + w; const int h = item & 3, row = item >> 2; const int b = row / SEQ, qpos = row % SEQ;
    const float lam = scal[0];
    sq[w][lane] = bf2f(Qb[(size_t)row * 512 + h * 128 + lane]); sq[w][64 + lane] = bf2f(Qb[(size_t)row * 512 + h * 128 + 64 + lane]);
    __syncthreads();
    const bf16_t* Kh = Kb + (size_t)b * SEQ * 512 + h * 128; const bf16_t* Vh = Vb + (size_t)b * SEQ * 512 + h * 128;
    float m0 = -INFINITY, l0 = 0.f, m1 = -INFINITY, l1 = 0.f;
    for (int k = lane; k <= qpos; k += 64) { const bf16_t* kr = Kh + (size_t)k * 512; float s0 = 0.f, s1 = 0.f;
        for (int d = 0; d < 64; ++d) { s0 += sq[w][d] * bf2f(kr[d]); s1 += sq[w][64 + d] * bf2f(kr[64 + d]); }
        float mn = fmaxf(m0, s0); l0 = l0 * exp2f(m0 - mn) + exp2f(s0 - mn); m0 = mn;
        mn = fmaxf(m1, s1); l1 = l1 * exp2f(m1 - mn) + exp2f(s1 - mn); m1 = mn; }
    const float M0 = wmax(m0), M1 = wmax(m1);
    const float L0 = wsum(m0 == -INFINITY ? 0.f : l0 * exp2f(m0 - M0)), L1 = wsum(m1 == -INFINITY ? 0.f : l1 * exp2f(m1 - M1));
    float o[128];
#pragma unroll
    for (int d = 0; d < 128; ++d) o[d] = 0.f;
    for (int k = lane; k <= qpos; k += 64) { const bf16_t* kr = Kh + (size_t)k * 512; float s0 = 0.f, s1 = 0.f;
        for (int d = 0; d < 64; ++d) { s0 += sq[w][d] * bf2f(kr[d]); s1 += sq[w][64 + d] * bf2f(kr[64 + d]); }
        const float wgt = exp2f(s0 - M0) / L0 - lam * exp2f(s1 - M1) / L1; const bf16_t* vr = Vh + (size_t)k * 512;
#pragma unroll
        for (int d = 0; d < 128; ++d) o[d] += wgt * bf2f(vr[d]); }
    float ss = 0.f;
#pragma unroll
    for (int d = 0; d < 128; ++d) { o[d] = wsum(o[d]); ss += o[d] * o[d]; }
    const float r = rsqrtf(ss * (1.f / 128.f) + EPS) * (1.f - LAM_INIT);
#pragma unroll
    for (int d = 0; d < 128; ++d) if (lane == (d & 63)) OAb[(size_t)row * 512 + h * 128 + d] = f2bf(o[d] * r * sg[d]);
}
__device__ __forceinline__ float gelu_tanh(float x) { const float u = 0.7978845608028654f * (x + 0.044715f * x * x * x); return 0.5f * x * (1.f + tanhf(u)); }
__global__ void __launch_bounds__(64) k_ssm(const bf16_t* __restrict__ Ub, const float* lre, const float* lim, const float* ldt, const float* bre, const float* bim, const float* cre, const float* cim, const float* dsk, bf16_t* __restrict__ Y2b) {
    const int b = blockIdx.x >> 5, g = blockIdx.x & 31, p = threadIdx.x;
    const float dt = expf(ldt[g]); const float lr = lre[g * 64 + p], li = lim[g * 64 + p];
    const float mag = expf(lr * dt); const float ar = mag * cosf(li * dt), ai = mag * sinf(li * dt);
    const float nr = ar - 1.f, ni = ai, den = lr * lr + li * li; const float fr = (nr * lr + ni * li) / den, fi = (ni * lr - nr * li) / den;
    float Br[16], Bi[16], Cr[16], Ci[16], Dk[16];
#pragma unroll
    for (int h = 0; h < 16; ++h) { const float x = bre[(g * 64 + p) * 16 + h], y = bim[(g * 64 + p) * 16 + h]; Br[h] = fr * x - fi * y; Bi[h] = fr * y + fi * x;
        Cr[h] = cre[(g * 16 + h) * 64 + p]; Ci[h] = cim[(g * 16 + h) * 64 + p]; Dk[h] = dsk[g * 16 + h]; }
    float sr = 0.f, si = 0.f;
    for (int t = 0; t < SEQ; ++t) { const size_t ro = ((size_t)b * SEQ + t) * 512 + g * 16; float u[16]; float xr = 0.f, xi = 0.f;
#pragma unroll
        for (int h = 0; h < 16; ++h) { u[h] = bf2f(Ub[ro + h]); xr += Br[h] * u[h]; xi += Bi[h] * u[h]; }
        const float nsr = ar * sr - ai * si + xr, nsi = ar * si + ai * sr + xi; sr = nsr; si = nsi;
#pragma unroll
        for (int h = 0; h < 16; ++h) { const float y = wsum(Cr[h] * sr - Ci[h] * si) + Dk[h] * u[h]; if (p == h) Y2b[ro + h] = f2bf(gelu_tanh(y)); }
    }
}
__global__ void __launch_bounds__(256) k_post_oa(const float* __restrict__ tmp, int ncol, int c0, const bf16_t* __restrict__ Gb, bf16_t* __restrict__ MAb) {
    const size_t i = (size_t)blockIdx.x * 256 + threadIdx.x; const size_t row = i / ncol; const int c = (int)(i % ncol);
    MAb[row * DM + c0 + c] = f2bf(bf2f(Gb[row * 2048 + c0 + c]) * tmp[i]);
}
__global__ void __launch_bounds__(256) k_post_glu(const float* __restrict__ z1, const float* __restrict__ z2, int ncol, int c0, const bf16_t* __restrict__ Gb, const bf16_t* __restrict__ MAb, bf16_t* __restrict__ MGb) {
    const size_t i = (size_t)blockIdx.x * 256 + threadIdx.x; const size_t row = i / ncol; const int c = (int)(i % ncol);
    const float os = z1[i] / (1.f + expf(-z2[i]));
    MGb[row * DM + c0 + c] = f2bf(bf2f(MAb[row * DM + c0 + c]) + bf2f(Gb[row * 2048 + 1024 + c0 + c]) * os);
}
__global__ void __launch_bounds__(256) k_post_out(const float* __restrict__ tmp, int ncol, int c0, const float* __restrict__ x, float* __restrict__ out, bf16_t* __restrict__ X1b) {
    const size_t i = (size_t)blockIdx.x * 256 + threadIdx.x; const size_t row = i / ncol; const int c = (int)(i % ncol);
    const float v = x[row * DM + c0 + c] + tmp[i]; out[row * DM + c0 + c] = v; X1b[row * DM + c0 + c] = f2bf(v);
}
__global__ void __launch_bounds__(256) k_router(const float* __restrict__ x1, const float* __restrict__ g, const float* __restrict__ wrg, const float* __restrict__ brg, const float* __restrict__ wre, const float* __restrict__ bre,
                                                int4* __restrict__ rinfo, float* __restrict__ rstd) {
    const int row = blockIdx.x * 4 + (threadIdx.x >> 6), lane = threadIdx.x & 63; const float* xr = x1 + (size_t)row * DM;
    float v[16]; float s = 0.f;
#pragma unroll
    for (int j = 0; j < 16; ++j) { v[j] = xr[lane + 64 * j]; s += v[j] * v[j]; }
    const float r = rsqrtf(wsum(s) * (1.f / DM) + EPS);
#pragma unroll
    for (int j = 0; j < 16; ++j) v[j] = v[j] * r * g[lane + 64 * j];
    float lg[4];
#pragma unroll
    for (int c = 0; c < 4; ++c) { float a = 0.f;
#pragma unroll
        for (int j = 0; j < 16; ++j) a += v[j] * wrg[(lane + 64 * j) * 4 + c];
        lg[c] = wsum(a) + brg[c]; }
    int grp = 0; float mx = lg[0];
#pragma unroll
    for (int c = 1; c < 4; ++c) if (lg[c] > mx) { mx = lg[c]; grp = c; }
    float den = 0.f;
#pragma unroll
    for (int c = 0; c < 4; ++c) den += expf(lg[c] - mx);
    const float pg = 1.f / den;
    float el[8];
#pragma unroll
    for (int e = 0; e < 8; ++e) { float a = 0.f;
#pragma unroll
        for (int j = 0; j < 16; ++j) a += v[j] * wre[(lane + 64 * j) * 32 + grp * 8 + e];
        el[e] = wsum(a) + bre[grp * 8 + e]; }
    int i1 = 0; float v1 = el[0];
#pragma unroll
    for (int e = 1; e < 8; ++e) if (el[e] > v1) { v1 = el[e]; i1 = e; }
    int i2 = -1; float v2 = -INFINITY;
#pragma unroll
    for (int e = 0; e < 8; ++e) if (e != i1 && el[e] > v2) { v2 = el[e]; i2 = e; }
    const float e2 = expf(v2 - v1); const float w1 = pg / (1.f + e2), w2 = pg * e2 / (1.f + e2);
    if (lane == 0) { rinfo[row] = make_int4(grp * 8 + i1, grp * 8 + i2, __float_as_int(w1), __float_as_int(w2)); rstd[row] = r; }
}
__global__ void __launch_bounds__(256) k_moe(float* __restrict__ out, const float* __restrict__ g, const int4* __restrict__ rinfo, const float* __restrict__ rstd,
                                             const float* __restrict__ Wg, const float* __restrict__ Wu, const float* __restrict__ Wd) {
    __shared__ float st[DM]; __shared__ float sh[256];
    const int row = blockIdx.x, tid = threadIdx.x; float* orow = out + (size_t)row * DM; const float r = rstd[row];
    float x1v[4];
#pragma unroll
    for (int j = 0; j < 4; ++j) { x1v[j] = orow[tid + 256 * j]; st[tid + 256 * j] = x1v[j] * r * g[tid + 256 * j]; }
    __syncthreads();
    const int4 ri = rinfo[row]; float acc[4] = {0.f, 0.f, 0.f, 0.f};
    for (int s = 0; s < 2; ++s) { const int e = s == 0 ? ri.x : ri.y; const float w = __int_as_float(s == 0 ? ri.z : ri.w);
        const float* wg = Wg + (size_t)e * DM * 256 + tid; const float* wu = Wu + (size_t)e * DM * 256 + tid; float a = 0.f, u = 0.f;
        for (int d = 0; d < DM; ++d) { a += st[d] * wg[(size_t)d * 256]; u += st[d] * wu[(size_t)d * 256]; }
        sh[tid] = a / (1.f + expf(-a)) * u * w;
        __syncthreads();
        const float* wd = Wd + (size_t)e * 256 * DM;
        for (int f = 0; f < 256; ++f) { const float hv = sh[f];
#pragma unroll
            for (int j = 0; j < 4; ++j) acc[j] += hv * wd[(size_t)f * DM + tid + 256 * j]; }
        __syncthreads();
    }
#pragma unroll
    for (int j = 0; j < 4; ++j) orow[tid + 256 * j] = x1v[j] + acc[j];
}
}
extern "C" void kernel_launch(void* const* d_in, const int* in_sizes, int n_in, void* d_out, int out_size, void* d_ws, size_t ws_size, hipStream_t stream) {
    if (n_in != 30 || out_size != T * DM || ws_size < WS_END) { fprintf(stderr, "kernel_launch: unexpected shapes n_in %d out %d ws %zu\n", n_in, out_size, ws_size); return; }
    const float* x = (const float*)d_in[0]; const int* pos = (const int*)d_in[1];
#define FIN(i) ((const float*)d_in[i])
    unsigned char* ws = (unsigned char*)d_ws; float* out = (float*)d_out;
    bf16_t *XN = (bf16_t*)(ws + WS_XN), *Qb = (bf16_t*)(ws + WS_Q), *Kb = (bf16_t*)(ws + WS_K), *Vb = (bf16_t*)(ws + WS_V), *Ub = (bf16_t*)(ws + WS_U), *Gb = (bf16_t*)(ws + WS_G),
           *OAb = (bf16_t*)(ws + WS_OA), *Y2b = (bf16_t*)(ws + WS_Y2), *MAb = (bf16_t*)(ws + WS_MA), *MGb = (bf16_t*)(ws + WS_MG), *X1b = (bf16_t*)(ws + WS_X1B);
    float* scal = (float*)(ws + WS_SCAL); int4* rinfo = (int4*)(ws + WS_RINFO); float* rstd = (float*)(ws + WS_RINFO + 512 * 1024);
    float* tmpC = (float*)(ws + WS_OA); float* tmp1 = (float*)(ws + WS_XN); float* tmp2 = (float*)(ws + WS_XN + 32 * MiB);
    nv::k_xn<<<T / 4, 256, 0, stream>>>(x, FIN(2), XN);
    nv::k_lam<<<1, 64, 0, stream>>>(FIN(6), FIN(7), FIN(8), FIN(9), scal);
    for (int jb = 0; jb < 8; ++jb) {
        nv::k_gemm<<<dim3(512 / 64, T / 64), 256, 0, stream>>>(XN, DM, FIN(3) + jb * 512, IN_COLS, tmpC, 512, DM);
        nv::k_post_in<<<T / 4, 256, 0, stream>>>(tmpC, jb, pos, FIN(4), FIN(5), Qb, Kb, Vb, Ub, Gb);
    }
    nv::k_attn<<<T, 256, 0, stream>>>(Qb, Kb, Vb, scal, FIN(10), OAb);
    nv::k_ssm<<<256, 64, 0, stream>>>(Ub, FIN(12), FIN(13), FIN(14), FIN(15), FIN(16), FIN(17), FIN(18), FIN(19), Y2b);
    for (int c = 0; c < 4; ++c) {
        nv::k_gemm<<<dim3(256 / 64, T / 64), 256, 0, stream>>>(OAb, 512, FIN(11) + c * 256, DM, tmp1, 256, 512);
        nv::k_post_oa<<<T, 256, 0, stream>>>(tmp1, 256, c * 256, Gb, MAb);
    }
    for (int c = 0; c < 4; ++c) {
        nv::k_gemm<<<dim3(256 / 64, T / 64), 256, 0, stream>>>(Y2b, 512, FIN(20) + c * 256, 2048, tmp1, 256, 512);
        nv::k_gemm<<<dim3(256 / 64, T / 64), 256, 0, stream>>>(Y2b, 512, FIN(20) + 1024 + c * 256, 2048, tmp2, 256, 512);
        nv::k_post_glu<<<T, 256, 0, stream>>>(tmp1, tmp2, 256, c * 256, Gb, MAb, MGb);
    }
    for (int c = 0; c < 2; ++c) {
        nv::k_gemm<<<dim3(512 / 64, T / 64), 256, 0, stream>>>(MGb, DM, FIN(21) + c * 512, DM, tmpC, 512, DM);
        nv::k_post_out<<<T * 2, 256, 0, stream>>>(tmpC, 512, c * 512, x, out, X1b);
    }
    nv::k_router<<<T / 4, 256, 0, stream>>>(out, FIN(22), FIN(23), FIN(24), FIN(25), FIN(26), rinfo, rstd);
    nv::k_moe<<<T, 256, 0, stream>>>(out, FIN(22), rinfo, rstd, FIN(27), FIN(28), FIN(29));
#undef FIN
}
```

```cpp
#include <hip/hip_runtime.h>
#include <hip/hip_bf16.h>
#include <cstdio>
#include <cstdint>
#include <cmath>

constexpr int DM = 1024, BATCH = 8, SEQ = 4096, T = BATCH * SEQ;
constexpr int IN_COLS = 4096;
constexpr float EPS = 1e-6f, ROPE_THETA = 500000.0f, LAM_INIT = 0.2f;
constexpr float QSCALE = 0.125f * 1.4426950408889634f;
typedef unsigned short bf16_t;
__device__ __forceinline__ float bf2f(bf16_t v) { return __uint_as_float(((unsigned)v) << 16); }
__device__ __forceinline__ bf16_t f2bf(float f) { unsigned u = __float_as_uint(f); return (bf16_t)((u + 0x7fffu + ((u >> 16) & 1u)) >> 16); }

#ifndef WT_STORES
#define WT_STORES 0
#endif
typedef unsigned wt_v4u __attribute__((ext_vector_type(4))); typedef unsigned wt_v2u __attribute__((ext_vector_type(2)));
__device__ __forceinline__ void st16(void* p, wt_v4u v) { if (WT_STORES) asm volatile("global_store_dwordx4 %0, %1, off sc1\n\ts_nop 1" :: "v"(p), "v"(v) : "memory"); else *(wt_v4u*)p = v; }
__device__ __forceinline__ void st8(void* p, wt_v2u v) { if (WT_STORES) asm volatile("global_store_dwordx2 %0, %1, off sc1\n\ts_nop 1" :: "v"(p), "v"(v) : "memory"); else *(wt_v2u*)p = v; }
__device__ __forceinline__ void pst16(void* p, wt_v4u v) { *(wt_v4u*)p = v; }
__device__ __forceinline__ void pst8(void* p, wt_v2u v) { *(wt_v2u*)p = v; }
#define ATTN_STORE16(p,v) st16((void*)(p), (v))

constexpr size_t MiB = 1u << 20;
constexpr size_t WS_CTL = 0, CTL_ZERO_BYTES = 1 * MiB;
constexpr size_t WS_SCAL = 1 * MiB, WS_ROPE = 2 * MiB, WS_WIN = 4 * MiB, WS_WO = 12 * MiB, WS_WGLU = 13 * MiB, WS_WOUT = 15 * MiB, WS_WGU = 17 * MiB, WS_WD = 49 * MiB,
                 WS_WR = 65 * MiB, WS_SSMF = 66 * MiB, WS_SSMG = 68 * MiB, WS_SSMH = 76 * MiB, WS_SSMA = 84 * MiB, WS_RINFO = 85 * MiB, WS_LISTS = 86 * MiB;
constexpr size_t WS_XN = 96 * MiB, WS_Q = 160 * MiB, WS_K = 192 * MiB, WS_V = 224 * MiB, WS_U = 256 * MiB, WS_G = 288 * MiB, WS_OA = 416 * MiB, WS_Y2 = 448 * MiB, WS_END = 480 * MiB;
constexpr size_t WS_OB = WS_XN, WS_X1B = WS_OA, WS_MA = WS_Q, WS_MG = WS_V, WS_HB = WS_G;
constexpr size_t WS_XN8 = 416 * MiB, WS_WG8 = 8 * MiB;
constexpr size_t WS_X1B8 = 96 * MiB;
constexpr size_t WS_PTOK = 360 * MiB;
constexpr size_t WS_LTOK = 332 * MiB, WS_LW = 340 * MiB, WS_LR = 348 * MiB;
namespace pg8 {
#define PG8_LAS __attribute__((address_space(3)))
typedef unsigned short bf16_t;
typedef short bf16x8 __attribute__((ext_vector_type(8)));
typedef float f32x4 __attribute__((ext_vector_type(4)));
typedef unsigned u32x4 __attribute__((ext_vector_type(4)));
constexpr int BM = 256, BK = 64, HALF = 128, HTB = HALF * BK * 2  , STAGE_BYTES = 8 * HTB, NXCD = 8, WGM = 8;

__host__ __device__ __forceinline__ int lds_byte(int r, int c) { const int st = (r >> 4) * 2 + (c >> 5), rr = r & 15, cc = c & 31, ob = rr * 64 + cc * 2; return st * 1024 + (ob ^ (((ob >> 9) & 1) << 5)); }
__host__ __device__ __forceinline__ void stage_rc(int b, int& R, int& C) { const int st = b / 1024, sb = b % 1024, swz = sb ^ (((sb >> 9) & 1) << 5); R = (st >> 1) * 16 + swz / 64; C = (st & 1) * 32 + (swz % 64) / 2; }
__host__ __device__ __forceinline__ int perm32(int rho) { const int n = rho >> 4, i = rho & 15; return 8 * (i >> 2) + 4 * n + (i & 3); }

struct Unit { int pm, pn; };
struct Gemm { const bf16_t* A; const bf16_t* Bt; int M, N, K; };

struct StaticOrder {
    int nM, nN, nwg, G, c;
    __host__ __device__ void init(int M, int N, int G_, int c_) { nM = M / BM; nN = N / BM; nwg = nM * nN; G = G_; c = c_; }
    __host__ __device__ bool next(int i, Unit& u) const {
        const long L = (long)i * G + c; if (L >= nwg) return false;
        int wgid = (int)L; { const int q = nwg / NXCD, r = nwg % NXCD, xcd = wgid % NXCD, off = wgid / NXCD; wgid = (xcd < r ? xcd * (q + 1) : r * (q + 1) + (xcd - r) * q) + off; }
        const int nig = WGM * nN, gid = wgid / nig, fm = gid * WGM, gsz = (nM - fm) < WGM ? (nM - fm) : WGM;
        u.pm = fm + ((wgid % nig) % gsz); u.pn = (wgid % nig) / gsz; return true;
    }
    __device__ __forceinline__ void a_ready(const Unit&) const {}
    __device__ __forceinline__ void done(const Unit&) const {}
};

__device__ __forceinline__ unsigned cvt_pk_bf16(float lo, float hi) { unsigned r; asm volatile("v_cvt_pk_bf16_f32 %0, %1, %2" : "=v"(r) : "v"(lo), "v"(hi)); return r; }
typedef float f32x2 __attribute__((ext_vector_type(2)));
__device__ __forceinline__ f32x2 gelu_pk(f32x2 v) {
    const f32x2 av = __builtin_elementwise_abs(v), d = av * 0.2316418882f + 1.0f;
    f32x2 t; t.x = __builtin_amdgcn_rcpf(d.x); t.y = __builtin_amdgcn_rcpf(d.y);
    f32x2 q = t * 0.5307027145f + (-0.7265760135f); q = q * t + 0.7107068705f; q = q * t + (-0.142248368f); q = q * t + 0.127414796f; q = q * t;
    const f32x2 s = (v * v) * (-0.72134752044f);
    f32x2 e; e.x = __builtin_amdgcn_exp2f(s.x); e.y = __builtin_amdgcn_exp2f(s.y);
    const f32x2 m = v * (q * e), r = v - m;
    f32x2 o; o.x = v.x < 0.f ? m.x : r.x; o.y = v.y < 0.f ? m.y : r.y; return o;
}

template <int ACT  > struct EpiBf16 {
    static constexpr bool PERM = true, AFTER_DRAIN = false; static_assert(ACT == 0 || ACT == 1, "EpiBf16: ACT is 0 (none) or 1 (gelu_pk)");
    bf16_t* O; int ldc; const float* bias; int split_cols; size_t split_stride; float scale0;
    __device__ __forceinline__ void operator()(const f32x4 (&acc)[2][2][4][2], const Unit& u, int wr, int wc, int fr, int fq) const {
        const int row0 = u.pm * BM + wr * 64 + fr; int colt = u.pn * BM; bf16_t* base = O;
        float sc = 1.f; if (split_cols) { const int t = colt / split_cols; base += (size_t)t * split_stride; colt -= t * split_cols; if (t == 0) sc = scale0; }
        const int col0 = colt + wc * 32 + 8 * fq, bcol0 = u.pn * BM + wc * 32 + 8 * fq;
        f32x4 bv[2][2];
#pragma unroll
        for (int bj = 0; bj < 2; ++bj)
#pragma unroll
            for (int n = 0; n < 2; ++n) bv[bj][n] = bias ? *(const f32x4*)(bias + bcol0 + bj * HALF + 4 * n) : (f32x4){0.f, 0.f, 0.f, 0.f};
#pragma unroll
        for (int ai = 0; ai < 2; ++ai)
#pragma unroll
            for (int m = 0; m < 4; ++m) { bf16_t* rowp = base + (size_t)(row0 + ai * HALF + m * 16) * ldc + col0;
#pragma unroll
                for (int bj = 0; bj < 2; ++bj) { f32x4 v0 = acc[ai][bj][m][0] + bv[bj][0], v1 = acc[ai][bj][m][1] + bv[bj][1];
                    if (ACT == 1) { f32x2 a = gelu_pk((f32x2){v0[0], v0[1]}), b = gelu_pk((f32x2){v0[2], v0[3]}), c = gelu_pk((f32x2){v1[0], v1[1]}), d = gelu_pk((f32x2){v1[2], v1[3]});
                        v0 = (f32x4){a.x, a.y, b.x, b.y}; v1 = (f32x4){c.x, c.y, d.x, d.y}; }
                    v0 = v0 * sc; v1 = v1 * sc; u32x4 w; w.x = cvt_pk_bf16(v0[0], v0[1]); w.y = cvt_pk_bf16(v0[2], v0[3]); w.z = cvt_pk_bf16(v1[0], v1[1]); w.w = cvt_pk_bf16(v1[2], v1[3]);
                    *(u32x4*)(rowp + bj * HALF) = w; } }
    }
};

template <class Epi, class Sched, bool ALIGN_EPI = false, bool SP2 = false, bool FP8 = false>
__device__ __forceinline__ void gemm_phase(PG8_LAS unsigned char* lds, const Gemm g, const Sched& S, const Epi& E, const int tid0) {
    int tid_ = tid0; asm volatile("" : "+v"(tid_));
    const int tid = tid_, wid = __builtin_amdgcn_readfirstlane(tid >> 6), lane = tid & 63, wr = wid >> 2, wc = wid & 3, fr = lane & 15, fq = lane >> 4;
    const int K = g.K; int nt_ = K / BK; if constexpr (FP8) asm volatile("" : "+s"(nt_));
    const int nt = nt_;
    unsigned voffA[2], voffB[2];
#pragma unroll
    for (int i = 0; i < 2; ++i) { int R, C; stage_rc(tid * 16 + i * 8192, R, C); const int Rb = Epi::PERM ? ((R & ~31) + perm32(R & 31)) : R;
        voffA[i] = (unsigned)(R * K + C) * 2u; voffB[i] = (unsigned)(Rb * K + C) * 2u; }
    const size_t kstep = (size_t)(BK * 2);
    const size_t hstep = (size_t)HALF * K * 2;
    const size_t tstep = 2 * hstep;
    const unsigned ldsw = (unsigned)wid * 1024u;
    const int aoff = lds_byte(wr * 64 + fr, fq * 8), boff = lds_byte(wc * 32 + fr, fq * 8);
#define PG8_SA(b, h) (((b) * 2 + (h)) * HTB)
#define PG8_SB(b, h) ((4 + (b) * 2 + (h)) * HTB)
#define PG8_STAGE(bufoff, gbase, voff) do { _Pragma("unroll") for (int _i = 0; _i < 2; ++_i) \
        __builtin_amdgcn_global_load_lds((const unsigned*)((const char*)(gbase) + (voff)[_i]), (PG8_LAS unsigned*)(lds + (bufoff) + ldsw + _i * 8192), 16, 0, 0); } while (0)
#define PG8_LDA(dst, b, h) do { _Pragma("unroll") for (int m = 0; m < 4; ++m) { if constexpr (FP8) { dst##8[m].lo = *(const PG8_LAS v4i_*)(lds + PG8_SA(b, h) + aoff + m * 2048); dst##8[m].hi = *(const PG8_LAS v4i_*)(lds + PG8_SA(b, h) + aoff + m * 2048 + 1024); } \
        else { _Pragma("unroll") for (int k = 0; k < 2; ++k) dst[m][k] = *(const PG8_LAS bf16x8*)(lds + PG8_SA(b, h) + aoff + m * 2048 + k * 1024); } } } while (0)
#define PG8_LDB(dst, b, h) do { _Pragma("unroll") for (int n = 0; n < 2; ++n) { if constexpr (FP8) { dst##8[n].lo = *(const PG8_LAS v4i_*)(lds + PG8_SB(b, h) + boff + n * 2048); dst##8[n].hi = *(const PG8_LAS v4i_*)(lds + PG8_SB(b, h) + boff + n * 2048 + 1024); } \
        else { _Pragma("unroll") for (int k = 0; k < 2; ++k) dst[n][k] = *(const PG8_LAS bf16x8*)(lds + PG8_SB(b, h) + boff + n * 2048 + k * 1024); } } } while (0)
#define PG8_MMA(ai, bj, At, Bt) do { __builtin_amdgcn_s_setprio(1); _Pragma("unroll") for (int m = 0; m < 4; ++m) _Pragma("unroll") for (int n = 0; n < 2; ++n) { \
        if constexpr (FP8) asm volatile("v_mfma_scale_f32_16x16x128_f8f6f4 %0, %1, %2, %0, %3, %3 op_sel_hi:[0,0,0]" : "+v"(acc[ai][bj][m][n]) : "v"(Bt##8[n]), "v"(At##8[m]), "v"(one8_)); \
        else { _Pragma("unroll") for (int k = 0; k < 2; ++k) acc[ai][bj][m][n] = __builtin_amdgcn_mfma_f32_16x16x32_bf16(Bt[n][k], At[m][k], acc[ai][bj][m][n], 0, 0, 0); } } __builtin_amdgcn_s_setprio(0); } while (0)
#define PG8_WAIT_V(n) asm volatile("s_waitcnt vmcnt(" #n ")" ::: "memory")
#define PG8_WAIT_L(n) asm volatile("s_waitcnt lgkmcnt(" #n ")" ::: "memory")
#define PG8_BAR __builtin_amdgcn_s_barrier()
#define PG8_SCHED __builtin_amdgcn_sched_barrier(0)
    Unit cur, nxt; int ui = 0;
    if (!S.next(0, cur)) return;
    f32x4 acc[2][2][4][2];
#pragma unroll
    for (int a = 0; a < 2; ++a)
#pragma unroll
        for (int b = 0; b < 2; ++b)
#pragma unroll
            for (int m = 0; m < 4; ++m)
#pragma unroll
                for (int n = 0; n < 2; ++n) acc[a][b][m][n] = (f32x4){0.f, 0.f, 0.f, 0.f};
    typedef int v4i_ __attribute__((ext_vector_type(4))); typedef int v8i_ __attribute__((ext_vector_type(8)));
    bf16x8 At[4][2], B0[2][2], B1[2][2]; v8i_ At8[4], B08[2], B18[2]; int one8_ = 0x7f7f7f7f; if constexpr (FP8) asm volatile("" : "+v"(one8_));
    const char* cA = (const char*)g.A + (size_t)cur.pm * tstep; const char* cB = (const char*)g.Bt + (size_t)cur.pn * tstep;
    S.a_ready(cur);
    if constexpr (SP2) {
        PG8_STAGE(PG8_SB(0, 0), cB, voffB); PG8_STAGE(PG8_SB(0, 1), cB + hstep, voffB); PG8_STAGE(PG8_SA(0, 0), cA, voffA); PG8_STAGE(PG8_SA(0, 1), cA + hstep, voffA);
        if (wr == 1) PG8_BAR;
        PG8_WAIT_V(2); PG8_BAR;
        PG8_STAGE(PG8_SB(1, 0), cB + kstep, voffB); PG8_STAGE(PG8_SA(1, 0), cA + kstep, voffA); PG8_STAGE(PG8_SB(1, 1), cB + hstep + kstep, voffB);
        PG8_WAIT_V(6); PG8_BAR;
    } else {
        PG8_STAGE(PG8_SB(0, 0), cB, voffB); PG8_STAGE(PG8_SA(0, 0), cA, voffA); PG8_STAGE(PG8_SB(0, 1), cB + hstep, voffB); PG8_STAGE(PG8_SA(0, 1), cA + hstep, voffA);
        if (wr == 1) PG8_BAR;
        PG8_WAIT_V(4); PG8_BAR;
        PG8_STAGE(PG8_SB(1, 0), cB + kstep, voffB); PG8_STAGE(PG8_SA(1, 0), cA + kstep, voffA); PG8_STAGE(PG8_SB(1, 1), cB + hstep + kstep, voffB);
        PG8_WAIT_V(6); PG8_BAR;
    }
    for (;;) {
        const bool has_next = S.next(ui + 1, nxt);
        const char* nA = has_next ? (const char*)g.A + (size_t)nxt.pm * tstep : cA; const char* nB = has_next ? (const char*)g.Bt + (size_t)nxt.pn * tstep : cB;
        for (int t = 0; t < nt; t += 2) {
            const bool last = (t == nt - 2);
            const char* a1 = cA + (size_t)(t + 1) * kstep;
            const char* a2 = last ? nA : cA + (size_t)(t + 2) * kstep; const char* b2 = last ? nB : cB + (size_t)(t + 2) * kstep;
            const char* a3 = a2 + kstep; const char* b3 = b2 + kstep;
            if (last && has_next) S.a_ready(nxt);
            if constexpr (SP2) {
            PG8_LDB(B0, 0, 0); PG8_LDB(B1, 0, 1); PG8_SCHED; PG8_LDA(At, 0, 0); PG8_STAGE(PG8_SA(1, 1), a1 + hstep, voffA);
            PG8_WAIT_V(8); PG8_WAIT_L(0); PG8_BAR; PG8_MMA(0, 0, At, B0); PG8_MMA(0, 1, At, B1); PG8_BAR; PG8_SCHED;
            PG8_LDA(At, 0, 1); PG8_STAGE(PG8_SB(0, 0), b2, voffB); PG8_STAGE(PG8_SB(0, 1), b2 + hstep, voffB); PG8_STAGE(PG8_SA(0, 0), a2, voffA);
            PG8_WAIT_V(8); PG8_WAIT_L(0); PG8_BAR; PG8_MMA(1, 0, At, B0); PG8_MMA(1, 1, At, B1); PG8_BAR; PG8_SCHED;
            PG8_LDB(B0, 1, 0); PG8_LDB(B1, 1, 1); PG8_SCHED; PG8_LDA(At, 1, 0); PG8_STAGE(PG8_SA(0, 1), a2 + hstep, voffA);
            PG8_WAIT_V(8); PG8_WAIT_L(0); PG8_BAR; PG8_MMA(0, 0, At, B0); PG8_MMA(0, 1, At, B1); PG8_BAR; PG8_SCHED;
            PG8_LDA(At, 1, 1); PG8_STAGE(PG8_SB(1, 0), b3, voffB); PG8_STAGE(PG8_SB(1, 1), b3 + hstep, voffB); PG8_STAGE(PG8_SA(1, 0), a3, voffA);
            PG8_WAIT_V(8); PG8_WAIT_L(0); PG8_BAR; PG8_MMA(1, 0, At, B0); PG8_MMA(1, 1, At, B1); PG8_BAR; PG8_SCHED;
            } else {
            PG8_LDB(B0, 0, 0); PG8_SCHED; PG8_LDA(At, 0, 0); PG8_STAGE(PG8_SA(1, 1), a1 + hstep, voffA);
            PG8_WAIT_L(8); PG8_BAR; PG8_WAIT_L(0); PG8_MMA(0, 0, At, B0); PG8_BAR; PG8_SCHED;
            PG8_LDB(B1, 0, 1); PG8_STAGE(PG8_SB(0, 0), b2, voffB);
            PG8_BAR; PG8_WAIT_L(0); PG8_MMA(0, 1, At, B1); PG8_BAR;
            PG8_LDA(At, 0, 1); PG8_STAGE(PG8_SA(0, 0), a2, voffA);
            PG8_BAR; PG8_WAIT_L(0); PG8_MMA(1, 0, At, B0); PG8_BAR; PG8_SCHED;
            PG8_STAGE(PG8_SB(0, 1), b2 + hstep, voffB);
            PG8_WAIT_V(6); PG8_BAR; PG8_MMA(1, 1, At, B1); PG8_BAR;
            PG8_LDB(B0, 1, 0); PG8_SCHED; PG8_LDA(At, 1, 0); PG8_STAGE(PG8_SA(0, 1), a2 + hstep, voffA);
            PG8_WAIT_L(8); PG8_BAR; PG8_WAIT_L(0); PG8_MMA(0, 0, At, B0); PG8_BAR; PG8_SCHED;
            PG8_LDB(B1, 1, 1); PG8_STAGE(PG8_SB(1, 0), b3, voffB);
            PG8_BAR; PG8_WAIT_L(0); PG8_MMA(0, 1, At, B1); PG8_BAR;
            PG8_LDA(At, 1, 1); PG8_STAGE(PG8_SA(1, 0), a3, voffA);
            PG8_BAR; PG8_WAIT_L(0); PG8_MMA(1, 0, At, B0); PG8_BAR; PG8_SCHED;
            PG8_STAGE(PG8_SB(1, 1), b3 + hstep, voffB);
            PG8_WAIT_V(6); PG8_BAR; PG8_MMA(1, 1, At, B1); PG8_BAR;
            }
        }
        if constexpr (ALIGN_EPI) { if (wr == 0) PG8_BAR; }
        if constexpr (FP8) {
            asm volatile("s_nop 15\n\ts_nop 15" ::: "memory");
#pragma unroll
            for (int a = 0; a < 2; ++a)
#pragma unroll
                for (int b = 0; b < 2; ++b) asm volatile("" : "+v"(acc[a][b][0][0]), "+v"(acc[a][b][0][1]), "+v"(acc[a][b][1][0]), "+v"(acc[a][b][1][1]), "+v"(acc[a][b][2][0]), "+v"(acc[a][b][2][1]), "+v"(acc[a][b][3][0]), "+v"(acc[a][b][3][1])); }
        if constexpr (!Epi::AFTER_DRAIN) { E(acc, cur, wr, wc, fr, fq); S.done(cur); }
        if (!has_next) break;
#pragma unroll
        for (int a = 0; a < 2; ++a)
#pragma unroll
            for (int b = 0; b < 2; ++b)
#pragma unroll
                for (int m = 0; m < 4; ++m)
#pragma unroll
                    for (int n = 0; n < 2; ++n) acc[a][b][m][n] = (f32x4){0.f, 0.f, 0.f, 0.f};
        cur = nxt; cA = nA; cB = nB; ++ui;
        if constexpr (ALIGN_EPI) { if (wr == 1) PG8_BAR; }
    }
    PG8_WAIT_V(0);
    if constexpr (!ALIGN_EPI) { if (wr == 0) PG8_BAR; }
    PG8_BAR;
    if constexpr (Epi::AFTER_DRAIN) { E.fused(acc, cur, wr, wc, fr, fq, lds, wid, lane); S.done(cur); }
#undef PG8_SA
#undef PG8_SB
#undef PG8_STAGE
#undef PG8_LDA
#undef PG8_LDB
#undef PG8_MMA
#undef PG8_WAIT_V
#undef PG8_WAIT_L
#undef PG8_BAR
#undef PG8_SCHED
}
}

#ifndef PG8_SP2
#define PG8_SP2 true
#endif
#ifndef PG8_ALIGN
#define PG8_ALIGN true
#endif
namespace pg8 {
template <class Epi, class Sched, bool ALIGN_EPI, bool FP8 = false>
__device__ __forceinline__ void gemm_phase_x(PG8_LAS unsigned char* lds, const char* Abase, const int K, const Sched& S, const Epi& E, const int tid0) {
    int tid_ = tid0; asm volatile("" : "+v"(tid_));
    const int tid = tid_, wid = __builtin_amdgcn_readfirstlane(tid >> 6), lane = tid & 63, wr = wid >> 2, wc = wid & 3, fr = lane & 15, fq = lane >> 4;
    int nt_ = K / BK; if constexpr (FP8) asm volatile("" : "+s"(nt_));
    const int nt = nt_;
    int RA[2]; unsigned CA[2], voffB[2];
#pragma unroll
    for (int i = 0; i < 2; ++i) { int R, C; stage_rc(tid * 16 + i * 8192, R, C); const int Rb = Epi::PERM ? ((R & ~31) + perm32(R & 31)) : R; RA[i] = R; CA[i] = (unsigned)C * 2u; voffB[i] = (unsigned)(Rb * K + C) * 2u; }
    const size_t kstep = (size_t)(BK * 2), hstep = (size_t)HALF * K * 2;
    const unsigned ldsw = (unsigned)wid * 1024u;
    const int aoff = lds_byte(wr * 64 + fr, fq * 8), boff = lds_byte(wc * 32 + fr, fq * 8);
#define PG8_SA(b, h) (((b) * 2 + (h)) * HTB)
#define PG8_SB(b, h) ((4 + (b) * 2 + (h)) * HTB)
#define PG8_STAGE(bufoff, gbase, voff) do { _Pragma("unroll") for (int _i = 0; _i < 2; ++_i) \
        __builtin_amdgcn_global_load_lds((const unsigned*)((const char*)(gbase) + (voff)[_i]), (PG8_LAS unsigned*)(lds + (bufoff) + ldsw + _i * 8192), 16, 0, 0); } while (0)
#define PG8_STAGE_A(bufoff, kb, VO) do { _Pragma("unroll") for (int _i = 0; _i < 2; ++_i) \
        __builtin_amdgcn_global_load_lds((const unsigned*)(Abase + (size_t)(kb) + (VO)[_i]), (PG8_LAS unsigned*)(lds + (bufoff) + ldsw + _i * 8192), 16, 0, 0); } while (0)
    constexpr bool GA = Sched::GATHER;
#define PG8_LDA(dst, b, h) do { _Pragma("unroll") for (int m = 0; m < 4; ++m) { if constexpr (FP8) { dst##8[m].lo = *(const PG8_LAS v4i_*)(lds + PG8_SA(b, h) + aoff + m * 2048); dst##8[m].hi = *(const PG8_LAS v4i_*)(lds + PG8_SA(b, h) + aoff + m * 2048 + 1024); } \
        else { _Pragma("unroll") for (int k = 0; k < 2; ++k) dst[m][k] = *(const PG8_LAS bf16x8*)(lds + PG8_SA(b, h) + aoff + m * 2048 + k * 1024); } } } while (0)
#define PG8_LDB(dst, b, h) do { _Pragma("unroll") for (int n = 0; n < 2; ++n) { if constexpr (FP8) { dst##8[n].lo = *(const PG8_LAS v4i_*)(lds + PG8_SB(b, h) + boff + n * 2048); dst##8[n].hi = *(const PG8_LAS v4i_*)(lds + PG8_SB(b, h) + boff + n * 2048 + 1024); } \
        else { _Pragma("unroll") for (int k = 0; k < 2; ++k) dst[n][k] = *(const PG8_LAS bf16x8*)(lds + PG8_SB(b, h) + boff + n * 2048 + k * 1024); } } } while (0)
#define PG8_MMA(ai, bj, At, Bt) do { __builtin_amdgcn_s_setprio(1); _Pragma("unroll") for (int m = 0; m < 4; ++m) _Pragma("unroll") for (int n = 0; n < 2; ++n) { \
        if constexpr (FP8) asm volatile("v_mfma_scale_f32_16x16x128_f8f6f4 %0, %1, %2, %0, %3, %3 op_sel_hi:[0,0,0]" : "+v"(acc[ai][bj][m][n]) : "v"(Bt##8[n]), "v"(At##8[m]), "v"(one8_)); \
        else { _Pragma("unroll") for (int k = 0; k < 2; ++k) acc[ai][bj][m][n] = __builtin_amdgcn_mfma_f32_16x16x32_bf16(Bt[n][k], At[m][k], acc[ai][bj][m][n], 0, 0, 0); } } __builtin_amdgcn_s_setprio(0); } while (0)
#define PG8_WAIT_V(n) asm volatile("s_waitcnt vmcnt(" #n ")" ::: "memory")
#define PG8_WAIT_L(n) asm volatile("s_waitcnt lgkmcnt(" #n ")" ::: "memory")
#define PG8_BAR __builtin_amdgcn_s_barrier()
#define PG8_SCHED __builtin_amdgcn_sched_barrier(0)
    typename Sched::U cur, nxt; int ui = 0;
    if (!S.next(0, cur)) return;
    f32x4 acc[2][2][4][2];
#pragma unroll
    for (int a = 0; a < 2; ++a)
#pragma unroll
        for (int b = 0; b < 2; ++b)
#pragma unroll
            for (int m = 0; m < 4; ++m)
#pragma unroll
                for (int n = 0; n < 2; ++n) acc[a][b][m][n] = (f32x4){0.f, 0.f, 0.f, 0.f};
    typedef int v4i_ __attribute__((ext_vector_type(4))); typedef int v8i_ __attribute__((ext_vector_type(8)));
    bf16x8 At[4][2], B0[2][2], B1[2][2]; v8i_ At8[4], B08[2], B18[2]; int one8_ = 0x7f7f7f7f; if constexpr (FP8) asm volatile("" : "+v"(one8_));
    unsigned cva[2][2], nva[2][2]; size_t cbase = GA ? (size_t)0 : S.a_base(cur), nbase = 0;
#pragma unroll
    for (int h = 0; h < 2; ++h)
#pragma unroll
        for (int i = 0; i < 2; ++i) { cva[h][i] = (GA ? S.a_off(cur, h * HALF + RA[i]) : (unsigned)(h * HALF + RA[i]) * (unsigned)S.rowbytes) + CA[i]; nva[h][i] = cva[h][i]; }
    const char* cB = S.b_ptr(cur);
    PG8_STAGE(PG8_SB(0, 0), cB, voffB); PG8_STAGE(PG8_SB(0, 1), cB + hstep, voffB); PG8_STAGE_A(PG8_SA(0, 0), cbase, cva[0]); PG8_STAGE_A(PG8_SA(0, 1), cbase, cva[1]);
    if (wr == 1) PG8_BAR;
    PG8_WAIT_V(2); PG8_BAR;
    PG8_STAGE(PG8_SB(1, 0), cB + kstep, voffB); PG8_STAGE_A(PG8_SA(1, 0), cbase + kstep, cva[0]); PG8_STAGE(PG8_SB(1, 1), cB + hstep + kstep, voffB);
    PG8_WAIT_V(6); PG8_BAR;
    for (;;) {
        const bool has_next = S.next(ui + 1, nxt);
        const char* nB = has_next ? S.b_ptr(nxt) : cB;
        if constexpr (GA) {
#pragma unroll
            for (int h = 0; h < 2; ++h)
#pragma unroll
                for (int i = 0; i < 2; ++i) nva[h][i] = has_next ? S.a_off(nxt, h * HALF + RA[i]) + CA[i] : cva[h][i];
        } else nbase = has_next ? S.a_base(nxt) : cbase;
        for (int t = 0; t < nt; t += 2) {
            const bool last = (t == nt - 2);
            const size_t k1 = cbase + (size_t)(t + 1) * kstep, k2 = last ? nbase : cbase + (size_t)(t + 2) * kstep, k3 = k2 + kstep;
            unsigned s2[2][2];
#pragma unroll
            for (int h = 0; h < 2; ++h)
#pragma unroll
                for (int i = 0; i < 2; ++i) s2[h][i] = (GA && last) ? nva[h][i] : cva[h][i];
            const char* b2 = last ? nB : cB + (size_t)(t + 2) * kstep; const char* b3 = b2 + kstep;
            PG8_LDB(B0, 0, 0); PG8_LDB(B1, 0, 1); PG8_SCHED; PG8_LDA(At, 0, 0); PG8_STAGE_A(PG8_SA(1, 1), k1, cva[1]);
            PG8_WAIT_V(8); PG8_WAIT_L(0); PG8_BAR; PG8_MMA(0, 0, At, B0); PG8_MMA(0, 1, At, B1); PG8_BAR; PG8_SCHED;
            PG8_LDA(At, 0, 1); PG8_STAGE(PG8_SB(0, 0), b2, voffB); PG8_STAGE(PG8_SB(0, 1), b2 + hstep, voffB); PG8_STAGE_A(PG8_SA(0, 0), k2, s2[0]);
            PG8_WAIT_V(8); PG8_WAIT_L(0); PG8_BAR; PG8_MMA(1, 0, At, B0); PG8_MMA(1, 1, At, B1); PG8_BAR; PG8_SCHED;
            PG8_LDB(B0, 1, 0); PG8_LDB(B1, 1, 1); PG8_SCHED; PG8_LDA(At, 1, 0); PG8_STAGE_A(PG8_SA(0, 1), k2, s2[1]);
            PG8_WAIT_V(8); PG8_WAIT_L(0); PG8_BAR; PG8_MMA(0, 0, At, B0); PG8_MMA(0, 1, At, B1); PG8_BAR; PG8_SCHED;
            PG8_LDA(At, 1, 1); PG8_STAGE(PG8_SB(1, 0), b3, voffB); PG8_STAGE(PG8_SB(1, 1), b3 + hstep, voffB); PG8_STAGE_A(PG8_SA(1, 0), k3, s2[0]);
            PG8_WAIT_V(8); PG8_WAIT_L(0); PG8_BAR; PG8_MMA(1, 0, At, B0); PG8_MMA(1, 1, At, B1); PG8_BAR; PG8_SCHED;
        }
        if constexpr (ALIGN_EPI) { if (wr == 0) PG8_BAR; }
        if constexpr (FP8) {
            asm volatile("s_nop 15\n\ts_nop 15" ::: "memory");
#pragma unroll
            for (int a = 0; a < 2; ++a)
#pragma unroll
                for (int b = 0; b < 2; ++b) asm volatile("" : "+v"(acc[a][b][0][0]), "+v"(acc[a][b][0][1]), "+v"(acc[a][b][1][0]), "+v"(acc[a][b][1][1]), "+v"(acc[a][b][2][0]), "+v"(acc[a][b][2][1]), "+v"(acc[a][b][3][0]), "+v"(acc[a][b][3][1])); }
        E(acc, cur, wr, wc, fr, fq);
        if (!has_next) break;
#pragma unroll
        for (int a = 0; a < 2; ++a)
#pragma unroll
            for (int b = 0; b < 2; ++b)
#pragma unroll
                for (int m = 0; m < 4; ++m)
#pragma unroll
                    for (int n = 0; n < 2; ++n) acc[a][b][m][n] = (f32x4){0.f, 0.f, 0.f, 0.f};
        cur = nxt; cB = nB; cbase = nbase; ++ui;
        if constexpr (GA) {
#pragma unroll
            for (int h = 0; h < 2; ++h)
#pragma unroll
                for (int i = 0; i < 2; ++i) cva[h][i] = nva[h][i]; }
        if constexpr (ALIGN_EPI) { if (wr == 1) PG8_BAR; }
    }
    PG8_WAIT_V(0);
    if constexpr (!ALIGN_EPI) { if (wr == 0) PG8_BAR; }
    PG8_BAR;
#undef PG8_SA
#undef PG8_SB
#undef PG8_STAGE
#undef PG8_STAGE_A
#undef PG8_LDA
#undef PG8_LDB
#undef PG8_MMA
#undef PG8_WAIT_V
#undef PG8_WAIT_L
#undef PG8_BAR
#undef PG8_SCHED
}
}
namespace pg8 {
template <class Epi, class Sched, bool ALIGN_EPI, bool FP8 = false>
__device__ __forceinline__ void gemm_phase_pair(PG8_LAS unsigned char* lds, const char* Abase, const Sched& S, const Epi& E, const int tid0) {
    int tid_ = tid0; asm volatile("" : "+v"(tid_));
    const int tid = tid_, wid = __builtin_amdgcn_readfirstlane(tid >> 6), lane = tid & 63, wr = wid >> 2, wc = wid & 3, fr = lane & 15, fq = lane >> 4;
    constexpr int KB = FP8 ? 128 : 256;
    constexpr int NH = FP8 ? 2 : 4;
    int RA[2]; unsigned CA[2], voffB[2];
#pragma unroll
    for (int i = 0; i < 2; ++i) { int R, C; stage_rc(tid * 16 + i * 8192, R, C); const int Rb = Epi::PERM ? ((R & ~31) + perm32(R & 31)) : R; RA[i] = R; CA[i] = (unsigned)C * 2u; voffB[i] = (unsigned)(Rb * KB + C) * 2u; }
    const size_t kstep = (size_t)(BK * 2), hstepB = (size_t)HALF * KB * 2;
    const unsigned ldsw = (unsigned)wid * 1024u;
    const int aoff = lds_byte(wr * 64 + fr, fq * 8), boff = lds_byte(wc * 32 + fr, fq * 8);
#define PG8_SA(b, h) (((b) * 2 + (h)) * HTB)
#define PG8_SB(b, h) ((4 + (b) * 2 + (h)) * HTB)
#define PG8_STAGE(bufoff, gbase, voff) do { _Pragma("unroll") for (int _i = 0; _i < 2; ++_i) \
        __builtin_amdgcn_global_load_lds((const unsigned*)((const char*)(gbase) + (voff)[_i]), (PG8_LAS unsigned*)(lds + (bufoff) + ldsw + _i * 8192), 16, 0, 0); } while (0)
#define PG8_STAGE_A(bufoff, kb, VO) do { _Pragma("unroll") for (int _i = 0; _i < 2; ++_i) \
        __builtin_amdgcn_global_load_lds((const unsigned*)(Abase + (size_t)(kb) + (VO)[_i]), (PG8_LAS unsigned*)(lds + (bufoff) + ldsw + _i * 8192), 16, 0, 0); } while (0)
#define PG8_LDA(dst, b, h) do { _Pragma("unroll") for (int m = 0; m < 4; ++m) { if constexpr (FP8) { dst##8[m].lo = *(const PG8_LAS v4i_*)(lds + PG8_SA(b, h) + aoff + m * 2048); dst##8[m].hi = *(const PG8_LAS v4i_*)(lds + PG8_SA(b, h) + aoff + m * 2048 + 1024); } \
        else { _Pragma("unroll") for (int k = 0; k < 2; ++k) dst[m][k] = *(const PG8_LAS bf16x8*)(lds + PG8_SA(b, h) + aoff + m * 2048 + k * 1024); } } } while (0)
#define PG8_LDB(dst, b, h) do { _Pragma("unroll") for (int n = 0; n < 2; ++n) { if constexpr (FP8) { dst##8[n].lo = *(const PG8_LAS v4i_*)(lds + PG8_SB(b, h) + boff + n * 2048); dst##8[n].hi = *(const PG8_LAS v4i_*)(lds + PG8_SB(b, h) + boff + n * 2048 + 1024); } \
        else { _Pragma("unroll") for (int k = 0; k < 2; ++k) dst[n][k] = *(const PG8_LAS bf16x8*)(lds + PG8_SB(b, h) + boff + n * 2048 + k * 1024); } } } while (0)
#define PG8_MMA(ai, bj, At, Bt) do { __builtin_amdgcn_s_setprio(1); _Pragma("unroll") for (int m = 0; m < 4; ++m) _Pragma("unroll") for (int n = 0; n < 2; ++n) { \
        if constexpr (FP8) asm volatile("v_mfma_scale_f32_16x16x128_f8f6f4 %0, %1, %2, %0, %3, %3 op_sel_hi:[0,0,0]" : "+v"(acc[ai][bj][m][n]) : "v"(Bt##8[n]), "v"(At##8[m]), "v"(one8_)); \
        else { _Pragma("unroll") for (int k = 0; k < 2; ++k) acc[ai][bj][m][n] = __builtin_amdgcn_mfma_f32_16x16x32_bf16(Bt[n][k], At[m][k], acc[ai][bj][m][n], 0, 0, 0); } } __builtin_amdgcn_s_setprio(0); } while (0)
#define PG8_WAIT_V(n) asm volatile("s_waitcnt vmcnt(" #n ")" ::: "memory")
#define PG8_WAIT_L(n) asm volatile("s_waitcnt lgkmcnt(" #n ")" ::: "memory")
#define PG8_BAR __builtin_amdgcn_s_barrier()
#define PG8_SCHED __builtin_amdgcn_sched_barrier(0)
#define PG8_LOADSET(dst, u, set) do { _Pragma("unroll") for (int _h = 0; _h < 2; ++_h) _Pragma("unroll") for (int _i = 0; _i < 2; ++_i) dst[_h][_i] = S.a_off(u, set, _h * HALF + RA[_i]) + CA[_i]; } while (0)
    typename Sched::U cur, nxt; int ui = 0;
    if (!S.next(0, cur)) return;
    f32x4 acc[2][2][4][2];
#pragma unroll
    for (int a = 0; a < 2; ++a)
#pragma unroll
        for (int b = 0; b < 2; ++b)
#pragma unroll
            for (int m = 0; m < 4; ++m)
#pragma unroll
                for (int n = 0; n < 2; ++n) acc[a][b][m][n] = (f32x4){0.f, 0.f, 0.f, 0.f};
    typedef int v4i_ __attribute__((ext_vector_type(4))); typedef int v8i_ __attribute__((ext_vector_type(8)));
    bf16x8 At[4][2], B0[2][2], B1[2][2]; v8i_ At8[4], B08[2], B18[2]; int one8_ = 0x7f7f7f7f; if constexpr (FP8) asm volatile("" : "+v"(one8_));
    unsigned va[2][2], vb[2][2];
    PG8_LOADSET(va, cur, 0); PG8_LOADSET(vb, cur, 1);
    const char* bLo = S.b_ptr(cur, 0); const char* bHi = S.b_ptr(cur, 1);
    PG8_STAGE(PG8_SB(0, 0), bLo, voffB); PG8_STAGE(PG8_SB(0, 1), bLo + hstepB, voffB); PG8_STAGE_A(PG8_SA(0, 0), 0, va[0]); PG8_STAGE_A(PG8_SA(0, 1), 0, va[1]);
    if (wr == 1) PG8_BAR;
    PG8_WAIT_V(2); PG8_BAR;
    PG8_STAGE(PG8_SB(1, 0), bLo + kstep, voffB); PG8_STAGE_A(PG8_SA(1, 0), kstep, va[0]); PG8_STAGE(PG8_SB(1, 1), bLo + hstepB + kstep, voffB);
    PG8_WAIT_V(6); PG8_BAR;
    for (;;) {
        const bool has_next = S.next(ui + 1, nxt);
        const char* nbLo = has_next ? S.b_ptr(nxt, 0) : bLo;
#pragma clang loop unroll(disable)
        for (int t = 0; t < 2 * NH; t += 2) { const bool last = t == 2 * NH - 2;
            if (t == NH - 2) PG8_LOADSET(vb, cur, 1);
            if (last) { if (has_next) PG8_LOADSET(va, nxt, 0); else PG8_LOADSET(va, cur, 0); }
            const bool xa = t + 1 < NH, ya = last || (t + 2 < NH);
            unsigned X1[2], Y0[2], Y1[2];
#pragma unroll
            for (int i = 0; i < 2; ++i) { X1[i] = xa ? va[1][i] : vb[1][i]; Y0[i] = ya ? va[0][i] : vb[0][i]; Y1[i] = ya ? va[1][i] : vb[1][i]; }
            const size_t kx = (size_t)((t + 1) & (NH - 1)) * kstep, ky2 = (size_t)((t + 2) & (NH - 1)) * kstep, ky3 = ky2 + kstep;
            const char* bY = last ? nbLo : (t + 2 < NH ? bLo : bHi); const char* b2 = bY + ky2; const char* b3 = b2 + kstep;
            PG8_LDB(B0, 0, 0); PG8_LDB(B1, 0, 1); PG8_SCHED; PG8_LDA(At, 0, 0); PG8_STAGE_A(PG8_SA(1, 1), kx, X1);
            PG8_WAIT_V(8); PG8_WAIT_L(0); PG8_BAR; PG8_MMA(0, 0, At, B0); PG8_MMA(0, 1, At, B1); PG8_BAR; PG8_SCHED;
            PG8_LDA(At, 0, 1); PG8_STAGE(PG8_SB(0, 0), b2, voffB); PG8_STAGE(PG8_SB(0, 1), b2 + hstepB, voffB); PG8_STAGE_A(PG8_SA(0, 0), ky2, Y0);
            PG8_WAIT_V(8); PG8_WAIT_L(0); PG8_BAR; PG8_MMA(1, 0, At, B0); PG8_MMA(1, 1, At, B1); PG8_BAR; PG8_SCHED;
            PG8_LDB(B0, 1, 0); PG8_LDB(B1, 1, 1); PG8_SCHED; PG8_LDA(At, 1, 0); PG8_STAGE_A(PG8_SA(0, 1), ky2, Y1);
            PG8_WAIT_V(8); PG8_WAIT_L(0); PG8_BAR; PG8_MMA(0, 0, At, B0); PG8_MMA(0, 1, At, B1); PG8_BAR; PG8_SCHED;
            PG8_LDA(At, 1, 1); PG8_STAGE(PG8_SB(1, 0), b3, voffB); PG8_STAGE(PG8_SB(1, 1), b3 + hstepB, voffB); PG8_STAGE_A(PG8_SA(1, 0), ky3, Y0);
            PG8_WAIT_V(8); PG8_WAIT_L(0); PG8_BAR; PG8_MMA(1, 0, At, B0); PG8_MMA(1, 1, At, B1); PG8_BAR; PG8_SCHED;
        }
        if constexpr (ALIGN_EPI) { if (wr == 0) PG8_BAR; }
        if constexpr (FP8) {
            asm volatile("s_nop 15\n\ts_nop 15" ::: "memory");
#pragma unroll
            for (int a = 0; a < 2; ++a)
#pragma unroll
                for (int b = 0; b < 2; ++b) asm volatile("" : "+v"(acc[a][b][0][0]), "+v"(acc[a][b][0][1]), "+v"(acc[a][b][1][0]), "+v"(acc[a][b][1][1]), "+v"(acc[a][b][2][0]), "+v"(acc[a][b][2][1]), "+v"(acc[a][b][3][0]), "+v"(acc[a][b][3][1])); }
        E(acc, cur, wr, wc, fr, fq);
        if (!has_next) break;
#pragma unroll
        for (int a = 0; a < 2; ++a)
#pragma unroll
            for (int b = 0; b < 2; ++b)
#pragma unroll
                for (int m = 0; m < 4; ++m)
#pragma unroll
                    for (int n = 0; n < 2; ++n) acc[a][b][m][n] = (f32x4){0.f, 0.f, 0.f, 0.f};
        cur = nxt; bLo = nbLo; bHi = S.b_ptr(cur, 1); ++ui;
        if constexpr (ALIGN_EPI) { if (wr == 1) PG8_BAR; }
    }
    PG8_WAIT_V(0);
    if constexpr (!ALIGN_EPI) { if (wr == 0) PG8_BAR; }
    PG8_BAR;
#undef PG8_SA
#undef PG8_SB
#undef PG8_STAGE
#undef PG8_STAGE_A
#undef PG8_LDA
#undef PG8_LDB
#undef PG8_MMA
#undef PG8_WAIT_V
#undef PG8_WAIT_L
#undef PG8_BAR
#undef PG8_SCHED
#undef PG8_LOADSET
}
}
#include <hip/hip_bf16.h>
#include <cmath>
namespace attn_body {
using bf16=__hip_bfloat16;
using bf16x8=__attribute__((ext_vector_type(8)))short;
using s16x4=__attribute__((ext_vector_type(4)))short;
using f32x16=__attribute__((ext_vector_type(16)))float;
using u32x4=__attribute__((ext_vector_type(4)))unsigned;
constexpr int SEQ=4096,D=64,PQ=512,PO=1024;
constexpr int NW=8,QBLK=32,QB=QBLK*NW,KVBLK=64,NQB=SEQ/QB;
constexpr int ATTN_UNIT_ROWS=QB;
__device__ __forceinline__ int crow(int r,int hi){return (r&3)+8*(r>>2)+4*hi;}
#define SBAR() __builtin_amdgcn_sched_barrier(0)
__device__ __forceinline__ void cmask(f32x16&p0,f32x16&p1,int jb,int qrel,int hi){
  const float NEG=-INFINITY; int kb=64*jb+4*hi;
  #pragma unroll
  for(int r=0;r<16;++r){int kv=kb+(r&3)+8*(r>>2); if(kv>qrel)p0[r]=NEG; if(kv+32>qrel)p1[r]=NEG;}
}

constexpr int NSLOT=3, SLOTB=8192;
constexpr int LDS_K=0, LDS_V=NSLOT*SLOTB, LDS_WS=2*NSLOT*SLOTB, LDS_OST=LDS_WS+NW*64*4, LDS_BYTES=LDS_OST+NW*4096;
constexpr float C2=0.125f*1.4426950408889634f;
__device__ __forceinline__ void glds16(const void*gsrc,unsigned lds_dst){unsigned keep;
  asm volatile("s_mov_b32 %0, m0\n\ts_mov_b32 m0, %2\n\ts_nop 0\n\tglobal_load_lds_dwordx4 %1, off\n\ts_mov_b32 m0, %0":"=&s"(keep):"v"(gsrc),"s"(lds_dst):"memory");}
__device__ __forceinline__ float max3f(float a,float b,float c){float r;asm("v_max3_f32 %0, %1, %2, %3":"=v"(r):"v"(a),"v"(b),"v"(c));return r;}
__device__ __forceinline__ float max2f(float a,float b){float r;asm("v_max_f32_e32 %0, %1, %2":"=v"(r):"v"(a),"v"(b));return r;}
__device__ __forceinline__ float fadd_s(float a,float b){float r;asm("v_add_f32_e32 %0, %1, %2":"=v"(r):"v"(a),"v"(b));return r;}
__device__ __forceinline__ float fsub_s(float a,float b){float r;asm("v_sub_f32_e32 %0, %1, %2":"=v"(r):"v"(a),"v"(b));return r;}
typedef float f32x2_t __attribute__((ext_vector_type(2))); typedef __bf16 bf16x2_t __attribute__((ext_vector_type(2)));
__device__ __forceinline__ unsigned cvtpk_s(float lo,float hi){f32x2_t v={lo,hi};bf16x2_t b=__builtin_convertvector(v,bf16x2_t);return __builtin_bit_cast(unsigned,b);}
#define WAIT_BAR(N) asm volatile("s_waitcnt vmcnt(" #N ") lgkmcnt(0)\n\ts_barrier":::"memory")

__device__ __forceinline__ void qkt(f32x16&p0,f32x16&p1,const char*Kslot,const bf16x8*qr,const f32x16&negm,int r32,int hi){
  const char*kb=Kslot+hi*1024+r32*16;
  #pragma unroll
  for(int d0=0;d0<4;++d0){
    const bf16x8 b0=*reinterpret_cast<const bf16x8*>(kb+d0*2048);
    const bf16x8 b1=*reinterpret_cast<const bf16x8*>(kb+d0*2048+512);
    if(d0==0){p0=__builtin_amdgcn_mfma_f32_32x32x16_bf16(b0,qr[0],negm,0,0,0);p1=__builtin_amdgcn_mfma_f32_32x32x16_bf16(b1,qr[0],negm,0,0,0);}
    else{p0=__builtin_amdgcn_mfma_f32_32x32x16_bf16(b0,qr[d0],p0,0,0,0);p1=__builtin_amdgcn_mfma_f32_32x32x16_bf16(b1,qr[d0],p1,0,0,0);}}
}
typedef __attribute__((address_space(3))) const char* lds_cptr;
typedef short v4i16_t __attribute__((ext_vector_type(4)));
__device__ __forceinline__ void kload8(bf16x8*kf,lds_cptr kp){
  kf[0]=*(const __attribute__((address_space(3))) bf16x8*)(kp);      kf[1]=*(const __attribute__((address_space(3))) bf16x8*)(kp+512);
  kf[2]=*(const __attribute__((address_space(3))) bf16x8*)(kp+2048); kf[3]=*(const __attribute__((address_space(3))) bf16x8*)(kp+2560);
  kf[4]=*(const __attribute__((address_space(3))) bf16x8*)(kp+4096); kf[5]=*(const __attribute__((address_space(3))) bf16x8*)(kp+4608);
  kf[6]=*(const __attribute__((address_space(3))) bf16x8*)(kp+6144); kf[7]=*(const __attribute__((address_space(3))) bf16x8*)(kp+6656);
}
__device__ __forceinline__ void kload2(bf16x8*kf,lds_cptr kp,int j){ kf[2*j]=*(const __attribute__((address_space(3))) bf16x8*)(kp+j*2048); kf[2*j+1]=*(const __attribute__((address_space(3))) bf16x8*)(kp+j*2048+512); }
__device__ __forceinline__ s16x4 vtr(lds_cptr p){ return __builtin_bit_cast(s16x4,__builtin_amdgcn_ds_read_tr16_b64_v4i16((__attribute__((address_space(3))) v4i16_t*)p)); }
__device__ __forceinline__ float rowmax(const f32x16&p0,const f32x16&p1){
  float a=max3f(p0[0],p0[1],p1[0]),b=max3f(p0[2],p0[3],p1[1]);a=max3f(a,p1[2],p1[3]);
  #pragma unroll
  for(int r=4;r<16;r+=4){a=max3f(a,p0[r],p0[r+1]);b=max3f(b,p0[r+2],p0[r+3]);a=max3f(a,p1[r],p1[r+1]);b=max3f(b,p1[r+2],p1[r+3]);}
  const float m=max2f(a,b);
  auto rr=__builtin_amdgcn_permlane32_swap(__float_as_uint(m),__float_as_uint(m),false,false);
  return max2f(__uint_as_float(rr[0]),__uint_as_float(rr[1]));
}
__device__ __forceinline__ void pv(f32x16*o,int vb,bf16x8 pa0,bf16x8 pa1,bf16x8 pa2,bf16x8 pa3){
  #pragma unroll
  for(int d0=0;d0<2;++d0){s16x4 lo[4],hi[4];
    #pragma unroll
    for(int ks=0;ks<4;++ks){
      asm volatile("ds_read_b64_tr_b16 %0,%1 offset:%c2":"=&v"(lo[ks]):"v"(vb),"i"(d0*4096+ks*1024):"memory");
      asm volatile("ds_read_b64_tr_b16 %0,%1 offset:%c2":"=&v"(hi[ks]):"v"(vb),"i"(d0*4096+ks*1024+512):"memory");}
    asm volatile("s_waitcnt lgkmcnt(0)":::"memory");SBAR();
    #define PK(k) (bf16x8){lo[k][0],lo[k][1],lo[k][2],lo[k][3],hi[k][0],hi[k][1],hi[k][2],hi[k][3]}
    o[d0]=__builtin_amdgcn_mfma_f32_32x32x16_bf16(pa0,PK(0),o[d0],0,0,0);
    o[d0]=__builtin_amdgcn_mfma_f32_32x32x16_bf16(pa1,PK(1),o[d0],0,0,0);
    o[d0]=__builtin_amdgcn_mfma_f32_32x32x16_bf16(pa2,PK(2),o[d0],0,0,0);
    o[d0]=__builtin_amdgcn_mfma_f32_32x32x16_bf16(pa3,PK(3),o[d0],0,0,0);
    #undef PK
  }
}

template<int THRL> __device__ __forceinline__ void attn_unit(long rowbase,int qb,const bf16*Qc,const bf16*__restrict__ Kc,const bf16*__restrict__ Vc,bf16*Oc,char*shm,const int tid0){
  int tid_=tid0; asm volatile("":"+v"(tid_)); const int tid=tid_,lane=tid&63,r32=lane&31,hi=lane>>5; const int wid=__builtin_amdgcn_readfirstlane(tid>>6);
  const int q0=qb*QB;
  const bf16*Qw=Qc+(rowbase+q0+wid*QBLK)*PQ;
  const bf16*Kh=Kc+rowbase*PQ,*Vh=Vc+rowbase*PQ;
  const unsigned lds0=(unsigned)(uintptr_t)shm;
  float*wsf=(float*)(shm+LDS_WS)+wid*64;
  const bf16*ksrc=Kh+(long)lane*PQ+wid*8;
  const bf16*vsrc=Vh+(long)(16*(wid&3)+(lane>>2))*PQ+(wid>>2)*32+(lane&3)*8;
  const unsigned kdst=lds0+LDS_K+wid*1024, vdst=lds0+LDS_V+wid*1024;
  #define DMA_K(t,slot) glds16(ksrc+(long)(t)*KVBLK*PQ,(unsigned)__builtin_amdgcn_readfirstlane(kdst+(slot)))
  #define DMA_V(t,slot) glds16(vsrc+(long)(t)*KVBLK*PQ,(unsigned)__builtin_amdgcn_readfirstlane(vdst+(slot)))
  const int vb0=(int)(lds0+LDS_V)+((lane>>4)&1)*32+(lane&3)*8+(4*hi+((lane&15)>>2))*64;
  const char*Kbase=shm+LDS_K; bf16x8 kf[8];
  const lds_cptr shm3=(lds_cptr)shm; const lds_cptr kp0=shm3+LDS_K+hi*1024+r32*16; const lds_cptr vp0=shm3+LDS_V+((lane>>4)&1)*32+(lane&3)*8+(4*hi+((lane&15)>>2))*64;
  const int NT=(q0+QB)/KVBLK;
  DMA_K(0,0);DMA_V(0,0);DMA_K(1,SLOTB);
  bf16x8 qr[4];
  #pragma unroll
  for(int d0=0;d0<4;++d0)qr[d0]=*reinterpret_cast<const bf16x8*>(&Qw[(long)r32*PQ+d0*16+hi*8]);
  float mhat=0.f,l_reg=0.f;float zsrc=0.f;asm volatile("":"+v"(zsrc));
  f32x16 o[2],negm;
  #pragma unroll
  for(int r=0;r<16;++r){o[0][r]=zsrc;o[1][r]=zsrc;negm[r]=zsrc;}
  asm volatile("":"+v"(negm));
  const int qrel=wid*QBLK+r32;
  #define CMASK(P0,P1,t) do{int jb_=(t)-(NT-4); if(jb_>=0)cmask(P0,P1,jb_,qrel,hi);}while(0)
  bool resc=false;
  #define START(P0,P1) do{ const float rm=rowmax(P0,P1); resc=false; \
    { const float dl=rm; mhat=fadd_s(mhat,dl); \
      _Pragma("unroll") for(int r=0;r<16;++r){P0[r]=fsub_s(P0[r],dl);P1[r]=fsub_s(P1[r],dl);} \
      _Pragma("unroll") for(int r=0;r<16;++r)negm[r]=-mhat; asm volatile("":"+v"(negm)); } \
    _Pragma("unroll") for(int r=0;r<16;++r)P0[r]=__builtin_amdgcn_exp2f(P0[r]); }while(0)
  #define RESC() do{ if(resc){ asm volatile("s_waitcnt lgkmcnt(0)":::"memory"); \
      _Pragma("unroll") for(int d_=0;d_<2;++d_) _Pragma("unroll") for(int r=0;r<16;++r)o[d_][r]*=wsf[crow(r,hi)]; } }while(0)
  f32x16 pA0,pA1,pB0,pB1;
  int sl_prev=0,sl_cur=0,sl_next=SLOTB;
  #define ROT() do{sl_prev=sl_cur;sl_cur=sl_next;sl_next=(sl_next==(NSLOT-1)*SLOTB)?0:sl_next+SLOTB;}while(0)
  DMA_K(2,2*SLOTB);
  WAIT_BAR(3);
  qkt(pA0,pA1,Kbase,qr,negm,r32,hi);asm volatile("s_nop 15\n\ts_nop 7":"+v"(pA0),"+v"(pA1));CMASK(pA0,pA1,0);
  START(pA0,pA1);
  _Pragma("unroll") for(int r=0;r<16;++r)pA1[r]=__builtin_amdgcn_exp2f(pA1[r]);
  WAIT_BAR(0);
  DMA_K(3,0);DMA_V(1,SLOTB);
  ROT();
  kload8(kf,kp0+sl_cur);
  WAIT_BAR(2);
  s16x4 vlo[8],vhi[8]; u32x4 pw0,pw1,pw2,pw3;
  #define PKW(P,B) cvtpk_s(P[B],P[B+1])
  #define PAF(k) __builtin_bit_cast(bf16x8,pw##k)
  #define VFR(i) (bf16x8){vlo[i][0],vlo[i][1],vlo[i][2],vlo[i][3],vhi[i][0],vhi[i][1],vhi[i][2],vhi[i][3]}
  #define PIN(x) asm volatile("":"+v"(x))
  #define MX3(a,b,c) __builtin_fmaxf(__builtin_fmaxf((a),(b)),(c))
  #define GAPA(MF,A0,A1,A2,A3,W0,W1,PW) do{ MF; sacc+=A0; sacc+=A1; sacc+=A2; sacc+=A3; PIN(sacc); W0; W1; PIN(PW); SBAR(); }while(0)
  #define EX(v) __builtin_amdgcn_exp2f(v)
  #define GAPB(MF,X,B) do{ MF; X[B]=EX(X[B]); X[B+1]=EX(X[B+1]); X[B+2]=EX(X[B+2]); X[B+3]=EX(X[B+3]); PIN(X); SBAR(); }while(0)
  #define VRD(i) do{ vlo[i]=vtr(vp_+(((i)>>2)*4096+((i)&3)*1024)); vhi[i]=vtr(vp_+(((i)>>2)*4096+((i)&3)*1024+512)); }while(0)
  #define KRD(G,j) do{ if(G){ kload2(kf,kp0+sl_next,j); SBAR(); } }while(0)
  #define STEP(C0,C1,P0,P1,t,GK,GV,GL) do{ SBAR(); \
    const lds_cptr vp_=vp0+sl_prev; \
    VRD(0); SBAR(); float sacc=(P0[0]+P0[1]); \
    GAPA(C0=__builtin_amdgcn_mfma_f32_32x32x16_bf16(kf[0],qr[0],negm,0,0,0), P0[2],P0[3],P0[4],P0[5],     pw0[0]=PKW(P0,0), pw0[1]=PKW(P0,2), pw0); \
    VRD(4); SBAR(); GAPA(C1=__builtin_amdgcn_mfma_f32_32x32x16_bf16(kf[1],qr[0],negm,0,0,0), P0[6],P0[7],P0[8],P0[9],     pw0[2]=PKW(P0,4), pw0[3]=PKW(P0,6), pw0); \
    VRD(1); SBAR(); GAPA(C0=__builtin_amdgcn_mfma_f32_32x32x16_bf16(kf[2],qr[1],C0,0,0,0),   P0[10],P0[11],P0[12],P0[13], pw1[0]=PKW(P0,8), pw1[1]=PKW(P0,10), pw1); \
    VRD(5); SBAR(); GAPA(C1=__builtin_amdgcn_mfma_f32_32x32x16_bf16(kf[3],qr[1],C1,0,0,0),   P0[14],P0[15],P1[0],P1[1],   pw1[2]=PKW(P0,12),pw1[3]=PKW(P0,14), pw1); \
    VRD(2); SBAR(); GAPA(C0=__builtin_amdgcn_mfma_f32_32x32x16_bf16(kf[4],qr[2],C0,0,0,0),   P1[2],P1[3],P1[4],P1[5],     pw2[0]=PKW(P1,0), pw2[1]=PKW(P1,2), pw2); \
    VRD(6); SBAR(); GAPA(C1=__builtin_amdgcn_mfma_f32_32x32x16_bf16(kf[5],qr[2],C1,0,0,0),   P1[6],P1[7],P1[8],P1[9],     pw2[2]=PKW(P1,4), pw2[3]=PKW(P1,6), pw2); \
    VRD(3); SBAR(); GAPA(C0=__builtin_amdgcn_mfma_f32_32x32x16_bf16(kf[6],qr[3],C0,0,0,0),   P1[10],P1[11],P1[12],P1[13], pw3[0]=PKW(P1,8), pw3[1]=PKW(P1,10), pw3); \
    VRD(7); SBAR(); GAPA(C1=__builtin_amdgcn_mfma_f32_32x32x16_bf16(kf[7],qr[3],C1,0,0,0),   P1[14],P1[15],0.f,0.f,       pw3[2]=PKW(P1,12),pw3[3]=PKW(P1,14), pw3); \
    l_reg+=sacc; \
    if(GK){DMA_K((t)+3,sl_cur);} if(GV){DMA_V((t)+1,sl_next);} \
    CMASK(C0,C1,t); \
    { float a=MX3(C0[0],C0[1],C1[0]),b=MX3(C0[2],C0[3],C1[1]); a=MX3(a,C1[2],C1[3]); \
      _Pragma("unroll") for(int r=4;r<16;r+=4){a=MX3(a,C0[r],C0[r+1]);b=MX3(b,C0[r+2],C0[r+3]);a=MX3(a,C1[r],C1[r+1]);b=MX3(b,C1[r+2],C1[r+3]);} \
      float rm=__builtin_fmaxf(a,b); { auto rr=__builtin_amdgcn_permlane32_swap(__float_as_uint(rm),__float_as_uint(rm),false,false); rm=__builtin_fmaxf(__uint_as_float(rr[0]),__uint_as_float(rr[1])); } \
      resc=false; \
      if(__builtin_expect(__any(rm>(float)THRL),0)){ const float dl=__builtin_fmaxf(rm,0.f); mhat+=dl; \
        _Pragma("unroll") for(int r=0;r<16;++r){C0[r]-=dl;C1[r]-=dl;} \
        _Pragma("unroll") for(int r=0;r<16;++r)negm[r]=-mhat; asm volatile("":"+v"(negm)); \
        const float f=__builtin_amdgcn_exp2f(-dl); l_reg*=f; if(hi==0)wsf[r32]=f; resc=true; } } \
    SBAR(); \
    GAPB(o[0]=__builtin_amdgcn_mfma_f32_32x32x16_bf16(PAF(0),VFR(0),o[0],0,0,0), C0,0); \
    GAPB(o[1]=__builtin_amdgcn_mfma_f32_32x32x16_bf16(PAF(0),VFR(4),o[1],0,0,0), C0,4); \
    KRD(GL,0); GAPB(o[0]=__builtin_amdgcn_mfma_f32_32x32x16_bf16(PAF(1),VFR(1),o[0],0,0,0), C0,8); \
    KRD(GL,1); GAPB(o[1]=__builtin_amdgcn_mfma_f32_32x32x16_bf16(PAF(1),VFR(5),o[1],0,0,0), C0,12); \
    KRD(GL,2); GAPB(o[0]=__builtin_amdgcn_mfma_f32_32x32x16_bf16(PAF(2),VFR(2),o[0],0,0,0), C1,0); \
    KRD(GL,3); GAPB(o[1]=__builtin_amdgcn_mfma_f32_32x32x16_bf16(PAF(2),VFR(6),o[1],0,0,0), C1,4); \
    GAPB(o[0]=__builtin_amdgcn_mfma_f32_32x32x16_bf16(PAF(3),VFR(3),o[0],0,0,0), C1,8); \
    GAPB(o[1]=__builtin_amdgcn_mfma_f32_32x32x16_bf16(PAF(3),VFR(7),o[1],0,0,0), C1,12); \
    }while(0)
  int t=1;
  #undef CMASK
  #define CMASK(P0,P1,t) do{}while(0)
  for(;t+5<NT;t+=2){
    STEP(pB0,pB1,pA0,pA1,t,true,true,true);     WAIT_BAR(2); RESC(); ROT();
    STEP(pA0,pA1,pB0,pB1,t+1,true,true,true);   WAIT_BAR(2); RESC(); ROT();
  }
  #undef CMASK
  #define CMASK(P0,P1,t) do{int jb_=(t)-(NT-4); if(jb_>=0)cmask(P0,P1,jb_,qrel,hi);}while(0)
  #define ENDW(tt) do{ if((tt)+3<NT){WAIT_BAR(2);} else if((tt)+2<NT){WAIT_BAR(1);} else {WAIT_BAR(0);} }while(0)
  for(;t+1<NT;t+=2){
    STEP(pB0,pB1,pA0,pA1,t,(t+3<NT),(t+1<NT),(t+1<NT));       ENDW(t);   RESC(); ROT();
    STEP(pA0,pA1,pB0,pB1,t+1,(t+4<NT),(t+2<NT),(t+2<NT));     ENDW(t+1); RESC(); ROT();
  }
  STEP(pB0,pB1,pA0,pA1,NT-1,false,false,false); RESC();
  { float sacc=pB0[0]+pB0[1]; _Pragma("unroll") for(int r=2;r<16;++r)sacc+=pB0[r]; _Pragma("unroll") for(int r=0;r<16;++r)sacc+=pB1[r]; l_reg+=sacc;
    pw0=(u32x4){PKW(pB0,0),PKW(pB0,2),PKW(pB0,4),PKW(pB0,6)};pw1=(u32x4){PKW(pB0,8),PKW(pB0,10),PKW(pB0,12),PKW(pB0,14)};pw2=(u32x4){PKW(pB1,0),PKW(pB1,2),PKW(pB1,4),PKW(pB1,6)};pw3=(u32x4){PKW(pB1,8),PKW(pB1,10),PKW(pB1,12),PKW(pB1,14)};
    SBAR(); pv(o,vb0+sl_cur,PAF(0),PAF(1),PAF(2),PAF(3)); }
  #undef PKW
  #undef PAF
  #undef VFR
  #undef PIN
  #undef MX3
  #undef GAPA
  #undef GAPB
  #undef EX
  #undef VRD
  #undef KRD
  #undef STEP
  #undef ENDW
  {auto rr=__builtin_amdgcn_permlane32_swap(__float_as_uint(l_reg),__float_as_uint(l_reg),false,false);l_reg=__uint_as_float(rr[0])+__uint_as_float(rr[1]);}
  if(hi==0)wsf[32+r32]=l_reg;asm volatile("s_waitcnt lgkmcnt(0)":::"memory");
  float rli[16];
  #pragma unroll
  for(int r=0;r<16;++r)rli[r]=__builtin_amdgcn_rcpf(wsf[32+crow(r,hi)]);
  bf16*Ow=Oc+(rowbase+q0+wid*QBLK)*PO;
  { bf16*stg=(bf16*)(shm+LDS_OST)+wid*2048;
    #pragma unroll
    for(int r=0;r<16;++r){const int orow=crow(r,hi);
      #pragma unroll
      for(int d0=0;d0<2;++d0)stg[orow*64+d0*32+r32]=__float2bfloat16(o[d0][r]*rli[r]);}
    asm volatile("s_waitcnt lgkmcnt(0)":::"memory");
    #pragma unroll
    for(int i=0;i<4;++i){const int row=i*8+(lane>>3),ch=lane&7; const u32x4 v=*(const u32x4*)(stg+row*64+ch*8); ATTN_STORE16(Ow+(long)row*PO+ch*8,v);} }
  asm volatile("s_waitcnt lgkmcnt(0)\n\ts_barrier":::"memory");
  #undef DMA_K
  #undef DMA_V
  #undef CMASK
  #undef START
  #undef RESC
  #undef ROT
}
__device__ __forceinline__ void pv128(f32x16*o,int vb,bf16x8 pa0,bf16x8 pa1,bf16x8 pa2,bf16x8 pa3){
  #pragma unroll
  for(int d0=0;d0<4;++d0){s16x4 lo[4],hi[4];
    #pragma unroll
    for(int ks=0;ks<4;++ks){
      asm volatile("ds_read_b64_tr_b16 %0,%1 offset:%c2":"=&v"(lo[ks]):"v"(vb),"i"(d0*4096+ks*1024):"memory");
      asm volatile("ds_read_b64_tr_b16 %0,%1 offset:%c2":"=&v"(hi[ks]):"v"(vb),"i"(d0*4096+ks*1024+512):"memory");}
    asm volatile("s_waitcnt lgkmcnt(0)":::"memory");SBAR();
    #define PK(k) (bf16x8){lo[k][0],lo[k][1],lo[k][2],lo[k][3],hi[k][0],hi[k][1],hi[k][2],hi[k][3]}
    o[d0]=__builtin_amdgcn_mfma_f32_32x32x16_bf16(pa0,PK(0),o[d0],0,0,0);
    o[d0]=__builtin_amdgcn_mfma_f32_32x32x16_bf16(pa1,PK(1),o[d0],0,0,0);
    o[d0]=__builtin_amdgcn_mfma_f32_32x32x16_bf16(pa2,PK(2),o[d0],0,0,0);
    o[d0]=__builtin_amdgcn_mfma_f32_32x32x16_bf16(pa3,PK(3),o[d0],0,0,0);
    #undef PK
  }
}
constexpr int SLOTBV=16384, LDS_V2=NSLOT*SLOTB, LDS_WS2=LDS_V2+NSLOT*SLOTBV, LDS_OST2=LDS_WS2+NW*64*4, LDS_BYTES2=LDS_OST2+NW*4096;
template<int THRL> __device__ __forceinline__ void attn_unit128(long rowbase,int qb,const bf16*Qc,const bf16*__restrict__ Kc,const bf16*__restrict__ Vc,bf16*Oc,char*shm,const int tid0){
  int tid_=tid0; asm volatile("":"+v"(tid_)); const int tid=tid_,lane=tid&63,r32=lane&31,hi=lane>>5; const int wid=__builtin_amdgcn_readfirstlane(tid>>6);
  const int q0=qb*QB;
  const bf16*Qw=Qc+(rowbase+q0+wid*QBLK)*PQ;
  const bf16*Kh=Kc+rowbase*PQ,*Vh=Vc+rowbase*PQ;
  const unsigned lds0=(unsigned)(uintptr_t)shm;
  float*wsf=(float*)(shm+LDS_WS2)+wid*64;
  const bf16*ksrc=Kh+(long)lane*PQ+wid*8;
  const bf16*vsrc=Vh+(long)(16*(wid&3)+(lane>>2))*PQ+(wid>>2)*32+(lane&3)*8;
  const unsigned kdst=lds0+LDS_K+wid*1024, vdst=lds0+LDS_V2+wid*1024;
  #define DMA_K(t,slot) glds16(ksrc+(long)(t)*KVBLK*PQ,(unsigned)__builtin_amdgcn_readfirstlane(kdst+(slot)))
  #define DMA_V(t,slot) do{ glds16(vsrc+(long)(t)*KVBLK*PQ,(unsigned)__builtin_amdgcn_readfirstlane(vdst+2*(slot))); glds16(vsrc+64+(long)(t)*KVBLK*PQ,(unsigned)__builtin_amdgcn_readfirstlane(vdst+8192+2*(slot))); }while(0)
  const char*Kbase=shm+LDS_K; bf16x8 kf[8];
  const lds_cptr shm3=(lds_cptr)shm; const lds_cptr kp0=shm3+LDS_K+hi*1024+r32*16; const lds_cptr vp0=shm3+LDS_V2+((lane>>4)&1)*32+(lane&3)*8+(4*hi+((lane&15)>>2))*64;
  const int NT=(q0+QB)/KVBLK;
  DMA_K(0,0);DMA_V(0,0);DMA_K(1,SLOTB);
  bf16x8 qr[4];
  #pragma unroll
  for(int d0=0;d0<4;++d0)qr[d0]=*reinterpret_cast<const bf16x8*>(&Qw[(long)r32*PQ+d0*16+hi*8]);
  float mhat=0.f,l_reg=0.f;float zsrc=0.f;asm volatile("":"+v"(zsrc));
  f32x16 o[4],negm;
  #pragma unroll
  for(int r=0;r<16;++r){o[0][r]=zsrc;o[1][r]=zsrc;o[2][r]=zsrc;o[3][r]=zsrc;negm[r]=zsrc;}
  asm volatile("":"+v"(negm));
  #define CMASK(P0,P1,t) do{int jb_=(t)-(NT-4); if(jb_>=0)cmask(P0,P1,jb_,wid*QBLK+r32,hi);}while(0)
  bool resc=false;
  #define START(P0,P1) do{ const float rm=rowmax(P0,P1); resc=false; \
    { const float dl=rm; mhat=fadd_s(mhat,dl); \
      _Pragma("unroll") for(int r=0;r<16;++r){P0[r]=fsub_s(P0[r],dl);P1[r]=fsub_s(P1[r],dl);} \
      _Pragma("unroll") for(int r=0;r<16;++r)negm[r]=-mhat; asm volatile("":"+v"(negm)); } \
    _Pragma("unroll") for(int r=0;r<16;++r)P0[r]=__builtin_amdgcn_exp2f(P0[r]); }while(0)
  #define RESC() do{ if(resc){ asm volatile("s_waitcnt lgkmcnt(0)":::"memory"); \
      _Pragma("unroll") for(int d_=0;d_<4;++d_) _Pragma("unroll") for(int r=0;r<16;++r)o[d_][r]*=wsf[crow(r,hi)]; } }while(0)
  f32x16 pA0,pA1,pB0,pB1;
  int sl_prev=0,sl_cur=0,sl_next=SLOTB;
  #define ROT() do{sl_prev=sl_cur;sl_cur=sl_next;sl_next=(sl_next==(NSLOT-1)*SLOTB)?0:sl_next+SLOTB;}while(0)
  DMA_K(2,2*SLOTB);
  WAIT_BAR(3);
  qkt(pA0,pA1,Kbase,qr,negm,r32,hi);asm volatile("s_nop 15\n\ts_nop 7":"+v"(pA0),"+v"(pA1));CMASK(pA0,pA1,0);
  START(pA0,pA1);
  _Pragma("unroll") for(int r=0;r<16;++r)pA1[r]=__builtin_amdgcn_exp2f(pA1[r]);
  WAIT_BAR(0);
  DMA_K(3,0);DMA_V(1,SLOTB);
  ROT();
  kload8(kf,kp0+sl_cur);
  WAIT_BAR(3);
  s16x4 vlo[8],vhi[8]; u32x4 pw0,pw1,pw2,pw3;
  #define PKW(P,B) cvtpk_s(P[B],P[B+1])
  #define PAF(k) __builtin_bit_cast(bf16x8,pw##k)
  #define VFR(i) (bf16x8){vlo[i][0],vlo[i][1],vlo[i][2],vlo[i][3],vhi[i][0],vhi[i][1],vhi[i][2],vhi[i][3]}
  #define PIN(x) asm volatile("":"+v"(x))
  #define MX3(a,b,c) __builtin_fmaxf(__builtin_fmaxf((a),(b)),(c))
  #define GAPA(MF,A0,A1,A2,A3,W0,W1,PW) do{ MF; sacc+=A0; sacc+=A1; sacc+=A2; sacc+=A3; PIN(sacc); W0; W1; PIN(PW); SBAR(); }while(0)
  #define EX(v) __builtin_amdgcn_exp2f(v)
  #define GAPB(MF,X,B) do{ MF; X[B]=EX(X[B]); X[B+1]=EX(X[B+1]); X[B+2]=EX(X[B+2]); X[B+3]=EX(X[B+3]); PIN(X); SBAR(); }while(0)
  #define GAPB2(MF,X,B) do{ MF; X[B]=EX(X[B]); X[B+1]=EX(X[B+1]); PIN(X); SBAR(); }while(0)
  #define VRD2(i) do{ vlo[i]=vtr(vp_+((((i)>>2)+2)*4096+((i)&3)*1024)); vhi[i]=vtr(vp_+((((i)>>2)+2)*4096+((i)&3)*1024+512)); }while(0)
  #define VRD(i) do{ vlo[i]=vtr(vp_+(((i)>>2)*4096+((i)&3)*1024)); vhi[i]=vtr(vp_+(((i)>>2)*4096+((i)&3)*1024+512)); }while(0)
  #define KRD(G,j) do{ if(G){ kload2(kf,kp0+sl_next,j); SBAR(); } }while(0)
  #define STEP(C0,C1,P0,P1,t,GK,GV,GL) do{ SBAR(); \
    const lds_cptr vp_=vp0+2*sl_prev; \
    VRD(0); SBAR(); float sacc=(P0[0]+P0[1]); \
    GAPA(C0=__builtin_amdgcn_mfma_f32_32x32x16_bf16(kf[0],qr[0],negm,0,0,0), P0[2],P0[3],P0[4],P0[5],     pw0[0]=PKW(P0,0), pw0[1]=PKW(P0,2), pw0); \
    VRD(4); SBAR(); GAPA(C1=__builtin_amdgcn_mfma_f32_32x32x16_bf16(kf[1],qr[0],negm,0,0,0), P0[6],P0[7],P0[8],P0[9],     pw0[2]=PKW(P0,4), pw0[3]=PKW(P0,6), pw0); \
    VRD(1); SBAR(); GAPA(C0=__builtin_amdgcn_mfma_f32_32x32x16_bf16(kf[2],qr[1],C0,0,0,0),   P0[10],P0[11],P0[12],P0[13], pw1[0]=PKW(P0,8), pw1[1]=PKW(P0,10), pw1); \
    VRD(5); SBAR(); GAPA(C1=__builtin_amdgcn_mfma_f32_32x32x16_bf16(kf[3],qr[1],C1,0,0,0),   P0[14],P0[15],P1[0],P1[1],   pw1[2]=PKW(P0,12),pw1[3]=PKW(P0,14), pw1); \
    VRD(2); SBAR(); GAPA(C0=__builtin_amdgcn_mfma_f32_32x32x16_bf16(kf[4],qr[2],C0,0,0,0),   P1[2],P1[3],P1[4],P1[5],     pw2[0]=PKW(P1,0), pw2[1]=PKW(P1,2), pw2); \
    VRD(6); SBAR(); GAPA(C1=__builtin_amdgcn_mfma_f32_32x32x16_bf16(kf[5],qr[2],C1,0,0,0),   P1[6],P1[7],P1[8],P1[9],     pw2[2]=PKW(P1,4), pw2[3]=PKW(P1,6), pw2); \
    VRD(3); SBAR(); GAPA(C0=__builtin_amdgcn_mfma_f32_32x32x16_bf16(kf[6],qr[3],C0,0,0,0),   P1[10],P1[11],P1[12],P1[13], pw3[0]=PKW(P1,8), pw3[1]=PKW(P1,10), pw3); \
    VRD(7); SBAR(); GAPA(C1=__builtin_amdgcn_mfma_f32_32x32x16_bf16(kf[7],qr[3],C1,0,0,0),   P1[14],P1[15],0.f,0.f,       pw3[2]=PKW(P1,12),pw3[3]=PKW(P1,14), pw3); \
    l_reg+=sacc; \
    if(GK){DMA_K((t)+3,sl_cur);} if(GV){DMA_V((t)+1,sl_next);} \
    CMASK(C0,C1,t); \
    { float a=MX3(C0[0],C0[1],C1[0]),b=MX3(C0[2],C0[3],C1[1]); a=MX3(a,C1[2],C1[3]); \
      _Pragma("unroll") for(int r=4;r<16;r+=4){a=MX3(a,C0[r],C0[r+1]);b=MX3(b,C0[r+2],C0[r+3]);a=MX3(a,C1[r],C1[r+1]);b=MX3(b,C1[r+2],C1[r+3]);} \
      float rm=__builtin_fmaxf(a,b); { auto rr=__builtin_amdgcn_permlane32_swap(__float_as_uint(rm),__float_as_uint(rm),false,false); rm=__builtin_fmaxf(__uint_as_float(rr[0]),__uint_as_float(rr[1])); } \
      resc=false; \
      if(__builtin_expect(__any(rm>(float)THRL),0)){ const float dl=__builtin_fmaxf(rm,0.f); mhat+=dl; \
        _Pragma("unroll") for(int r=0;r<16;++r){C0[r]-=dl;C1[r]-=dl;} \
        _Pragma("unroll") for(int r=0;r<16;++r)negm[r]=-mhat; asm volatile("":"+v"(negm)); \
        const float f=__builtin_amdgcn_exp2f(-dl); l_reg*=f; if(hi==0)wsf[r32]=f; resc=true; } } \
    SBAR(); \
    GAPB2(o[0]=__builtin_amdgcn_mfma_f32_32x32x16_bf16(PAF(0),VFR(0),o[0],0,0,0), C0,0); VRD2(0); SBAR(); \
    GAPB2(o[1]=__builtin_amdgcn_mfma_f32_32x32x16_bf16(PAF(0),VFR(4),o[1],0,0,0), C0,2); VRD2(4); SBAR(); \
    KRD(GL,0); GAPB2(o[0]=__builtin_amdgcn_mfma_f32_32x32x16_bf16(PAF(1),VFR(1),o[0],0,0,0), C0,4); VRD2(1); SBAR(); \
    KRD(GL,1); GAPB2(o[1]=__builtin_amdgcn_mfma_f32_32x32x16_bf16(PAF(1),VFR(5),o[1],0,0,0), C0,6); VRD2(5); SBAR(); \
    KRD(GL,2); GAPB2(o[0]=__builtin_amdgcn_mfma_f32_32x32x16_bf16(PAF(2),VFR(2),o[0],0,0,0), C0,8); VRD2(2); SBAR(); \
    KRD(GL,3); GAPB2(o[1]=__builtin_amdgcn_mfma_f32_32x32x16_bf16(PAF(2),VFR(6),o[1],0,0,0), C0,10); VRD2(6); SBAR(); \
    GAPB2(o[0]=__builtin_amdgcn_mfma_f32_32x32x16_bf16(PAF(3),VFR(3),o[0],0,0,0), C0,12); VRD2(3); SBAR(); \
    GAPB2(o[1]=__builtin_amdgcn_mfma_f32_32x32x16_bf16(PAF(3),VFR(7),o[1],0,0,0), C0,14); VRD2(7); SBAR(); \
    GAPB2(o[2]=__builtin_amdgcn_mfma_f32_32x32x16_bf16(PAF(0),VFR(0),o[2],0,0,0), C1,0); \
    GAPB2(o[3]=__builtin_amdgcn_mfma_f32_32x32x16_bf16(PAF(0),VFR(4),o[3],0,0,0), C1,2); \
    GAPB2(o[2]=__builtin_amdgcn_mfma_f32_32x32x16_bf16(PAF(1),VFR(1),o[2],0,0,0), C1,4); \
    GAPB2(o[3]=__builtin_amdgcn_mfma_f32_32x32x16_bf16(PAF(1),VFR(5),o[3],0,0,0), C1,6); \
    GAPB2(o[2]=__builtin_amdgcn_mfma_f32_32x32x16_bf16(PAF(2),VFR(2),o[2],0,0,0), C1,8); \
    GAPB2(o[3]=__builtin_amdgcn_mfma_f32_32x32x16_bf16(PAF(2),VFR(6),o[3],0,0,0), C1,10); \
    GAPB2(o[2]=__builtin_amdgcn_mfma_f32_32x32x16_bf16(PAF(3),VFR(3),o[2],0,0,0), C1,12); \
    GAPB2(o[3]=__builtin_amdgcn_mfma_f32_32x32x16_bf16(PAF(3),VFR(7),o[3],0,0,0), C1,14); \
    }while(0)
  int t=1;
  #undef CMASK
  #define CMASK(P0,P1,t) do{}while(0)
  for(;t+5<NT;t+=2){
    STEP(pB0,pB1,pA0,pA1,t,true,true,true);     WAIT_BAR(3); RESC(); ROT();
    STEP(pA0,pA1,pB0,pB1,t+1,true,true,true);   WAIT_BAR(3); RESC(); ROT();
  }
  #undef CMASK
  #define CMASK(P0,P1,t) do{int jb_=(t)-(NT-4); if(jb_>=0)cmask(P0,P1,jb_,wid*QBLK+r32,hi);}while(0)
  #define ENDW(tt) do{ if((tt)+3<NT){WAIT_BAR(3);} else if((tt)+2<NT){WAIT_BAR(2);} else {WAIT_BAR(0);} }while(0)
  for(;t+1<NT;t+=2){
    STEP(pB0,pB1,pA0,pA1,t,(t+3<NT),(t+1<NT),(t+1<NT));       ENDW(t);   RESC(); ROT();
    STEP(pA0,pA1,pB0,pB1,t+1,(t+4<NT),(t+2<NT),(t+2<NT));     ENDW(t+1); RESC(); ROT();
  }
  STEP(pB0,pB1,pA0,pA1,NT-1,false,false,false); RESC();
  { float sacc=pB0[0]+pB0[1]; _Pragma("unroll") for(int r=2;r<16;++r)sacc+=pB0[r]; _Pragma("unroll") for(int r=0;r<16;++r)sacc+=pB1[r]; l_reg+=sacc;
    pw0=(u32x4){PKW(pB0,0),PKW(pB0,2),PKW(pB0,4),PKW(pB0,6)};pw1=(u32x4){PKW(pB0,8),PKW(pB0,10),PKW(pB0,12),PKW(pB0,14)};pw2=(u32x4){PKW(pB1,0),PKW(pB1,2),PKW(pB1,4),PKW(pB1,6)};pw3=(u32x4){PKW(pB1,8),PKW(pB1,10),PKW(pB1,12),PKW(pB1,14)};
    SBAR(); const int vb0=(int)(lds0+LDS_V2)+((lane>>4)&1)*32+(lane&3)*8+(4*hi+((lane&15)>>2))*64; pv128(o,vb0+2*sl_cur,PAF(0),PAF(1),PAF(2),PAF(3)); }
  #undef PKW
  #undef PAF
  #undef VFR
  #undef PIN
  #undef MX3
  #undef GAPA
  #undef GAPB
  #undef GAPB2
  #undef VRD2
  #undef EX
  #undef VRD
  #undef KRD
  #undef STEP
  #undef ENDW
  {auto rr=__builtin_amdgcn_permlane32_swap(__float_as_uint(l_reg),__float_as_uint(l_reg),false,false);l_reg=__uint_as_float(rr[0])+__uint_as_float(rr[1]);}
  if(hi==0)wsf[32+r32]=l_reg;asm volatile("s_waitcnt lgkmcnt(0)":::"memory");
  float rli[16];
  #pragma unroll
  for(int r=0;r<16;++r)rli[r]=__builtin_amdgcn_rcpf(wsf[32+crow(r,hi)]);
  bf16*Ow=Oc+(rowbase+q0+wid*QBLK)*PO;
  { bf16*stg=(bf16*)(shm+LDS_OST2)+wid*2048;
    #pragma unroll
    for(int hh=0;hh<2;++hh){
      #pragma unroll
      for(int r=0;r<16;++r){const int orow=crow(r,hi);
        #pragma unroll
        for(int d0=0;d0<2;++d0)stg[orow*64+d0*32+r32]=__float2bfloat16(o[2*hh+d0][r]*rli[r]);}
      asm volatile("s_waitcnt lgkmcnt(0)":::"memory");
      #pragma unroll
      for(int i=0;i<4;++i){const int row=i*8+(lane>>3),ch=lane&7; const u32x4 v=*(const u32x4*)(stg+row*64+ch*8); ATTN_STORE16(Ow+(long)row*PO+hh*64+ch*8,v);}
      asm volatile("s_waitcnt lgkmcnt(0)":::"memory"); } }
  asm volatile("s_waitcnt lgkmcnt(0)\n\ts_barrier":::"memory");
  #undef DMA_K
  #undef DMA_V
  #undef CMASK
  #undef START
  #undef RESC
  #undef ROT
}
constexpr int ATTN_LDS_BYTES=LDS_BYTES;
#undef SBAR
#undef WAIT_BAR
}
#define GAS __attribute__((address_space(1)))
#define LAS __attribute__((address_space(3)))
typedef unsigned v4u __attribute__((ext_vector_type(4)));
typedef float f32x4 __attribute__((ext_vector_type(4)));
typedef short bf16x8 __attribute__((ext_vector_type(8)));
typedef GAS unsigned gu32;
typedef GAS unsigned long long gu64;
#define RLX_AGENT __ATOMIC_RELAXED, __HIP_MEMORY_SCOPE_AGENT
#define LDS_WAIT() asm volatile("s_waitcnt lgkmcnt(0)" ::: "memory")
#define VM_WAIT() asm volatile("s_waitcnt vmcnt(0)" ::: "memory")
__device__ __forceinline__ int lane_id() { int l; asm volatile("v_mbcnt_lo_u32_b32 %0, -1, 0\n\tv_mbcnt_hi_u32_b32 %0, -1, %0" : "=v"(l)); return l; }
__device__ __forceinline__ unsigned long long rt() { return __builtin_amdgcn_s_memrealtime(); }
typedef float pk_f32x2 __attribute__((ext_vector_type(2))); typedef __bf16 pk_bf16x2 __attribute__((ext_vector_type(2)));
__device__ __forceinline__ unsigned pk2(float lo, float hi) { pk_f32x2 v = {lo, hi}; pk_bf16x2 b = __builtin_convertvector(v, pk_bf16x2); return __builtin_bit_cast(unsigned, b); }

#define XB_TMO      128
#define XB_XCNT(j)  (256  + 64 * (j))
#define XB_XSUB(j)  (1280 + 64 * (j))
#define XB_XGEN(j)  (2304 + 64 * (j))
#define XB_TOP      3328
#define XB_TOPGEN   3392
#define XCD_BAR_WORDS 3456
#define XB_SPIN_CAP (1u << 18)

__device__ __forceinline__ unsigned xb_ld(unsigned* p)              { return __hip_atomic_load(p, __ATOMIC_RELAXED, __HIP_MEMORY_SCOPE_AGENT); }
__device__ __forceinline__ unsigned xb_add(unsigned* p, unsigned v) { return __hip_atomic_fetch_add(p, v, __ATOMIC_RELAXED, __HIP_MEMORY_SCOPE_AGENT); }
__device__ __forceinline__ unsigned xb_xcc_id() { return (unsigned)__builtin_amdgcn_s_getreg((3 << 11) | 20) & 0xFu; }
#define XB_SPIN(cond, bar) do { unsigned _sp = 0; while (cond) { __builtin_amdgcn_s_sleep(1); \
    if ((++_sp & 255u) == 0u) { if (xb_ld(&(bar)[XB_TMO])) break; if (_sp > XB_SPIN_CAP) { atomicAdd(&(bar)[XB_TMO], 1u); break; } } } } while (0)

struct XcdBarrier {
    unsigned* bar; unsigned x;
    volatile LAS unsigned* st;
};

__device__ __forceinline__ XcdBarrier xcd_barrier_post(unsigned* bar, volatile LAS unsigned* st, const int tid0) {
    XcdBarrier b; b.bar = bar; b.x = xb_xcc_id(); b.st = st;
    if (tid0 == 0) (void)xb_add(&bar[XB_XCNT(b.x)], 1u);
    return b;
}
__device__ __forceinline__ void xcd_barrier_complete(unsigned* bar, unsigned x, unsigned& nloc, unsigned& nx) {
    const unsigned G = gridDim.x * gridDim.y * gridDim.z;
    unsigned sum, cnt, mine, sp = 0u;
    for (;;) {
        sum = 0u; cnt = 0u; mine = 0u;
#pragma unroll
        for (unsigned j = 0; j < 16; ++j) { const unsigned c = xb_ld(&bar[XB_XCNT(j)]); sum += c; cnt += (c > 0u) ? 1u : 0u; mine = (j == x) ? c : mine; }
        if (sum == G) break;
        __builtin_amdgcn_s_sleep(1);
        if ((++sp & 255u) == 0u) { if (xb_ld(&bar[XB_TMO])) break; if (sp > XB_SPIN_CAP) { atomicAdd(&bar[XB_TMO], 1u); break; } }
    }
    nloc = mine > 0u ? mine : 1u; nx = cnt > 0u ? cnt : 1u;
}

__device__ __forceinline__ void xcd_barrier(const XcdBarrier& b, const int tid0) {
    asm volatile("s_waitcnt vmcnt(0)" ::: "memory");
    __syncthreads();
    if (tid0 == 0) {
        unsigned* bar = b.bar;
        __builtin_amdgcn_s_waitcnt(0);
        unsigned nloc = b.st[0], nx = b.st[1];
        if (nloc == 0u) { xcd_barrier_complete(bar, b.x, nloc, nx); b.st[0] = nloc; b.st[1] = nx; }
        const unsigned old = xb_add(&bar[XB_XSUB(b.x)], 1u);
        const unsigned gen = old / nloc;
        if (old + 1u == (gen + 1u) * nloc) {
            __builtin_amdgcn_fence(__ATOMIC_RELEASE, "agent");
            asm volatile("s_waitcnt vmcnt(0)" ::: "memory");
            const unsigned og = xb_add(&bar[XB_TOP], 1u);
            const unsigned tg = og / nx;
            if (og + 1u == (tg + 1u) * nx) xb_add(&bar[XB_TOPGEN], 1u);
            else XB_SPIN(xb_ld(&bar[XB_TOPGEN]) == tg, bar);
            __builtin_amdgcn_fence(__ATOMIC_ACQUIRE, "agent");
            xb_add(&bar[XB_XGEN(b.x)], 1u);
            asm volatile("s_waitcnt vmcnt(0)" ::: "memory");
        } else {
            XB_SPIN(xb_ld(&bar[XB_XGEN(b.x)]) == gen, bar);
            __builtin_amdgcn_fence(__ATOMIC_ACQUIRE, "agent");
            asm volatile("s_waitcnt vmcnt(0)" ::: "memory");
        }
    }
    __syncthreads();
}
constexpr int NWAVES = 8;
constexpr int RING_OFF = 0, RING_BYTES = 131072;
constexpr int LDSCTL_OFF = RING_BYTES, MISC_OFF = LDSCTL_OFF + 320;
constexpr int LDS_BYTES = 147456;
constexpr int CW_TMO = 0, CW_CODE = 1, CW_BAR = 4096;
constexpr float GATE_WSCALE = 32.f, H_SCALE = 16.f, WD_SCALE = 16.f;
constexpr int CW_CNT2 = 32768;
constexpr int CW_CNT = 16384;

struct Frame {
    LAS unsigned char* lds;
    volatile LAS unsigned* MISC;
    gu32* ctl;
    int tid, lane, wave;
    int vcu, G;
    unsigned char* ws;
    const float* in[30]; float* out;
};
__device__ __forceinline__ float wave_sum(float v) {
#pragma unroll
    for (int o = 1; o < 64; o <<= 1) v += __shfl_xor(v, o);
    return v;
}
__device__ __forceinline__ float fast_sigmoid(float v) { return __builtin_amdgcn_rcpf(1.f + __builtin_amdgcn_exp2f(-1.4426950408889634f * v)); }

__device__ __forceinline__ void p0_transpose_item(const float* W, int K, int N, bf16_t* WT, int dst_row0, const float* kscale, LAS float* scr, int k0, int n0, int lane) {
    const int c = lane & 7;
    f32x4 ks0 = (f32x4){1.f, 1.f, 1.f, 1.f}, ks1 = ks0;
    if (kscale) { ks0 = *(const f32x4*)(kscale + k0 + 8 * c); ks1 = *(const f32x4*)(kscale + k0 + 8 * c + 4); }
    float v[32];
#pragma unroll
    for (int i = 0; i < 32; ++i) v[i] = __builtin_nontemporal_load(W + (size_t)(k0 + 2 * i + (lane >> 5)) * N + n0 + (lane & 31));
#pragma unroll
    for (int i = 0; i < 32; ++i) scr[(2 * i + (lane >> 5)) * 33 + (lane & 31)] = v[i];
    LDS_WAIT(); asm volatile("" ::: "memory");
#pragma unroll
    for (int j = 0; j < 4; ++j) { const int n = (lane >> 3) + 8 * j; const LAS float* s = scr + (8 * c) * 33 + n;
        v4u o; o.x = pk2(s[0 * 33] * ks0.x, s[1 * 33] * ks0.y); o.y = pk2(s[2 * 33] * ks0.z, s[3 * 33] * ks0.w); o.z = pk2(s[4 * 33] * ks1.x, s[5 * 33] * ks1.y); o.w = pk2(s[6 * 33] * ks1.z, s[7 * 33] * ks1.w);
        st16(WT + (size_t)(dst_row0 + n) * K + k0 + 8 * c, o); }
    LDS_WAIT(); asm volatile("" ::: "memory");
}
__device__ __forceinline__ unsigned pk4_fp8(float a, float b, float c, float d) { unsigned r = 0u;
    a = __builtin_amdgcn_fmed3f(a, -448.f, 448.f); b = __builtin_amdgcn_fmed3f(b, -448.f, 448.f); c = __builtin_amdgcn_fmed3f(c, -448.f, 448.f); d = __builtin_amdgcn_fmed3f(d, -448.f, 448.f); r = (unsigned)__builtin_amdgcn_cvt_pk_fp8_f32(a, b, (int)r, false); r = (unsigned)__builtin_amdgcn_cvt_pk_fp8_f32(c, d, (int)r, true); return r; }
__device__ __forceinline__ void p0_transpose_item_fp8(const float* W, int K, int N, unsigned char* WT, int dst_row0, float scale, LAS float* scr, int k0, int n0, int lane, const float* kscale = nullptr) {
    const int c = lane & 7;
    f32x4 ks0 = (f32x4){scale, scale, scale, scale}, ks1 = ks0;
    if (kscale) { ks0 = *(const f32x4*)(kscale + k0 + 8 * c) * scale; ks1 = *(const f32x4*)(kscale + k0 + 8 * c + 4) * scale; }
    float v[32];
#pragma unroll
    for (int i = 0; i < 32; ++i) v[i] = __builtin_nontemporal_load(W + (size_t)(k0 + 2 * i + (lane >> 5)) * N + n0 + (lane & 31));
#pragma unroll
    for (int i = 0; i < 32; ++i) scr[(2 * i + (lane >> 5)) * 33 + (lane & 31)] = v[i];
    LDS_WAIT(); asm volatile("" ::: "memory");
#pragma unroll
    for (int j = 0; j < 4; ++j) { const int n = (lane >> 3) + 8 * j; const LAS float* s = scr + (8 * c) * 33 + n;
        wt_v2u o; o.x = pk4_fp8(s[0 * 33] * ks0.x, s[1 * 33] * ks0.y, s[2 * 33] * ks0.z, s[3 * 33] * ks0.w); o.y = pk4_fp8(s[4 * 33] * ks1.x, s[5 * 33] * ks1.y, s[6 * 33] * ks1.z, s[7 * 33] * ks1.w);
        st8(WT + (size_t)(dst_row0 + n) * K + k0 + 8 * c, o); }
    LDS_WAIT(); asm volatile("" ::: "memory");
}
__device__ __forceinline__ int perm_in(int n) { return (n & ~255) | (((n >> 5) & 1) << 7) | (((n >> 6) & 3) << 5) | (n & 31); }
__device__ __forceinline__ int perm_glu(int n) { const int bj = n >> 10, rem = n & 1023; return ((rem >> 7) << 8) | (bj << 7) | (rem & 127); }
template <int NR> __device__ __forceinline__ void rms_rows_to_bf16(Frame& F, const float* xrow, const float* g, bf16_t* orow, unsigned char* o8row) {
    const GAS f32x4* xr = (const GAS f32x4*)xrow + F.lane; const GAS f32x4* gr = (const GAS f32x4*)g + F.lane;
    f32x4 v[NR][4]; float s[NR];
#pragma unroll
    for (int r = 0; r < NR; ++r)
#pragma unroll
        for (int j = 0; j < 4; ++j) v[r][j] = __builtin_nontemporal_load(xr + r * 256 + 64 * j);
#pragma unroll
    for (int r = 0; r < NR; ++r) { s[r] = 0.f;
#pragma unroll
        for (int j = 0; j < 4; ++j) s[r] += (v[r][j].x * v[r][j].x + v[r][j].y * v[r][j].y) + (v[r][j].z * v[r][j].z + v[r][j].w * v[r][j].w); }
#pragma unroll
    for (int o = 1; o < 64; o <<= 1)
#pragma unroll
        for (int r = 0; r < NR; ++r) s[r] += __shfl_xor(s[r], o);
    f32x4 gg[4];
#pragma unroll
    for (int j = 0; j < 4; ++j) gg[j] = gr[64 * j];
#pragma unroll
    for (int r = 0; r < NR; ++r) { const float rs = rsqrtf(s[r] * (1.f / DM) + EPS); GAS unsigned long long* o8 = (GAS unsigned long long*)(orow + (size_t)r * DM) + F.lane;
#pragma unroll
        for (int j = 0; j < 4; ++j) { const float a = v[r][j].x * rs * gg[j].x, b = v[r][j].y * rs * gg[j].y, c = v[r][j].z * rs * gg[j].z, d = v[r][j].w * rs * gg[j].w;
            wt_v2u w2; w2.x = pk2(a, b); w2.y = pk2(c, d); st8((void*)(o8 + 64 * j), w2); ((GAS unsigned*)(o8row + (size_t)r * DM))[F.lane + 64 * j] = pk4_fp8(a, b, c, d); } }
}
__device__ __forceinline__ void p0_prologue(Frame& F) {
    LAS float* scr = (LAS float*)(F.lds + RING_OFF + F.wave * 16384);
    const int gw = F.vcu * NWAVES + F.wave, NGW = F.G * NWAVES;
    bf16_t* Win_t = (bf16_t*)(F.ws + WS_WIN); bf16_t* Wo_t = (bf16_t*)(F.ws + WS_WO); bf16_t* Wglu_t = (bf16_t*)(F.ws + WS_WGLU); bf16_t* Wout_t = (bf16_t*)(F.ws + WS_WOUT);
    constexpr int I_IN = 16 * 128, I_O = 8 * 32, I_GLU = 8 * 64, I_OUT = 16 * 32;
    constexpr int NITEMS = I_IN + I_O + I_GLU + I_OUT;
    for (int it = gw; it < NITEMS; it += NGW) {
        int r = it;
        if (r < I_IN) { const int kb = r / 128, nb = r % 128;
            if (nb < 64) p0_transpose_item(F.in[3], DM, IN_COLS, Win_t, perm_in(32 * nb), nullptr, scr, 64 * kb, 32 * nb, F.lane);
            else p0_transpose_item_fp8(F.in[3], DM, IN_COLS, F.ws + WS_WG8, perm_in(32 * nb) - 2048, GATE_WSCALE, scr, 64 * kb, 32 * nb, F.lane);
            continue; } r -= I_IN;
        if (r < I_O) { const int kb = r / 32, nb = r % 32; p0_transpose_item(F.in[11], 512, DM, Wo_t, 32 * nb, nullptr, scr, 64 * kb, 32 * nb, F.lane); continue; } r -= I_O;
        if (r < I_GLU) { const int kb = r / 64, nb = r % 64; p0_transpose_item(F.in[20], 512, 2048, Wglu_t, perm_glu(32 * nb), nullptr, scr, 64 * kb, 32 * nb, F.lane); continue; } r -= I_GLU;
        { const int kb = r / 32, nb = r % 32; p0_transpose_item(F.in[21], DM, DM, Wout_t, 32 * nb, nullptr, scr, 64 * kb, 32 * nb, F.lane); }
    }
    bf16_t* XN = (bf16_t*)(F.ws + WS_XN);
    for (int m = 4 * gw; m < T; m += 4 * NGW) rms_rows_to_bf16<4>(F, F.in[0] + (size_t)m * DM, F.in[2], XN + (size_t)m * DM, F.ws + WS_XN8 + (size_t)m * DM);
    { float* rope = (float*)(F.ws + WS_ROPE); const int* pos = (const int*)F.in[1]; const int gt = (F.vcu * NWAVES + F.wave) * 64 + F.lane, NGT = NGW * 64;
        for (int i = gt; i < T * 8; i += NGT) { const int row = i >> 3, k = i & 7;
            double rv = (double)pos[row] * (0.15915494309189535 * exp2(-(double)k * 2.3664460711655217)); rv -= rint(rv);
            rope[row * 16 + k] = __builtin_amdgcn_cosf((float)rv); rope[row * 16 + 8 + k] = __builtin_amdgcn_sinf((float)rv); } }
    {   const float* lre = F.in[12]; const float* lim = F.in[13]; const float* ldt = F.in[14]; const float* bre = F.in[15]; const float* bim = F.in[16]; const float* cre = F.in[17]; const float* cim = F.in[18];
        bf16_t* Ft = (bf16_t*)(F.ws + WS_SSMF); bf16_t* Gt = (bf16_t*)(F.ws + WS_SSMG); bf16_t* Ht = (bf16_t*)(F.ws + WS_SSMH); float* A64 = (float*)(F.ws + WS_SSMA);
#define CPOW(lr_, li_, dt_, e_, outr, outi) do { const float m_ = __expf((lr_) * (dt_) * (float)(e_)); double rv_ = (double)(li_) * (double)(dt_) * (double)(e_) * 0.15915494309189535; rv_ -= rint(rv_); \
        outr = m_ * __builtin_amdgcn_cosf((float)rv_); outi = m_ * __builtin_amdgcn_sinf((float)rv_); } while (0)
#define CFAC(lr_, li_, dt_, fr_, fi_) do { float a1r_, a1i_; CPOW(lr_, li_, dt_, 1, a1r_, a1i_); const float nr_ = a1r_ - 1.f, ni_ = a1i_, den_ = (lr_) * (lr_) + (li_) * (li_); \
        fr_ = (nr_ * (lr_) + ni_ * (li_)) / den_; fi_ = (ni_ * (lr_) - nr_ * (li_)) / den_; } while (0)
        LAS float* sw = (LAS float*)(F.lds + RING_OFF + F.wave * 16384);
        for (int it = gw; it < 32 * 64; it += NGW) { const int g = it >> 6, d = it & 63; const int p = F.lane;
            { const float dt = __expf(ldt[g]); const float lr = lre[g * 64 + p], li = lim[g * 64 + p]; float fr, fi, wr, wi; CFAC(lr, li, dt, fr, fi); CPOW(lr, li, dt, d, wr, wi);
              sw[p * 2] = wr * fr - wi * fi; sw[p * 2 + 1] = wr * fi + wi * fr; }
            LDS_WAIT(); asm volatile("" ::: "memory");
            const int hp = F.lane >> 2, h0 = (F.lane & 3) * 4; float acc[4] = {0.f, 0.f, 0.f, 0.f};
#pragma unroll 16
            for (int q = 0; q < 64; ++q) { const float ur = sw[q * 2], ui = sw[q * 2 + 1]; const float cr = cre[(g * 16 + hp) * 64 + q], ci = cim[(g * 16 + hp) * 64 + q];
                const f32x4 br = *(const f32x4*)(bre + (g * 64 + q) * 16 + h0), bi = *(const f32x4*)(bim + (g * 64 + q) * 16 + h0);
                const float er = cr * ur - ci * ui, ei = cr * ui + ci * ur;
                acc[0] += er * br.x - ei * bi.x; acc[1] += er * br.y - ei * bi.y; acc[2] += er * br.z - ei * bi.z; acc[3] += er * br.w - ei * bi.w; }
#pragma unroll
            for (int i = 0; i < 4; ++i) { const int h = h0 + i; float v = acc[i]; if (d == 0 && h == hp) v += F.in[19][g * 16 + hp];
                Ft[((size_t)(g * 64 + d) * 64 + hp + 16 * (h >> 3)) * 8 + (h & 7)] = f2bf(v);
                if (d < 63) Ft[((size_t)(g * 64 + d + 1) * 64 + hp + 16 * (2 + (h >> 3))) * 8 + (h & 7)] = f2bf(v);
                if (d == 0) Ft[((size_t)(g * 64) * 64 + hp + 16 * (2 + (h >> 3))) * 8 + (h & 7)] = 0; }
            LDS_WAIT(); asm volatile("" ::: "memory");
        }
        const int gt = gw * 64 + F.lane, NGT = NGW * 64;
        for (int idx = gt; idx < 32 * 4 * 512; idx += NGT) { const int j = idx & 7, ln = (idx >> 3) & 63, kk = (idx >> 9) & 3, g = idx >> 11; const int hp = ln & 15, sidx = 32 * kk + 8 * (ln >> 4) + j;
            Gt[idx] = f2bf(sidx < 64 ? cre[(g * 16 + hp) * 64 + sidx] : -cim[(g * 16 + hp) * 64 + sidx - 64]); }
        for (int idx = gt; idx < 32 * 64; idx += NGT) { const int g = idx >> 6, p = idx & 63; const float dt = __expf(ldt[g]); const float lr = lre[idx], li = lim[idx]; f32x4 ab; CPOW(lr, li, dt, 1, ab.x, ab.y); CPOW(lr, li, dt, 2, ab.z, ab.w);
            ((f32x4*)(A64 + 16384))[idx] = ab; }
        for (int idx = gt; idx < 32 * 64 * 64; idx += NGT) { const int g = idx >> 12, t = (idx >> 6) & 63, p = idx & 63;
            const float dt = __expf(ldt[g]);
            { const int pp = t, jt = p;
              const float lr2 = lre[g * 64 + pp], li2 = lim[g * 64 + pp]; float fr, fi, wr0, wi0; CFAC(lr2, li2, dt, fr, fi); CPOW(lr2, li2, dt, 63 - jt, wr0, wi0);
              const float wr = wr0 * fr - wi0 * fi, wi = wr0 * fi + wi0 * fr;
              const int mt = pp >> 4, mrow = pp & 15, ks = jt >> 1;
              const f32x4* b4r = (const f32x4*)(bre + (g * 64 + pp) * 16); const f32x4* b4i = (const f32x4*)(bim + (g * 64 + pp) * 16);
#pragma unroll
              for (int hq = 0; hq < 2; ++hq) {
                  const f32x4 ra = b4r[2 * hq], rb = b4r[2 * hq + 1], ia = b4i[2 * hq], ib = b4i[2 * hq + 1]; const int kq = (jt & 1) * 2 + hq;
                  v4u o0, o1; o0.x = pk2(wr * ra.x - wi * ia.x, wr * ra.y - wi * ia.y); o0.y = pk2(wr * ra.z - wi * ia.z, wr * ra.w - wi * ia.w); o0.z = pk2(wr * rb.x - wi * ib.x, wr * rb.y - wi * ib.y); o0.w = pk2(wr * rb.z - wi * ib.z, wr * rb.w - wi * ib.w);
                  o1.x = pk2(wr * ia.x + wi * ra.x, wr * ia.y + wi * ra.y); o1.y = pk2(wr * ia.z + wi * ra.z, wr * ia.w + wi * ra.w); o1.z = pk2(wr * ib.x + wi * rb.x, wr * ib.y + wi * rb.y); o1.w = pk2(wr * ib.z + wi * rb.z, wr * ib.w + wi * rb.w);
                  st16(Ht + ((size_t)((g * 8 + mt) * 32 + ks) * 64 + mrow + 16 * kq) * 8, o0);
                  st16(Ht + ((size_t)((g * 8 + 4 + mt) * 32 + ks) * 64 + mrow + 16 * kq) * 8, o1); }
              if (jt == 0) { float ar, ai; CPOW(lr2, li2, dt, 64, ar, ai); A64[(g * 64 + pp) * 2] = ar; A64[(g * 64 + pp) * 2 + 1] = ai; } }
        }
#undef CPOW
#undef CFAC
    }
    { bf16_t* Wr = (bf16_t*)(F.ws + WS_WR); const int gt2 = gw * 64 + F.lane, NGT2 = NGW * 64;
      for (int idx = gt2; idx < 32 * 3 * 512; idx += NGT2) { const int ks = idx / 1536, rem = idx % 1536, ntl = rem >> 9, ln = (rem & 511) >> 3, j = rem & 7; const int k = 32 * ks + 8 * (ln >> 4) + j, ncol = 16 * ntl + (ln & 15);
          float v = 0.f; if (ncol < 4) v = F.in[23][k * 4 + ncol]; else if (ncol < 36) v = F.in[25][k * 32 + ncol - 4];
          Wr[idx] = f2bf(v * F.in[22][k]); } }
    if (blockIdx.x == 0 && F.wave == 0) { const float a = wave_sum(F.in[6][F.lane] * F.in[7][F.lane]), b = wave_sum(F.in[8][F.lane] * F.in[9][F.lane]);
        if (F.lane == 0) ((float*)(F.ws + WS_SCAL))[0] = expf(a) - expf(b) + LAM_INIT; }
}

__device__ __forceinline__ void expert_weights_items(Frame& F, int gwp, int ngwp) {
    LAS float* scr = (LAS float*)(F.lds + RING_OFF + F.wave * 16384);
    bf16_t* Wgu_t = (bf16_t*)(F.ws + WS_WGU); bf16_t* Wd_t = (bf16_t*)(F.ws + WS_WD);
    constexpr int I_GU = 32 * 2 * 16 * 8, I_D = 32 * 4 * 32;
    for (int it = gwp; it < I_GU + I_D; it += ngwp) { int r = it;
        if (r < I_GU) { const int e = r / 256, up = (r / 128) & 1, kb = (r % 128) / 8, nb = r % 8;
            const int n0 = 32 * nb, pn = n0 >> 7, j0 = n0 & 127;
            p0_transpose_item_fp8((up ? F.in[28] : F.in[27]) + (size_t)e * DM * 256, DM, 256, F.ws + WS_WGU + (size_t)e * 512 * DM, 256 * pn + 128 * up + j0, GATE_WSCALE, scr, 64 * kb, n0, F.lane, F.in[22]); continue; } r -= I_GU;
        { const int e = r / 128, kb = (r % 128) / 32, nb = r % 32; p0_transpose_item_fp8(F.in[29] + (size_t)e * 256 * DM, 256, DM, F.ws + WS_WD + (size_t)e * DM * 256, 32 * nb, WD_SCALE, scr, 64 * kb, 32 * nb, F.lane); } }
    __syncthreads();
}
__device__ __forceinline__ float sum_x16_x32(float s) {
    { auto rr = __builtin_amdgcn_permlane16_swap(__float_as_uint(s), __float_as_uint(s), false, false); s = __uint_as_float(rr[0]) + __uint_as_float(rr[1]); }
    { auto rr = __builtin_amdgcn_permlane32_swap(__float_as_uint(s), __float_as_uint(s), false, false); s = __uint_as_float(rr[0]) + __uint_as_float(rr[1]); }
    return s; }
__device__ __forceinline__ float from_x16(float v, int fq) {
    auto rr = __builtin_amdgcn_permlane16_swap(__float_as_uint(v), __float_as_uint(v), false, false); return __uint_as_float((fq & 1) ? rr[0] : rr[1]); }
typedef unsigned u32x2g __attribute__((ext_vector_type(2)));
__device__ __forceinline__ unsigned q8(float a, float b, float c, float d) { const unsigned x = (unsigned)(a * 255.f + 0.5f), y = (unsigned)(b * 255.f + 0.5f), z = (unsigned)(c * 255.f + 0.5f), w = (unsigned)(d * 255.f + 0.5f); return x | (y << 8) | (z << 16) | (w << 24); }
__device__ __forceinline__ void unq8(const u32x2g v, float (&f)[8]) { constexpr float k = 1.f / 255.f;
    f[0] = (float)(v.x & 255u) * k; f[1] = (float)((v.x >> 8) & 255u) * k; f[2] = (float)((v.x >> 16) & 255u) * k; f[3] = (float)(v.x >> 24) * k;
    f[4] = (float)(v.y & 255u) * k; f[5] = (float)((v.y >> 8) & 255u) * k; f[6] = (float)((v.y >> 16) & 255u) * k; f[7] = (float)(v.y >> 24) * k; }
template <int PN0> struct EpiInT {
    static constexpr bool PERM = true, AFTER_DRAIN = false;
    bf16_t *Qb, *Kb, *Vb, *Ub, *Gb; const float* rope; const float* qg; const float* kg; float gsc;
    __device__ __forceinline__ void operator()(const pg8::f32x4 (&acc)[2][2][4][2], const pg8::Unit& u, int wr, int wc, int fr, int fq) const {
        const int row0 = u.pm * 256 + wr * 64 + fr; const int pn = u.pn + PN0;
        if constexpr (PN0 == 0) { if (pn < 4) {
            const bool isq = pn < 2; const float* g = isq ? qg : kg; bf16_t* O = isq ? Qb : Kb; const float sc = isq ? QSCALE : 1.f; const int gidx = (pn & 1) * 4 + wc;
            f32x4 gv[2][2];
#pragma unroll
            for (int bj = 0; bj < 2; ++bj)
#pragma unroll
                for (int n = 0; n < 2; ++n) gv[bj][n] = *(const f32x4*)(g + 32 * bj + 8 * fq + 4 * n);
#pragma unroll
            for (int ai = 0; ai < 2; ++ai)
#pragma unroll
                for (int m = 0; m < 4; ++m) { const int row = row0 + ai * 128 + m * 16; f32x4 v[2][2]; float s = 0.f;
#pragma unroll
                    for (int bj = 0; bj < 2; ++bj)
#pragma unroll
                        for (int n = 0; n < 2; ++n) { v[bj][n] = acc[ai][bj][m][n]; s += (v[bj][n].x * v[bj][n].x + v[bj][n].y * v[bj][n].y) + (v[bj][n].z * v[bj][n].z + v[bj][n].w * v[bj][n].w); }
                    s = sum_x16_x32(s);
                    const float r = rsqrtf(s * (1.f / 64.f) + EPS);
#pragma unroll
                    for (int bj = 0; bj < 2; ++bj)
#pragma unroll
                        for (int n = 0; n < 2; ++n) v[bj][n] = v[bj][n] * r * gv[bj][n];
#pragma unroll
                    for (int n = 0; n < 2; ++n) { f32x4 p; p.x = from_x16(v[0][n].x, fq); p.y = from_x16(v[0][n].y, fq); p.z = from_x16(v[0][n].z, fq); p.w = from_x16(v[0][n].w, fq);
                        if (fq < 2) { const f32x4 cs = *(const f32x4*)(rope + (size_t)row * 16 + 4 * n), sn = *(const f32x4*)(rope + (size_t)row * 16 + 8 + 4 * n);
                            v[0][n] = fq == 0 ? v[0][n] * cs - p * sn : v[0][n] * cs + p * sn; } }
#pragma unroll
                    for (int bj = 0; bj < 2; ++bj) { const f32x4 a = v[bj][0] * sc, b = v[bj][1] * sc; v4u w; w.x = pk2(a.x, a.y); w.y = pk2(a.z, a.w); w.z = pk2(b.x, b.y); w.w = pk2(b.z, b.w);
                        pst16(O + (size_t)row * 512 + gidx * 64 + 32 * bj + 8 * fq, w); }
                }
        } else {
            bf16_t* O = pn < 6 ? Vb : Ub; const int cbase = (pn & 1) * 256 + 64 * wc + 8 * fq;
#pragma unroll
            for (int ai = 0; ai < 2; ++ai)
#pragma unroll
                for (int m = 0; m < 4; ++m) { const int row = row0 + ai * 128 + m * 16;
#pragma unroll
                    for (int bj = 0; bj < 2; ++bj) { const f32x4 a = acc[ai][bj][m][0], b = acc[ai][bj][m][1]; v4u w; w.x = pk2(a.x, a.y); w.y = pk2(a.z, a.w); w.z = pk2(b.x, b.y); w.w = pk2(b.z, b.w);
                        pst16(O + (size_t)row * 512 + cbase + 32 * bj, w); } }
        } } else {
            const int cbase = (pn - 8) * 256 + 64 * wc + 8 * fq;
#pragma unroll
            for (int ai = 0; ai < 2; ++ai)
#pragma unroll
                for (int m = 0; m < 4; ++m) { const int row = row0 + ai * 128 + m * 16;
#pragma unroll
                    for (int bj = 0; bj < 2; ++bj) { const f32x4 a = acc[ai][bj][m][0] * gsc, b = acc[ai][bj][m][1] * gsc; u32x2g w;
                        w.x = q8(fast_sigmoid(a.x), fast_sigmoid(a.y), fast_sigmoid(a.z), fast_sigmoid(a.w)); w.y = q8(fast_sigmoid(b.x), fast_sigmoid(b.y), fast_sigmoid(b.z), fast_sigmoid(b.w));
                        pst8((unsigned char*)Gb + (size_t)row * 2048 + cbase + 32 * bj, w); } }
        }
    }
};


__device__ __forceinline__ void unpack8(const v4u w, float (&f)[8]) { f[0] = __uint_as_float(w.x << 16); f[1] = __uint_as_float(w.x & 0xffff0000u); f[2] = __uint_as_float(w.y << 16); f[3] = __uint_as_float(w.y & 0xffff0000u);
    f[4] = __uint_as_float(w.z << 16); f[5] = __uint_as_float(w.z & 0xffff0000u); f[6] = __uint_as_float(w.w << 16); f[7] = __uint_as_float(w.w & 0xffff0000u); }
struct EpiOA {
    static constexpr bool PERM = true, AFTER_DRAIN = false;
    const bf16_t* Gb; bf16_t* MA;
    __device__ __forceinline__ void operator()(const pg8::f32x4 (&acc)[2][2][4][2], const pg8::Unit& u, int wr, int wc, int fr, int fq) const {
        const int row0 = u.pm * 256 + wr * 64 + fr, col0 = u.pn * 256 + wc * 32 + 8 * fq;
        u32x2g gv[2][4][2];
#pragma unroll
        for (int ai = 0; ai < 2; ++ai)
#pragma unroll
            for (int m = 0; m < 4; ++m)
#pragma unroll
                for (int bj = 0; bj < 2; ++bj) gv[ai][m][bj] = *(const u32x2g*)((const unsigned char*)Gb + (size_t)(row0 + ai * 128 + m * 16) * 2048 + col0 + bj * 128);
#pragma unroll
        for (int ai = 0; ai < 2; ++ai)
#pragma unroll
            for (int m = 0; m < 4; ++m) { const size_t row = row0 + ai * 128 + m * 16;
#pragma unroll
                for (int bj = 0; bj < 2; ++bj) { float gg[8]; unq8(gv[ai][m][bj], gg);
                    const f32x4 a = acc[ai][bj][m][0], b = acc[ai][bj][m][1]; v4u w; w.x = pk2(a.x * gg[0], a.y * gg[1]); w.y = pk2(a.z * gg[2], a.w * gg[3]); w.z = pk2(b.x * gg[4], b.y * gg[5]); w.w = pk2(b.z * gg[6], b.w * gg[7]);
                    pst16(MA + row * DM + col0 + bj * 128, w); } }
    }
};
struct EpiGlu {
    static constexpr bool PERM = true, AFTER_DRAIN = false;
    const bf16_t* Gb; const bf16_t* MA; bf16_t* MG;
    __device__ __forceinline__ void operator()(const pg8::f32x4 (&acc)[2][2][4][2], const pg8::Unit& u, int wr, int wc, int fr, int fq) const {
        const int row0 = u.pm * 256 + wr * 64 + fr, col = u.pn * 128 + wc * 32 + 8 * fq;
        u32x2g gv[2][4]; v4u mv[2][4];
#pragma unroll
        for (int ai = 0; ai < 2; ++ai)
#pragma unroll
            for (int m = 0; m < 4; ++m) { const size_t row = row0 + ai * 128 + m * 16; gv[ai][m] = *(const u32x2g*)((const unsigned char*)Gb + row * 2048 + 1024 + col); mv[ai][m] = *(const v4u*)(MA + row * DM + col); }
#pragma unroll
        for (int ai = 0; ai < 2; ++ai)
#pragma unroll
            for (int m = 0; m < 4; ++m) { const size_t row = row0 + ai * 128 + m * 16; float gg[8], ma[8]; unq8(gv[ai][m], gg); unpack8(mv[ai][m], ma);
                const f32x4 z1a = acc[ai][0][m][0], z1b = acc[ai][0][m][1], z2a = acc[ai][1][m][0], z2b = acc[ai][1][m][1]; v4u w;
                w.x = pk2(ma[0] + gg[0] * z1a.x * fast_sigmoid(z2a.x), ma[1] + gg[1] * z1a.y * fast_sigmoid(z2a.y)); w.y = pk2(ma[2] + gg[2] * z1a.z * fast_sigmoid(z2a.z), ma[3] + gg[3] * z1a.w * fast_sigmoid(z2a.w));
                w.z = pk2(ma[4] + gg[4] * z1b.x * fast_sigmoid(z2b.x), ma[5] + gg[5] * z1b.y * fast_sigmoid(z2b.y)); w.w = pk2(ma[6] + gg[6] * z1b.z * fast_sigmoid(z2b.z), ma[7] + gg[7] * z1b.w * fast_sigmoid(z2b.w));
                pst16(MG + row * DM + col, w); }
    }
};
struct EpiOut {
    static constexpr bool PERM = true, AFTER_DRAIN = false;
    const float* x; float* out; bf16_t* X1b; unsigned char* X1b8;
    __device__ __forceinline__ void operator()(const pg8::f32x4 (&acc)[2][2][4][2], const pg8::Unit& u, int wr, int wc, int fr, int fq) const {
        const int row0 = u.pm * 256 + wr * 64 + fr, col0 = u.pn * 256 + wc * 32 + 8 * fq;
        f32x4 xv[4][2][2], sv[4][2][2];
#pragma unroll
        for (int m = 0; m < 4; ++m)
#pragma unroll
            for (int bj = 0; bj < 2; ++bj) { const size_t o = (size_t)(row0 + m * 16) * DM + col0 + bj * 128; xv[m][bj][0] = __builtin_nontemporal_load((const f32x4*)(x + o)); xv[m][bj][1] = __builtin_nontemporal_load((const f32x4*)(x + o + 4)); }
#pragma unroll
        for (int m = 0; m < 4; ++m)
#pragma unroll
            for (int bj = 0; bj < 2; ++bj) { sv[m][bj][0] = acc[0][bj][m][0] + xv[m][bj][0]; sv[m][bj][1] = acc[0][bj][m][1] + xv[m][bj][1]; }
#pragma unroll
        for (int m = 0; m < 4; ++m)
#pragma unroll
            for (int bj = 0; bj < 2; ++bj) { const size_t o = (size_t)(row0 + 128 + m * 16) * DM + col0 + bj * 128; xv[m][bj][0] = __builtin_nontemporal_load((const f32x4*)(x + o)); xv[m][bj][1] = __builtin_nontemporal_load((const f32x4*)(x + o + 4)); }
#pragma unroll
        for (int ai = 0; ai < 2; ++ai) {
            if (ai == 1) {
#pragma unroll
                for (int m = 0; m < 4; ++m)
#pragma unroll
                    for (int bj = 0; bj < 2; ++bj) { sv[m][bj][0] = acc[1][bj][m][0] + xv[m][bj][0]; sv[m][bj][1] = acc[1][bj][m][1] + xv[m][bj][1]; } }
#pragma unroll
            for (int m = 0; m < 4; ++m)
#pragma unroll
                for (int bj = 0; bj < 2; ++bj) { const size_t o = (size_t)(row0 + ai * 128 + m * 16) * DM + col0 + bj * 128; const f32x4 a = sv[m][bj][0], b = sv[m][bj][1];
                    v4u w; w.x = pk2(a.x, a.y); w.y = pk2(a.z, a.w); w.z = pk2(b.x, b.y); w.w = pk2(b.z, b.w); pst16(X1b + o, w);
                    wt_v2u w8; w8.x = pk4_fp8(a.x, a.y, a.z, a.w); w8.y = pk4_fp8(b.x, b.y, b.z, b.w); pst8(X1b8 + o, w8); } }
    }
};

struct RotOrder {
    pg8::StaticOrder so; int n, rot;
    __device__ __forceinline__ bool next(int i, pg8::Unit& u) const { if (i >= n) return false; int j = i + rot; if (j >= n) j -= n; return so.next(j, u); }
    __device__ __forceinline__ void a_ready(const pg8::Unit&) const {}
    __device__ __forceinline__ void done(const pg8::Unit&) const {}
};

struct ChainOrder {
    pg8::StaticOrder so;
    __device__ __forceinline__ bool next(int i, pg8::Unit& u) const { pg8::Unit t; if (!so.next(i / 3, t)) return false; const int part = i % 3;
        if (part == 0) { u.pm = t.pm; u.pn = t.pn; } else { u.pm = t.pm + T / 256; u.pn = 4 + 2 * t.pn + (part - 1); } return true; }
    __device__ __forceinline__ void a_ready(const pg8::Unit&) const {}
    __device__ __forceinline__ void done(const pg8::Unit&) const {}
};
struct EpiOAGlu {
    static constexpr bool PERM = true, AFTER_DRAIN = false;
    EpiOA a; EpiGlu b;
    __device__ __forceinline__ void operator()(const pg8::f32x4 (&acc)[2][2][4][2], const pg8::Unit& u, int wr, int wc, int fr, int fq) const {
        if (u.pn < 4) a(acc, u, wr, wc, fr, fq);
        else { asm volatile("s_waitcnt vmcnt(0)" ::: "memory"); pg8::Unit v; v.pm = u.pm - T / 256; v.pn = u.pn - 4; b(acc, v, wr, wc, fr, fq); }
    }
};

__device__ __forceinline__ float gelu_tanh_f(float x) { const float u = 0.7978845608028654f * (x + 0.044715f * x * x * x); const float e = __builtin_amdgcn_exp2f(2.885390081777927f * u); return 0.5f * x * (2.f - 2.f * __builtin_amdgcn_rcpf(e + 1.f)); }
#define SSM_DMA(gsrc, ldsdst) __builtin_amdgcn_global_load_lds((const unsigned*)(gsrc), (LAS unsigned*)(ldsdst), 16, 0, 0)
__device__ __forceinline__ void ssm_phase(Frame& F) {
    for (int pair = F.vcu; pair < 256; pair += F.G) {
    int lane = F.lane; asm volatile("" : "+v"(lane));
    const int b = pair & 7, g = pair >> 3; const int w = F.wave, nt = w & 3, tp = w >> 2, n = lane & 15, kq = lane >> 4;
    LAS unsigned char* L = F.lds + RING_OFF;
    LAS float* ES = (LAS float*)(L + 65536);
    const bf16_t* up = (const bf16_t*)(F.ws + WS_U) + ((size_t)b * SEQ + (16 * nt + n) * 64 + (kq >> 1)) * 512 + g * 16 + 8 * (kq & 1);
    bf16x8 U[32];
#pragma unroll
    for (int jp = 0; jp < 32; ++jp) U[jp] = *(const GAS bf16x8*)(up + (size_t)(2 * jp) * 512);
    const GAS bf16x8* Hw = (const GAS bf16x8*)(F.ws + WS_SSMH) + ((size_t)(g * 8 + w) * 32) * 64 + lane;
#define SSM_HBATCH(kb, buf) do { _Pragma("unroll") for (int q_ = 0; q_ < 4; ++q_) SSM_DMA(Hw + (size_t)(4 * (kb) + q_) * 64, L + (buf) * 32768 + (4 * w + q_) * 1024); } while (0)
    SSM_HBATCH(0, 0); SSM_HBATCH(1, 1);
    f32x4 E[4];
#pragma unroll
    for (int mt = 0; mt < 4; ++mt) E[mt] = (f32x4){0.f, 0.f, 0.f, 0.f};
#pragma unroll
    for (int kb = 0; kb < 8; ++kb) {
        if (kb < 7) asm volatile("s_waitcnt vmcnt(4)\n\ts_barrier" ::: "memory"); else asm volatile("s_waitcnt vmcnt(0)\n\ts_barrier" ::: "memory");
        const LAS bf16x8* hb = (const LAS bf16x8*)(L + (kb & 1) * 32768) + (tp * 16) * 64 + lane;
#pragma unroll
        for (int k4 = 0; k4 < 4; ++k4)
#pragma unroll
            for (int mt = 0; mt < 4; ++mt) E[mt] = __builtin_amdgcn_mfma_f32_16x16x32_bf16(hb[(mt * 4 + k4) * 64], U[4 * kb + k4], E[mt], 0, 0, 0);
        if (kb < 6) { asm volatile("s_waitcnt lgkmcnt(0)\n\ts_barrier" ::: "memory"); SSM_HBATCH(kb + 2, kb & 1); }
    }
#pragma unroll
    for (int mt = 0; mt < 4; ++mt)
#pragma unroll
        for (int i = 0; i < 4; ++i) ES[(16 * (4 * tp + mt) + 4 * kq + i) * 65 + 16 * nt + n] = E[mt][i];
    asm volatile("s_waitcnt lgkmcnt(0)\n\ts_barrier" ::: "memory");
    { const GAS bf16x8* Fg = (const GAS bf16x8*)(F.ws + WS_SSMF + (size_t)g * 65536) + lane;
#pragma unroll
      for (int q = 0; q < 8; ++q) SSM_DMA(Fg + (size_t)(8 * w + q) * 64, L + (8 * w + q) * 1024); }
    if (w == 0) { const float* A64 = (const float*)(F.ws + WS_SSMA) + (g * 64 + lane) * 2; const float ar = A64[0], ai = A64[1]; float sr = 0.f, si = 0.f;
        for (int c = 0; c < 64; ++c) { const float er = ES[lane * 65 + c], ei = ES[(64 + lane) * 65 + c]; ES[lane * 65 + c] = sr; ES[(64 + lane) * 65 + c] = si;
            const float nr = ar * sr - ai * si + er, ni = ar * si + ai * sr + ei; sr = nr; si = ni; } }
    int ln3 = lane; asm volatile("" : "+v"(ln3));
    const int n3 = ln3 & 15, kq3 = ln3 >> 4;
    bf16x8 CF[4];
#pragma unroll
    for (int kk = 0; kk < 4; ++kk) CF[kk] = *((const GAS bf16x8*)(F.ws + WS_SSMG) + (size_t)(g * 4 + kk) * 64 + ln3);
    float zr[16], zi[16], a2r[16], a2i[16];
#pragma unroll
    for (int q = 0; q < 16; ++q) { const f32x4 ab = ((const GAS f32x4*)((const float*)(F.ws + WS_SSMA) + 16384))[g * 64 + 32 * (q >> 3) + 8 * kq3 + (q & 7)]; a2r[q] = ab.z; a2i[q] = ab.w; zr[q] = tp ? ab.z : ab.x; zi[q] = tp ? ab.w : ab.y; }
    asm volatile("s_waitcnt vmcnt(0) lgkmcnt(0)\n\ts_barrier" ::: "memory");
#pragma unroll
    for (int q = 0; q < 16; ++q) { const int p = 32 * (q >> 3) + 8 * kq3 + (q & 7); const float sr = ES[p * 65 + 16 * nt + n3], si = ES[(64 + p) * 65 + 16 * nt + n3];
        const float r0 = zr[q] * sr - zi[q] * si, i0 = zr[q] * si + zi[q] * sr; zr[q] = r0; zi[q] = i0; }
    const LAS bf16x8* Fl = (const LAS bf16x8*)L + tp * 64 + ln3;
    bf16_t* yp = (bf16_t*)(F.ws + WS_Y2) + ((size_t)b * SEQ + (16 * nt + n3) * 64 + tp) * 512 + g * 16 + 4 * kq3;
#pragma unroll
    for (int tt = 0; tt < 32; ++tt) {
        f32x4 acc = (f32x4){0.f, 0.f, 0.f, 0.f};
#pragma unroll
        for (int kk = 0; kk < 4; ++kk) { const float* z = (kk < 2) ? zr : zi; const int o8 = 8 * (kk & 1); v4u zw; zw.x = pk2(z[o8], z[o8 + 1]); zw.y = pk2(z[o8 + 2], z[o8 + 3]); zw.z = pk2(z[o8 + 4], z[o8 + 5]); zw.w = pk2(z[o8 + 6], z[o8 + 7]);
            acc = __builtin_amdgcn_mfma_f32_16x16x32_bf16(CF[kk], __builtin_bit_cast(bf16x8, zw), acc, 0, 0, 0); }
#pragma unroll
        for (int jp = 0; jp <= tt; ++jp) acc = __builtin_amdgcn_mfma_f32_16x16x32_bf16(Fl[128 * (tt - jp)], U[jp], acc, 0, 0, 0);
        typedef unsigned u32x2v __attribute__((ext_vector_type(2))); u32x2v o; o.x = pk2(gelu_tanh_f(acc.x), gelu_tanh_f(acc.y)); o.y = pk2(gelu_tanh_f(acc.z), gelu_tanh_f(acc.w));
        st8(yp + (size_t)(2 * tt) * 512, o);
        if (tt < 31) {
#pragma unroll
            for (int q = 0; q < 16; ++q) { const float r0 = zr[q] * a2r[q] - zi[q] * a2i[q], i0 = zr[q] * a2i[q] + zi[q] * a2r[q]; zr[q] = r0; zi[q] = i0; } }
        asm volatile("" ::: "memory"); }
    asm volatile("s_waitcnt lgkmcnt(0)\n\ts_barrier" ::: "memory");
    }
}
#undef SSM_HBATCH

__device__ __forceinline__ void attn_post(Frame& F, int b, int h, int qb, const bf16_t* Ob, bf16_t* OAb, float lam) {
    int ln = lane_id(); asm volatile("s_waitcnt vmcnt(0)" : "+v"(ln) :: "memory");
    const int row = b * SEQ + qb * 256 + F.wave * 32 + (ln >> 1), half = ln & 1;
    const bf16_t* p0 = Ob + (size_t)row * 1024 + h * 128 + half * 64; const bf16_t* p1 = p0 + 512;
    float o[64]; float ss = 0.f;
#pragma unroll
    for (int j = 0; j < 8; ++j) { const v4u a = *(const GAS v4u*)(p0 + 8 * j), c = *(const GAS v4u*)(p1 + 8 * j);
        const unsigned aw[4] = {a.x, a.y, a.z, a.w}, cw[4] = {c.x, c.y, c.z, c.w};
#pragma unroll
        for (int k = 0; k < 4; ++k) { const float x0 = __uint_as_float(aw[k] << 16) - lam * __uint_as_float(cw[k] << 16), x1 = __uint_as_float(aw[k] & 0xffff0000u) - lam * __uint_as_float(cw[k] & 0xffff0000u);
            o[8 * j + 2 * k] = x0; o[8 * j + 2 * k + 1] = x1; ss += x0 * x0 + x1 * x1; } }
    ss += __shfl_xor(ss, 1);
    const float r = rsqrtf(ss * (1.f / 128.f) + EPS) * (1.f - LAM_INIT);
    const float* sg = F.in[10] + half * 64; bf16_t* q = OAb + (size_t)row * 512 + h * 128 + half * 64;
#pragma unroll
    for (int j = 0; j < 8; ++j) { const f32x4 g0 = *(const f32x4*)(sg + 8 * j), g1 = *(const f32x4*)(sg + 8 * j + 4); v4u w;
        w.x = pk2(o[8 * j] * r * g0.x, o[8 * j + 1] * r * g0.y); w.y = pk2(o[8 * j + 2] * r * g0.z, o[8 * j + 3] * r * g0.w);
        w.z = pk2(o[8 * j + 4] * r * g1.x, o[8 * j + 5] * r * g1.y); w.w = pk2(o[8 * j + 6] * r * g1.z, o[8 * j + 7] * r * g1.w);
        st16(q + 8 * j, w); }
}
__device__ __forceinline__ void attn_phase(Frame& F, char* lds) {
    using abf = attn_body::bf16;
    const abf* Qb = (const abf*)(F.ws + WS_Q); const abf* Kb = (const abf*)(F.ws + WS_K); const abf* Vb = (const abf*)(F.ws + WS_V); abf* Ob = (abf*)(F.ws + WS_OB);
    const float lam = ((const float*)(F.ws + WS_SCAL))[0];
    for (int v = F.vcu; v < 256; v += F.G) {
    const int bh = v >> 3, s = v & 7, b = bh >> 2, h = bh & 3;
#pragma clang loop unroll(disable)
    for (int it = 0; it < 4; ++it) { const int qb = it < 2 ? s : 15 - s, c = it & 1;
        attn_body::attn_unit128<8>((long)b * SEQ, qb, Qb + (2 * h + c) * 64, Kb + (2 * h + c) * 64, Vb + h * 128, Ob + c * 512 + h * 128, lds, F.wave * 64 + lane_id());
        if (it & 1) attn_post(F, b, h, qb, (const bf16_t*)Ob, (bf16_t*)(F.ws + WS_OA), lam);
    }
    }
}

constexpr int LDS_TAB = LDSCTL_OFF + 1024;
__device__ __forceinline__ void router_phase(Frame& F) {
    LAS unsigned char* L = F.lds + RING_OFF; LAS unsigned* tab = (LAS unsigned*)(F.lds + LDS_TAB);
    { const GAS v4u* src = (const GAS v4u*)(F.ws + WS_WR);
#pragma unroll
      for (int i = 0; i < 12; ++i) ((LAS v4u*)L)[F.tid + 512 * i] = src[F.tid + 512 * i]; }
    const int lane = F.lane, m = lane & 15, kq = lane >> 4;
    LAS float* scr = (LAS float*)(L + 98304 + F.wave * 4096);
    const bf16_t* X1b = (const bf16_t*)(F.ws + WS_X1B); int* ltok = (int*)(F.ws + WS_LTOK); float* lw = (float*)(F.ws + WS_LW); float* lrs = (float*)(F.ws + WS_LR);
    for (int tile = F.vcu * NWAVES + F.wave; tile < T / 16; tile += F.G * NWAVES) {
        if (F.tid < 64) tab[192 + F.tid] = 0u; else if (F.tid < 176) tab[320 + F.tid - 64] = 0u;
        __syncthreads();
        const int row0 = tile * 16; const bf16_t* ap = X1b + (size_t)(row0 + m) * DM + 8 * kq;
        bf16x8 A[32];
#pragma unroll
        for (int ks = 0; ks < 32; ++ks) A[ks] = *(const GAS bf16x8*)(ap + 32 * ks);
        f32x4 acc[3]; float ss = 0.f;
#pragma unroll
        for (int q = 0; q < 3; ++q) acc[q] = (f32x4){0.f, 0.f, 0.f, 0.f};
#pragma unroll
        for (int ks = 0; ks < 32; ++ks) {
#pragma unroll
            for (int j = 0; j < 8; ++j) { const float v = bf2f((bf16_t)A[ks][j]); ss += v * v; }
#pragma unroll
            for (int q = 0; q < 3; ++q) acc[q] = __builtin_amdgcn_mfma_f32_16x16x32_bf16(A[ks], *(const LAS bf16x8*)(L + ((ks * 3 + q) * 64 + lane) * 16), acc[q], 0, 0, 0); }
        ss += __shfl_xor(ss, 16); ss += __shfl_xor(ss, 32);
        const float r = rsqrtf(ss * (1.f / DM) + EPS);
#pragma unroll
        for (int q = 0; q < 3; ++q)
#pragma unroll
            for (int i = 0; i < 4; ++i) scr[(4 * kq + i) * 49 + 16 * q + m] = acc[q][i];
        LDS_WAIT(); asm volatile("" ::: "memory");
        int l1 = 0, l2 = 0, rk1 = 0, rk2 = 0, pid = 0, rk3 = 0; float w1 = 0.f, w2 = 0.f;
        if (lane < 16) { const LAS float* lr = scr + lane * 49; const float* brg = F.in[24]; const float* bre = F.in[26];
            int grp = 0; float mx = lr[0] * r + brg[0]; float lg[4]; lg[0] = mx;
#pragma unroll
            for (int c = 1; c < 4; ++c) { lg[c] = lr[c] * r + brg[c]; if (lg[c] > mx) { mx = lg[c]; grp = c; } }
            float den = 0.f;
#pragma unroll
            for (int c = 0; c < 4; ++c) den += __expf(lg[c] - mx);
            const float pg = 1.f / den;
            const LAS float* le = lr + 4 + grp * 8; const float* be = bre + grp * 8;
            float v1 = -INFINITY, v2 = -INFINITY; int i1 = 0, i2 = 0;
#pragma unroll
            for (int e = 0; e < 8; ++e) { const float v = le[e] * r + be[e]; if (v > v1) { v2 = v1; i2 = i1; v1 = v; i1 = e; } else if (v > v2) { v2 = v; i2 = e; } }
            const float e2 = __expf(v2 - v1); w1 = pg / (1.f + e2); w2 = pg * e2 / (1.f + e2);
            l1 = grp * 8 + i1; l2 = 32 + grp * 8 + i2;
            rk1 = (int)__hip_atomic_fetch_add(tab + 192 + l1, 1u, __ATOMIC_RELAXED, __HIP_MEMORY_SCOPE_WORKGROUP); rk2 = (int)__hip_atomic_fetch_add(tab + 192 + l2, 1u, __ATOMIC_RELAXED, __HIP_MEMORY_SCOPE_WORKGROUP);
            { const int lo = i1 < i2 ? i1 : i2, hi = i1 < i2 ? i2 : i1; pid = grp * 28 + lo * 8 - (lo * (lo + 1)) / 2 + hi - lo - 1; }
            rk3 = (int)__hip_atomic_fetch_add(tab + 320 + pid, 1u, __ATOMIC_RELAXED, __HIP_MEMORY_SCOPE_WORKGROUP); }
        __syncthreads();
        if (F.tid < 64) { const unsigned c = tab[192 + F.tid]; tab[256 + F.tid] = c ? __hip_atomic_fetch_add(F.ctl + CW_CNT + 64 * F.tid, c, RLX_AGENT) : 0u; }
        else if (F.tid < 176) { const int q = F.tid - 64; const unsigned c = tab[320 + q]; tab[432 + q] = c ? __hip_atomic_fetch_add(F.ctl + CW_CNT2 + 64 * q, c, RLX_AGENT) : 0u; }
        __syncthreads();
        if (lane < 16) { const int row = row0 + lane; const size_t p1 = (size_t)l1 * T + tab[256 + l1] + rk1, p2 = (size_t)l2 * T + tab[256 + l2] + rk2;
            ltok[p1] = row; lw[p1] = w1; lrs[p1] = r; ltok[p2] = row; lw[p2] = w2; lrs[p2] = r;
            ((int*)(F.ws + WS_PTOK))[(size_t)pid * T + tab[432 + pid] + rk3] = row;
            ((int4*)(F.ws + WS_RINFO))[row] = make_int4(l1, (int)(tab[256 + l1] + rk1), l2, (int)(tab[256 + l2] + rk2)); }
        __syncthreads();
    }
}
struct MoeUnit { int mt, l, tl, pn, cnt, ord; };
template <bool GATHER_> struct MoeSched {
    using U = MoeUnit; static constexpr bool GATHER = GATHER_;
    const LAS unsigned* tab; const LAS unsigned* tokbuf; int G, c, npn, l_lo, l_hi, rowbytes; const int* ltok; const char* Bbase; size_t bexp, bpn; int u_lo, u_hi;
    __device__ __forceinline__ int rd(int i) const { return __builtin_amdgcn_readfirstlane((int)tab[i]); }
    __device__ __forceinline__ bool next(int i, U& u) const {
        const int mt_lo = rd(64 + l_lo), mt_hi = rd(64 + l_hi); long Lidx;
        if ((G & 15) == 0) { const int mr = (c >> 4) * 8 + (c & 7), pn_ = (c >> 3) & 1; Lidx = (long)u_lo + (long)i * G + 2 * mr + pn_; } else Lidx = (long)u_lo + (long)i * G + c;
        if (Lidx >= (long)(mt_hi - mt_lo) * npn || Lidx >= (long)u_hi) return false;
        const int mt = mt_lo + (int)(Lidx / npn); u.pn = (int)(Lidx % npn); u.mt = mt; const int l = rd(320 + mt);
        u.l = l; u.tl = mt - rd(64 + l); u.cnt = rd(l); u.ord = i; return true; }
    __device__ __forceinline__ unsigned a_off(const U& u, int r) const { return tokbuf[(u.ord & 7) * 256 + r] * (unsigned)rowbytes; }
    __device__ __forceinline__ size_t a_base(const U& u) const { return (size_t)u.mt * 256 * (size_t)rowbytes; }
    __device__ __forceinline__ const char* b_ptr(const U& u) const { return Bbase + (size_t)(u.l & 31) * bexp + (size_t)u.pn * bpn; }
};
__device__ __forceinline__ void moe_tables(Frame& F) {
    LAS unsigned* tab = (LAS unsigned*)(F.lds + LDS_TAB);
    if (F.tid < 64) { const unsigned c = __hip_atomic_load(F.ctl + CW_CNT + 64 * F.tid, RLX_AGENT), t = (c + 255u) >> 8; unsigned inc = t;
#pragma unroll
        for (int o = 1; o < 64; o <<= 1) { const unsigned v = __shfl_up(inc, o); if ((F.tid & 63) >= o) inc += v; }
        tab[F.tid] = c; tab[64 + F.tid] = inc - t; if (F.tid == 63) tab[128] = inc;
        for (unsigned mt = inc - t; mt < inc && mt < 336u; ++mt) tab[320 + mt] = (unsigned)F.tid; }
    __syncthreads();
}
constexpr int LDS_TOK = LDSCTL_OFF + 4096;
template <class S_> __device__ __forceinline__ void moe_stage_tokens(Frame& F, const S_& S) {
    LAS unsigned* tb = (LAS unsigned*)(F.lds + LDS_TOK);
#pragma unroll
    for (int base = 0; base < 8; base += 4) { const int i = base + (F.tid >> 7), r0 = F.tid & 127; MoeUnit u;
        if (S.next(i, u)) { const int p0 = u.tl * 256 + r0, p1 = p0 + 128; const int* lt = S.ltok + (size_t)u.l * T;
            const unsigned a = p0 < u.cnt ? (unsigned)lt[p0] : 0u, b = p1 < u.cnt ? (unsigned)lt[p1] : 0u; tb[i * 256 + r0] = a; tb[i * 256 + r0 + 128] = b; } }
    __syncthreads();
}
struct EpiMoe1 {
    static constexpr bool PERM = true, AFTER_DRAIN = false;
    const float* lw; const float* lrs; unsigned char* Hb; float wsc;
    __device__ __forceinline__ void operator()(const pg8::f32x4 (&acc)[2][2][4][2], const MoeUnit& u, int wr, int wc, int fr, int fq) const {
        int lane_ = fr + 16 * fq; asm volatile("" : "+v"(lane_)); fr = lane_ & 15; fq = lane_ >> 4;
        const int col = u.pn * 128 + wc * 32 + 8 * fq;
        float wv[2][4], rv[2][4];
#pragma unroll
        for (int ai = 0; ai < 2; ++ai)
#pragma unroll
            for (int m = 0; m < 4; ++m) { const size_t p = (size_t)u.l * T + u.tl * 256 + ai * 128 + wr * 64 + m * 16 + fr; wv[ai][m] = lw[p]; rv[ai][m] = lrs[p] * wsc; }
#pragma unroll
        for (int ai = 0; ai < 2; ++ai)
#pragma unroll
            for (int m = 0; m < 4; ++m) { const int r = ai * 128 + wr * 64 + m * 16 + fr; const float w = wv[ai][m], rs = rv[ai][m];
                const f32x4 ga = acc[ai][0][m][0] * rs, gb = acc[ai][0][m][1] * rs, ua = acc[ai][1][m][0] * (rs * w * H_SCALE), ub = acc[ai][1][m][1] * (rs * w * H_SCALE); wt_v2u o;
                o.x = pk4_fp8(ga.x * fast_sigmoid(ga.x) * ua.x, ga.y * fast_sigmoid(ga.y) * ua.y, ga.z * fast_sigmoid(ga.z) * ua.z, ga.w * fast_sigmoid(ga.w) * ua.w);
                o.y = pk4_fp8(gb.x * fast_sigmoid(gb.x) * ub.x, gb.y * fast_sigmoid(gb.y) * ub.y, gb.z * fast_sigmoid(gb.z) * ub.z, gb.w * fast_sigmoid(gb.w) * ub.w);
                pst8(Hb + ((size_t)u.mt * 256 + r) * 256 + col, o); }
    }
};
constexpr int P2_CNT = 130, P2_PREFIX = 242, P2_MAP = 356, P2_PAIR = 724;
__device__ __forceinline__ void moe_tables2(Frame& F) {
    LAS unsigned* tab = (LAS unsigned*)(F.lds + LDS_TAB);
    if (F.tid < 64) { const int ln = F.tid;
        const unsigned c0 = __hip_atomic_load(F.ctl + CW_CNT2 + 64 * ln, RLX_AGENT), c1 = ln < 48 ? __hip_atomic_load(F.ctl + CW_CNT2 + 64 * (64 + ln), RLX_AGENT) : 0u;
        const unsigned t0 = (c0 + 255u) >> 8, t1 = (c1 + 255u) >> 8; unsigned i0 = t0, i1 = t1;
#pragma unroll
        for (int o = 1; o < 64; o <<= 1) { const unsigned v0 = __shfl_up(i0, o), v1 = __shfl_up(i1, o); if (ln >= o) { i0 += v0; i1 += v1; } }
        const unsigned tot0 = __shfl(i0, 63), lo0 = i0 - t0, lo1 = tot0 + i1 - t1;
        tab[P2_CNT + ln] = c0; tab[P2_PREFIX + ln] = lo0;
        for (unsigned mt = lo0; mt < lo0 + t0 && mt < 368u; ++mt) tab[P2_MAP + mt] = (unsigned)ln;
        if (ln < 48) { tab[P2_CNT + 64 + ln] = c1; tab[P2_PREFIX + 64 + ln] = lo1; for (unsigned mt = lo1; mt < lo1 + t1 && mt < 368u; ++mt) tab[P2_MAP + mt] = (unsigned)(64 + ln); }
        if (ln == 47) tab[P2_PREFIX + 112] = lo1 + t1; }
    else if (F.tid >= 128 && F.tid < 156) { const int k = F.tid - 128; int lo = 0, off = 0; while (k >= off + 7 - lo) { off += 7 - lo; ++lo; } tab[P2_PAIR + k] = (unsigned)(lo | ((lo + 1 + k - off) << 8)); }
    __syncthreads();
}
struct PairUnit { int mt, pid, tl, pn, cnt, ord; };
struct PairSched {
    using U = PairUnit;
    const LAS unsigned* tab; const LAS unsigned* tokbuf; int G, c; const char* Wd;
    __device__ __forceinline__ int rd(int i) const { return __builtin_amdgcn_readfirstlane((int)tab[i]); }
    __device__ __forceinline__ bool next(int i, U& u) const {
        int mt, pn;
        if ((G & 31) == 0) { const int slot = c >> 3, per = G >> 2; int w = (slot >> 2) * 8 + (c & 7) + (i & 1); w = w >= per ? w - per : w; mt = i * per + w; pn = slot & 3; }
        else { const long idx = (long)i * G + c; mt = (int)(idx >> 2); pn = (int)(idx & 3); }
        if (i >= 4 || mt >= rd(P2_PREFIX + 112)) return false;
        u.mt = mt; u.pn = pn; const int pid = rd(P2_MAP + mt); u.pid = pid; u.tl = mt - rd(P2_PREFIX + pid); u.cnt = rd(P2_CNT + pid); u.ord = i; return true; }
    __device__ __forceinline__ unsigned a_off(const U& u, int set, int r) const { return tokbuf[((u.ord & 3) * 2 + set) * 256 + r]; }
    __device__ __forceinline__ const char* b_ptr(const U& u, int set) const { const int g = u.pid / 28, pe = rd(P2_PAIR + u.pid - g * 28), e = g * 8 + (set ? (pe >> 8) : (pe & 255));
        return Wd + (size_t)e * ((size_t)DM * 256) + (size_t)u.pn * ((size_t)256 * 256); }
};
__device__ __forceinline__ void moe_stage_pairs(Frame& F, const PairSched& S) {
    LAS unsigned* tb = (LAS unsigned*)(F.lds + LDS_TOK); const LAS unsigned* tab = (const LAS unsigned*)(F.lds + LDS_TAB);
    const int* ptok = (const int*)(F.ws + WS_PTOK); const int4* rinfo = (const int4*)(F.ws + WS_RINFO);
    const int i = F.tid >> 7, r0 = F.tid & 127; PairUnit u;
    if (S.next(i, u)) { int tk[2]; int4 ri[2];
#pragma unroll
        for (int h = 0; h < 2; ++h) { const int p = u.tl * 256 + r0 + 128 * h; tk[h] = p < u.cnt ? ptok[(size_t)u.pid * T + p] : -1; }
#pragma unroll
        for (int h = 0; h < 2; ++h) ri[h] = rinfo[tk[h] < 0 ? 0 : tk[h]];
#pragma unroll
        for (int h = 0; h < 2; ++h) { const unsigned r1 = (tab[64 + ri[h].x] * 256u + (unsigned)ri[h].y) * 256u, r2 = (tab[64 + ri[h].z] * 256u + (unsigned)ri[h].w) * 256u;     const bool f = (ri[h].x & 31) < (ri[h].z & 31), ok = tk[h] >= 0;
            const int r = r0 + 128 * h; tb[(i * 2 + 0) * 256 + r] = ok ? (f ? r1 : r2) : 0u; tb[(i * 2 + 1) * 256 + r] = ok ? (f ? r2 : r1) : 0u; tb[2048 + i * 256 + r] = (unsigned)tk[h]; } }
    __syncthreads();
}
struct EpiPair {
    static constexpr bool PERM = true, AFTER_DRAIN = false;
    const LAS int* toks; const bf16_t* X1b; float* out; float sc;
    __device__ __forceinline__ void operator()(const pg8::f32x4 (&acc)[2][2][4][2], const PairUnit& u, int wr, int wc, int fr, int fq) const {
        const int lane_ = lane_id(); fr = lane_ & 15; fq = lane_ >> 4;
        const int col0 = u.pn * 256 + wc * 32 + 8 * fq;
        int tok[2][4];
#pragma unroll
        for (int ai = 0; ai < 2; ++ai)
#pragma unroll
            for (int m = 0; m < 4; ++m) tok[ai][m] = toks[(u.ord & 3) * 256 + ai * 128 + wr * 64 + m * 16 + fr];
        v4u xv[2][4][2];
#pragma unroll
        for (int ai = 0; ai < 2; ++ai)
#pragma unroll
            for (int m = 0; m < 4; ++m)
#pragma unroll
                for (int bj = 0; bj < 2; ++bj) xv[ai][m][bj] = *(const v4u*)(X1b + (size_t)(tok[ai][m] < 0 ? 0 : tok[ai][m]) * DM + col0 + bj * 128);
#pragma unroll
        for (int ai = 0; ai < 2; ++ai) {
#pragma unroll
            for (int m = 0; m < 4; ++m) if (tok[ai][m] >= 0) {
#pragma unroll
                for (int bj = 0; bj < 2; ++bj) { const v4u x = xv[ai][m][bj]; f32x4 a = acc[ai][bj][m][0] * sc, b = acc[ai][bj][m][1] * sc;
                    a.x += __uint_as_float(x.x << 16); a.y += __uint_as_float(x.x & 0xffff0000u); a.z += __uint_as_float(x.y << 16); a.w += __uint_as_float(x.y & 0xffff0000u);
                    b.x += __uint_as_float(x.z << 16); b.y += __uint_as_float(x.z & 0xffff0000u); b.z += __uint_as_float(x.w << 16); b.w += __uint_as_float(x.w & 0xffff0000u);
                    float* o = out + (size_t)tok[ai][m] * DM + col0 + bj * 128; pst16(o, __builtin_bit_cast(v4u, a)); pst16(o + 4, __builtin_bit_cast(v4u, b)); } } }
    }
};
struct Args { const float* in[30]; float* out; unsigned char* ws; int ph_lo, ph_hi, li, use_bar; };
constexpr int N_PHASES = 12;
template <int LO, int HI> __global__ void __launch_bounds__(NWAVES * 64, 2) skel_fwd(Args args) {
    extern __shared__ __attribute__((aligned(16))) unsigned char lds[];
    Frame F;
    F.lds = (LAS unsigned char*)lds;
    F.MISC = (volatile LAS unsigned*)(F.lds + MISC_OFF);
    const int wave0 = __builtin_amdgcn_readfirstlane((int)threadIdx.x >> 6);
#define MKTID (wave0 * 64 + lane_id())
    F.tid = MKTID; F.lane = F.tid & 63; F.wave = wave0;
    F.G = gridDim.x; { const int bx = blockIdx.x; F.vcu = (F.G % 8 == 0) ? (bx % 8) * (F.G / 8) + bx / 8 : bx; }
    F.ws = args.ws; F.ctl = (gu32*)(args.ws + WS_CTL); F.out = args.out;
#pragma unroll
    for (int i = 0; i < 30; ++i) F.in[i] = args.in[i];
    for (int u = F.tid; u < (LDS_BYTES - LDSCTL_OFF) / 4; u += NWAVES * 64) ((LAS unsigned*)(F.lds + LDSCTL_OFF))[u] = 0u;
    __syncthreads();
    XcdBarrier bar; bar.bar = (unsigned*)(F.ctl + CW_BAR); bar.x = 0; bar.st = nullptr;
    if (args.use_bar) bar = xcd_barrier_post((unsigned*)(F.ctl + CW_BAR), F.MISC + 8, MKTID);
#define GRID_BAR() do { if (args.use_bar) xcd_barrier(bar, MKTID); } while (0)
    constexpr int lo = LO, hi = HI;
#define IN(k) (lo <= (k) && (k) < hi)
#define REFRESH() do { int t_ = MKTID; asm volatile("" : "+v"(t_)); F.tid = t_; F.lane = t_ & 63; F.wave = wave0; } while (0)
#define BOTH(k) (IN(k) && IN((k) + 1))

    if (IN(0)) { REFRESH(); p0_prologue(F); if (BOTH(0)) GRID_BAR(); }

    if (IN(1)) {
        const int nw = (T / 256) * 8;
        { pg8::Gemm g{(const bf16_t*)(F.ws + WS_XN), (const bf16_t*)(F.ws + WS_WIN), T, IN_COLS / 2, DM}; RotOrder S; S.so.init(T, IN_COLS / 2, F.G, (int)blockIdx.x);
          S.n = (nw % F.G == 0) ? nw / F.G : 0; S.rot = S.n ? (int)((blockIdx.x >> 3) % (unsigned)S.n) : 0; if (S.n == 0) S.n = 1 << 30;
          EpiInT<0> E{(bf16_t*)(F.ws + WS_Q), (bf16_t*)(F.ws + WS_K), (bf16_t*)(F.ws + WS_V), (bf16_t*)(F.ws + WS_U), (bf16_t*)(F.ws + WS_G), (const float*)(F.ws + WS_ROPE), F.in[4], F.in[5], 1.f};
          pg8::gemm_phase<EpiInT<0>, RotOrder, PG8_ALIGN, PG8_SP2>(F.lds + RING_OFF, g, S, E, MKTID); }
        { pg8::Gemm g{(const bf16_t*)(F.ws + WS_XN8), (const bf16_t*)(F.ws + WS_WG8), T, IN_COLS / 2, DM / 2}; RotOrder S; S.so.init(T, IN_COLS / 2, F.G, (int)blockIdx.x);
          S.n = (nw % F.G == 0) ? nw / F.G : 0; S.rot = S.n ? (int)((blockIdx.x >> 3) % (unsigned)S.n) : 0; if (S.n == 0) S.n = 1 << 30;
          EpiInT<8> E{(bf16_t*)(F.ws + WS_Q), (bf16_t*)(F.ws + WS_K), (bf16_t*)(F.ws + WS_V), (bf16_t*)(F.ws + WS_U), (bf16_t*)(F.ws + WS_G), (const float*)(F.ws + WS_ROPE), F.in[4], F.in[5], 1.f / GATE_WSCALE};
          pg8::gemm_phase<EpiInT<8>, RotOrder, PG8_ALIGN, PG8_SP2, true>(F.lds + RING_OFF, g, S, E, MKTID); }
        if (BOTH(1)) GRID_BAR();
    }
    if (IN(2)) { REFRESH(); ssm_phase(F); }
    if (IN(3)) { REFRESH(); attn_phase(F, (char*)lds + RING_OFF); if (BOTH(3)) GRID_BAR(); }
    if (IN(4)) {
        pg8::Gemm g{(const bf16_t*)(F.ws + WS_OA), (const bf16_t*)(F.ws + WS_WO), 2 * T, 3072, 512}; ChainOrder S; S.so.init(T, DM, F.G, (int)blockIdx.x);
        EpiOAGlu E{EpiOA{(const bf16_t*)(F.ws + WS_G), (bf16_t*)(F.ws + WS_MA)}, EpiGlu{(const bf16_t*)(F.ws + WS_G), (const bf16_t*)(F.ws + WS_MA), (bf16_t*)(F.ws + WS_MG)}};
        pg8::gemm_phase<EpiOAGlu, ChainOrder, PG8_ALIGN, PG8_SP2>(F.lds + RING_OFF, g, S, E, MKTID);
        if (IN(6)) GRID_BAR();
    }
    if (IN(6)) {
        pg8::Gemm g{(const bf16_t*)(F.ws + WS_MG), (const bf16_t*)(F.ws + WS_WOUT), T, DM, DM}; pg8::StaticOrder S; S.init(T, DM, F.G, (int)blockIdx.x);
        EpiOut E{F.in[0], F.out, (bf16_t*)(F.ws + WS_X1B), F.ws + WS_X1B8};
        REFRESH(); const int late = F.vcu & 1, gwp = (F.vcu >> 1) * NWAVES + F.wave, ngwp = (F.G >> 1) * NWAVES;
        if ((F.G & 1) == 0 && late) { expert_weights_items(F, 2 * gwp + 1, 2 * ngwp); }
        pg8::gemm_phase<EpiOut, pg8::StaticOrder, PG8_ALIGN, PG8_SP2>(F.lds + RING_OFF, g, S, E, MKTID);
        REFRESH();
        if ((F.G & 1) != 0) expert_weights_items(F, F.vcu * NWAVES + F.wave, F.G * NWAVES); else if (!late) expert_weights_items(F, 2 * gwp, 2 * ngwp);
        if (BOTH(6)) GRID_BAR();
    }
    if (IN(7)) { REFRESH(); router_phase(F); if (BOTH(7)) GRID_BAR(); }
    if (IN(8)) { REFRESH(); moe_tables(F);
        MoeSched<true> S{(const LAS unsigned*)(F.lds + LDS_TAB), (const LAS unsigned*)(F.lds + LDS_TOK), F.G, (int)blockIdx.x, 2, 0, 64, DM, (const int*)(F.ws + WS_LTOK), (const char*)(F.ws + WS_WGU), (size_t)512 * DM, (size_t)256 * DM, 0, 1 << 30};
        moe_stage_tokens(F, S);
        EpiMoe1 E{(const float*)(F.ws + WS_LW), (const float*)(F.ws + WS_LR), F.ws + WS_HB, 1.f / GATE_WSCALE};
        pg8::gemm_phase_x<EpiMoe1, MoeSched<true>, true, true>(F.lds + RING_OFF, (const char*)(F.ws + WS_X1B8), DM / 2, S, E, MKTID);
        if (BOTH(8)) GRID_BAR(); }
    if (IN(9)) { REFRESH(); moe_tables(F); moe_tables2(F);
        PairSched S{(const LAS unsigned*)(F.lds + LDS_TAB), (const LAS unsigned*)(F.lds + LDS_TOK), F.G, (int)blockIdx.x, (const char*)(F.ws + WS_WD)};
        moe_stage_pairs(F, S);
        EpiPair E{(const LAS int*)(F.lds + LDS_TOK + 8192), (const bf16_t*)(F.ws + WS_X1B), F.out, 1.f / (H_SCALE * WD_SCALE)};
        pg8::gemm_phase_pair<EpiPair, PairSched, true, true>(F.lds + RING_OFF, (const char*)(F.ws + WS_HB), S, E, MKTID); }
#undef IN
#undef BOTH
}
#ifndef MK_PER_PHASE
#define MK_PER_PHASE 0
#endif
template <int LO, int HI> static bool launch_phases(const Args& a, int grid, hipStream_t stream) {
    static bool attr = false;
    if (!attr) { if (hipFuncSetAttribute((const void*)skel_fwd<LO, HI>, hipFuncAttributeMaxDynamicSharedMemorySize, LDS_BYTES) != hipSuccess) { fprintf(stderr, "kernel_launch: hipFuncSetAttribute failed (%d bytes of dynamic LDS)\n", LDS_BYTES); return false; } attr = true; }
    hipLaunchKernelGGL((skel_fwd<LO, HI>), dim3(grid), dim3(NWAVES * 64), LDS_BYTES, stream, a);
    const hipError_t le = hipPeekAtLastError();
    if (le != hipSuccess) { fprintf(stderr, "kernel_launch: launch of phases [%d,%d) failed: %s\n", LO, HI, hipGetErrorName(le)); return false; }
    return true;
}
extern "C" void kernel_launch(void* const* d_in, const int* in_sizes, int n_in, void* d_out, int out_size, void* d_ws, size_t ws_size, hipStream_t stream) {
    static int grid = 0;
    if (grid == 0) {
        if (n_in != 30 || in_sizes[0] != T * DM || out_size != T * DM || ws_size < WS_END) { fprintf(stderr, "kernel_launch: unexpected shapes: n_in %d, out %d, ws %zu; nothing launched\n", n_in, out_size, ws_size); grid = -1; return; }
        int dev = 0, cus = 0;
        if (hipGetDevice(&dev) != hipSuccess || hipDeviceGetAttribute(&cus, hipDeviceAttributeMultiprocessorCount, dev) != hipSuccess || cus < 8) { fprintf(stderr, "kernel_launch: device query failed; nothing launched\n"); grid = -1; return; }
        grid = cus > 256 ? 256 : cus;
    }
    if (grid < 0) return;
    if (hipMemsetAsync((char*)d_ws + WS_CTL, 0, CTL_ZERO_BYTES, stream) != hipSuccess) { fprintf(stderr, "kernel_launch: hipMemsetAsync failed\n"); return; }
    Args a{};
    for (int i = 0; i < 30; ++i) a.in[i] = (const float*)d_in[i];
    a.out = (float*)d_out; a.ws = (unsigned char*)d_ws;
#if MK_PER_PHASE
    a.use_bar = 0;
    launch_phases<0, 1>(a, grid, stream) && launch_phases<1, 2>(a, grid, stream) && launch_phases<2, 4>(a, grid, stream) && launch_phases<4, 5>(a, grid, stream) && launch_phases<5, 6>(a, grid, stream) &&
        launch_phases<6, 7>(a, grid, stream) && launch_phases<7, 8>(a, grid, stream) && launch_phases<8, 9>(a, grid, stream) && launch_phases<9, 10>(a, grid, stream) && launch_phases<10, 11>(a, grid, stream);
#else
    a.use_bar = 1; a.ph_lo = 0; a.ph_hi = 11;
    launch_phases<0, 11>(a, grid, stream);
#endif
}
```

```cpp
#include <hip/hip_runtime.h>
#include <hip/hip_bf16.h>
#include <cstdio>
#include <cstdint>
#include <cmath>

constexpr int DM = 1024, BATCH = 8, SEQ = 4096, T = BATCH * SEQ;
constexpr int IN_COLS = 4096;
constexpr float EPS = 1e-6f, ROPE_THETA = 500000.0f, LAM_INIT = 0.2f;
constexpr float QSCALE = 0.125f * 1.4426950408889634f;
typedef unsigned short bf16_t;
__device__ __forceinline__ float bf2f(bf16_t v) { return __uint_as_float(((unsigned)v) << 16); }
__device__ __forceinline__ bf16_t f2bf(float f) { unsigned u = __float_as_uint(f); return (bf16_t)((u + 0x7fffu + ((u >> 16) & 1u)) >> 16); }

#ifndef WT_STORES
#define WT_STORES 0
#endif
typedef unsigned wt_v4u __attribute__((ext_vector_type(4))); typedef unsigned wt_v2u __attribute__((ext_vector_type(2)));
__device__ __forceinline__ void st16(void* p, wt_v4u v) { if (WT_STORES) asm volatile("global_store_dwordx4 %0, %1, off sc1\n\ts_nop 1" :: "v"(p), "v"(v) : "memory"); else *(wt_v4u*)p = v; }
__device__ __forceinline__ void st8(void* p, wt_v2u v) { if (WT_STORES) asm volatile("global_store_dwordx2 %0, %1, off sc1\n\ts_nop 1" :: "v"(p), "v"(v) : "memory"); else *(wt_v2u*)p = v; }
__device__ __forceinline__ void pst16(void* p, wt_v4u v) { *(wt_v4u*)p = v; }
__device__ __forceinline__ void pst8(void* p, wt_v2u v) { *(wt_v2u*)p = v; }
#define ATTN_STORE16(p,v) st16((void*)(p), (v))

constexpr size_t MiB = 1u << 20;
constexpr size_t WS_CTL = 0, CTL_ZERO_BYTES = 1 * MiB;
constexpr size_t WS_SCAL = 1 * MiB, WS_ROPE = 2 * MiB, WS_WIN = 4 * MiB, WS_WO = 12 * MiB, WS_WGLU = 13 * MiB, WS_WOUT = 15 * MiB, WS_WGU = 17 * MiB, WS_WD = 49 * MiB,
                 WS_WR = 65 * MiB, WS_SSMF = 66 * MiB, WS_SSMG = 68 * MiB, WS_SSMH = 76 * MiB, WS_SSMA = 84 * MiB, WS_RINFO = 85 * MiB, WS_LISTS = 86 * MiB;
constexpr size_t WS_XN = 96 * MiB, WS_Q = 160 * MiB, WS_K = 192 * MiB, WS_V = 224 * MiB, WS_U = 256 * MiB, WS_G = 288 * MiB, WS_OA = 416 * MiB, WS_Y2 = 448 * MiB, WS_END = 480 * MiB;
constexpr size_t WS_OB = WS_XN, WS_X1B = WS_OA, WS_MA = WS_Q, WS_MG = WS_V, WS_HB = WS_G;
constexpr size_t WS_XN8 = 416 * MiB, WS_WG8 = 8 * MiB, WS_SA = 1 * MiB + 256 * 1024, WS_SW = 1 * MiB + 512 * 1024;
constexpr size_t WS_XN8_LEGACY = 0;
constexpr size_t WS_X1B8 = 96 * MiB;
constexpr size_t WS_PTOK = 360 * MiB;
constexpr size_t WS_LTOK = 332 * MiB, WS_LW = 340 * MiB, WS_LR = 348 * MiB;
namespace pg8 {
#define PG8_LAS __attribute__((address_space(3)))
typedef unsigned short bf16_t;
typedef short bf16x8 __attribute__((ext_vector_type(8)));
typedef float f32x4 __attribute__((ext_vector_type(4)));
typedef unsigned u32x4 __attribute__((ext_vector_type(4)));
constexpr int BM = 256, BK = 64, HALF = 128, HTB = HALF * BK * 2  , STAGE_BYTES = 8 * HTB, NXCD = 8, WGM = 8;

__host__ __device__ __forceinline__ int lds_byte(int r, int c) { const int st = (r >> 4) * 2 + (c >> 5), rr = r & 15, cc = c & 31, ob = rr * 64 + cc * 2; return st * 1024 + (ob ^ (((ob >> 9) & 1) << 5)); }
__host__ __device__ __forceinline__ void stage_rc(int b, int& R, int& C) { const int st = b / 1024, sb = b % 1024, swz = sb ^ (((sb >> 9) & 1) << 5); R = (st >> 1) * 16 + swz / 64; C = (st & 1) * 32 + (swz % 64) / 2; }
__host__ __device__ __forceinline__ int perm32(int rho) { const int n = rho >> 4, i = rho & 15; return 8 * (i >> 2) + 4 * n + (i & 3); }

struct Unit { int pm, pn; };
struct Gemm { const bf16_t* A; const bf16_t* Bt; int M, N, K; };

struct StaticOrder {
    int nM, nN, nwg, G, c;
    __host__ __device__ void init(int M, int N, int G_, int c_) { nM = M / BM; nN = N / BM; nwg = nM * nN; G = G_; c = c_; }
    __host__ __device__ bool next(int i, Unit& u) const {
        const long L = (long)i * G + c; if (L >= nwg) return false;
        int wgid = (int)L; { const int q = nwg / NXCD, r = nwg % NXCD, xcd = wgid % NXCD, off = wgid / NXCD; wgid = (xcd < r ? xcd * (q + 1) : r * (q + 1) + (xcd - r) * q) + off; }
        const int nig = WGM * nN, gid = wgid / nig, fm = gid * WGM, gsz = (nM - fm) < WGM ? (nM - fm) : WGM;
        u.pm = fm + ((wgid % nig) % gsz); u.pn = (wgid % nig) / gsz; return true;
    }
    __device__ __forceinline__ void a_ready(const Unit&) const {}
    __device__ __forceinline__ void done(const Unit&) const {}
};

__device__ __forceinline__ unsigned cvt_pk_bf16(float lo, float hi) { unsigned r; asm volatile("v_cvt_pk_bf16_f32 %0, %1, %2" : "=v"(r) : "v"(lo), "v"(hi)); return r; }
typedef float f32x2 __attribute__((ext_vector_type(2)));
__device__ __forceinline__ f32x2 gelu_pk(f32x2 v) {
    const f32x2 av = __builtin_elementwise_abs(v), d = av * 0.2316418882f + 1.0f;
    f32x2 t; t.x = __builtin_amdgcn_rcpf(d.x); t.y = __builtin_amdgcn_rcpf(d.y);
    f32x2 q = t * 0.5307027145f + (-0.7265760135f); q = q * t + 0.7107068705f; q = q * t + (-0.142248368f); q = q * t + 0.127414796f; q = q * t;
    const f32x2 s = (v * v) * (-0.72134752044f);
    f32x2 e; e.x = __builtin_amdgcn_exp2f(s.x); e.y = __builtin_amdgcn_exp2f(s.y);
    const f32x2 m = v * (q * e), r = v - m;
    f32x2 o; o.x = v.x < 0.f ? m.x : r.x; o.y = v.y < 0.f ? m.y : r.y; return o;
}

template <int ACT  > struct EpiBf16 {
    static constexpr bool PERM = true, AFTER_DRAIN = false; static_assert(ACT == 0 || ACT == 1, "EpiBf16: ACT is 0 (none) or 1 (gelu_pk)");
    bf16_t* O; int ldc; const float* bias; int split_cols; size_t split_stride; float scale0;
    __device__ __forceinline__ void operator()(const f32x4 (&acc)[2][2][4][2], const Unit& u, int wr, int wc, int fr, int fq) const {
        const int row0 = u.pm * BM + wr * 64 + fr; int colt = u.pn * BM; bf16_t* base = O;
        float sc = 1.f; if (split_cols) { const int t = colt / split_cols; base += (size_t)t * split_stride; colt -= t * split_cols; if (t == 0) sc = scale0; }
        const int col0 = colt + wc * 32 + 8 * fq, bcol0 = u.pn * BM + wc * 32 + 8 * fq;
        f32x4 bv[2][2];
#pragma unroll
        for (int bj = 0; bj < 2; ++bj)
#pragma unroll
            for (int n = 0; n < 2; ++n) bv[bj][n] = bias ? *(const f32x4*)(bias + bcol0 + bj * HALF + 4 * n) : (f32x4){0.f, 0.f, 0.f, 0.f};
#pragma unroll
        for (int ai = 0; ai < 2; ++ai)
#pragma unroll
            for (int m = 0; m < 4; ++m) { bf16_t* rowp = base + (size_t)(row0 + ai * HALF + m * 16) * ldc + col0;
#pragma unroll
                for (int bj = 0; bj < 2; ++bj) { f32x4 v0 = acc[ai][bj][m][0] + bv[bj][0], v1 = acc[ai][bj][m][1] + bv[bj][1];
                    if (ACT == 1) { f32x2 a = gelu_pk((f32x2){v0[0], v0[1]}), b = gelu_pk((f32x2){v0[2], v0[3]}), c = gelu_pk((f32x2){v1[0], v1[1]}), d = gelu_pk((f32x2){v1[2], v1[3]});
                        v0 = (f32x4){a.x, a.y, b.x, b.y}; v1 = (f32x4){c.x, c.y, d.x, d.y}; }
                    v0 = v0 * sc; v1 = v1 * sc; u32x4 w; w.x = cvt_pk_bf16(v0[0], v0[1]); w.y = cvt_pk_bf16(v0[2], v0[3]); w.z = cvt_pk_bf16(v1[0], v1[1]); w.w = cvt_pk_bf16(v1[2], v1[3]);
                    *(u32x4*)(rowp + bj * HALF) = w; } }
    }
};

template <class Epi, class Sched, bool ALIGN_EPI = false, bool SP2 = false, bool FP8 = false, bool INT8 = false>
__device__ __forceinline__ void gemm_phase(PG8_LAS unsigned char* lds, const Gemm g, const Sched& S, const Epi& E, const int tid0) {
    int tid_ = tid0; asm volatile("" : "+v"(tid_));
    const int tid = tid_, wid = __builtin_amdgcn_readfirstlane(tid >> 6), lane = tid & 63, wr = wid >> 2, wc = wid & 3, fr = lane & 15, fq = lane >> 4;
    const int K = g.K; int nt_ = K / BK; if constexpr (FP8) asm volatile("" : "+s"(nt_));
    const int nt = nt_;
    unsigned voffA[2], voffB[2];
#pragma unroll
    for (int i = 0; i < 2; ++i) { int R, C; stage_rc(tid * 16 + i * 8192, R, C); const int Rb = Epi::PERM ? ((R & ~31) + perm32(R & 31)) : R;
        voffA[i] = (unsigned)(R * K + C) * 2u; voffB[i] = (unsigned)(Rb * K + C) * 2u; }
    const size_t kstep = (size_t)(BK * 2);
    const size_t hstep = (size_t)HALF * K * 2;
    const size_t tstep = 2 * hstep;
    const unsigned ldsw = (unsigned)wid * 1024u;
    const int aoff = lds_byte(wr * 64 + fr, fq * 8), boff = lds_byte(wc * 32 + fr, fq * 8);
#define PG8_SA(b, h) (((b) * 2 + (h)) * HTB)
#define PG8_SB(b, h) ((4 + (b) * 2 + (h)) * HTB)
#define PG8_STAGE(bufoff, gbase, voff) do { _Pragma("unroll") for (int _i = 0; _i < 2; ++_i) \
        __builtin_amdgcn_global_load_lds((const unsigned*)((const char*)(gbase) + (voff)[_i]), (PG8_LAS unsigned*)(lds + (bufoff) + ldsw + _i * 8192), 16, 0, 0); } while (0)
#define PG8_LDA(dst, b, h) do { _Pragma("unroll") for (int m = 0; m < 4; ++m) { if constexpr (FP8) { dst##8[m].lo = *(const PG8_LAS v4i_*)(lds + PG8_SA(b, h) + aoff + m * 2048); dst##8[m].hi = *(const PG8_LAS v4i_*)(lds + PG8_SA(b, h) + aoff + m * 2048 + 1024); } \
        else { _Pragma("unroll") for (int k = 0; k < 2; ++k) dst[m][k] = *(const PG8_LAS bf16x8*)(lds + PG8_SA(b, h) + aoff + m * 2048 + k * 1024); } } } while (0)
#define PG8_LDB(dst, b, h) do { _Pragma("unroll") for (int n = 0; n < 2; ++n) { if constexpr (FP8) { dst##8[n].lo = *(const PG8_LAS v4i_*)(lds + PG8_SB(b, h) + boff + n * 2048); dst##8[n].hi = *(const PG8_LAS v4i_*)(lds + PG8_SB(b, h) + boff + n * 2048 + 1024); } \
        else { _Pragma("unroll") for (int k = 0; k < 2; ++k) dst[n][k] = *(const PG8_LAS bf16x8*)(lds + PG8_SB(b, h) + boff + n * 2048 + k * 1024); } } } while (0)
#define PG8_MMA(ai, bj, At, Bt) do { __builtin_amdgcn_s_setprio(1); _Pragma("unroll") for (int m = 0; m < 4; ++m) _Pragma("unroll") for (int n = 0; n < 2; ++n) { \
        if constexpr (FP8) asm volatile("v_mfma_scale_f32_16x16x128_f8f6f4 %0, %1, %2, %0, %3, %3 op_sel_hi:[0,0,0]" : "+v"(acc[ai][bj][m][n]) : "v"(Bt##8[n]), "v"(At##8[m]), "v"(one8_)); \
        else if constexpr (INT8) { _Pragma("unroll") for (int k = 0; k < 2; ++k) acc[ai][bj][m][n] = __builtin_bit_cast(f32x4, __builtin_amdgcn_mfma_i32_16x16x64_i8(__builtin_bit_cast(v4i_, Bt[n][k]), __builtin_bit_cast(v4i_, At[m][k]), __builtin_bit_cast(v4i_, acc[ai][bj][m][n]), 0, 0, 0)); } \
        else { _Pragma("unroll") for (int k = 0; k < 2; ++k) acc[ai][bj][m][n] = __builtin_amdgcn_mfma_f32_16x16x32_bf16(Bt[n][k], At[m][k], acc[ai][bj][m][n], 0, 0, 0); } } __builtin_amdgcn_s_setprio(0); } while (0)
#define PG8_WAIT_V(n) asm volatile("s_waitcnt vmcnt(" #n ")" ::: "memory")
#define PG8_WAIT_L(n) asm volatile("s_waitcnt lgkmcnt(" #n ")" ::: "memory")
#define PG8_BAR __builtin_amdgcn_s_barrier()
#define PG8_SCHED __builtin_amdgcn_sched_barrier(0)
    Unit cur, nxt; int ui = 0;
    if (!S.next(0, cur)) return;
    f32x4 acc[2][2][4][2];
#pragma unroll
    for (int a = 0; a < 2; ++a)
#pragma unroll
        for (int b = 0; b < 2; ++b)
#pragma unroll
            for (int m = 0; m < 4; ++m)
#pragma unroll
                for (int n = 0; n < 2; ++n) acc[a][b][m][n] = (f32x4){0.f, 0.f, 0.f, 0.f};
    typedef int v4i_ __attribute__((ext_vector_type(4))); typedef int v8i_ __attribute__((ext_vector_type(8)));
    bf16x8 At[4][2], B0[2][2], B1[2][2]; v8i_ At8[4], B08[2], B18[2]; int one8_ = 0x7f7f7f7f; if constexpr (FP8) asm volatile("" : "+v"(one8_));
    const char* cA = (const char*)g.A + (size_t)cur.pm * tstep; const char* cB = (const char*)g.Bt + (size_t)cur.pn * tstep;
    S.a_ready(cur);
    if constexpr (SP2) {
        PG8_STAGE(PG8_SB(0, 0), cB, voffB); PG8_STAGE(PG8_SB(0, 1), cB + hstep, voffB); PG8_STAGE(PG8_SA(0, 0), cA, voffA); PG8_STAGE(PG8_SA(0, 1), cA + hstep, voffA);
        if (wr == 1) PG8_BAR;
        PG8_WAIT_V(2); PG8_BAR;
        PG8_STAGE(PG8_SB(1, 0), cB + kstep, voffB); PG8_STAGE(PG8_SA(1, 0), cA + kstep, voffA); PG8_STAGE(PG8_SB(1, 1), cB + hstep + kstep, voffB);
        PG8_WAIT_V(6); PG8_BAR;
    } else {
        PG8_STAGE(PG8_SB(0, 0), cB, voffB); PG8_STAGE(PG8_SA(0, 0), cA, voffA); PG8_STAGE(PG8_SB(0, 1), cB + hstep, voffB); PG8_STAGE(PG8_SA(0, 1), cA + hstep, voffA);
        if (wr == 1) PG8_BAR;
        PG8_WAIT_V(4); PG8_BAR;
        PG8_STAGE(PG8_SB(1, 0), cB + kstep, voffB); PG8_STAGE(PG8_SA(1, 0), cA + kstep, voffA); PG8_STAGE(PG8_SB(1, 1), cB + hstep + kstep, voffB);
        PG8_WAIT_V(6); PG8_BAR;
    }
    for (;;) {
        const bool has_next = S.next(ui + 1, nxt);
        const char* nA = has_next ? (const char*)g.A + (size_t)nxt.pm * tstep : cA; const char* nB = has_next ? (const char*)g.Bt + (size_t)nxt.pn * tstep : cB;
        for (int t = 0; t < nt; t += 2) {
            const bool last = (t == nt - 2);
            const char* a1 = cA + (size_t)(t + 1) * kstep;
            const char* a2 = last ? nA : cA + (size_t)(t + 2) * kstep; const char* b2 = last ? nB : cB + (size_t)(t + 2) * kstep;
            const char* a3 = a2 + kstep; const char* b3 = b2 + kstep;
            if (last && has_next) S.a_ready(nxt);
            if constexpr (SP2) {
            PG8_LDB(B0, 0, 0); PG8_LDB(B1, 0, 1); PG8_SCHED; PG8_LDA(At, 0, 0); PG8_STAGE(PG8_SA(1, 1), a1 + hstep, voffA);
            PG8_WAIT_V(8); PG8_WAIT_L(0); PG8_BAR; PG8_MMA(0, 0, At, B0); PG8_MMA(0, 1, At, B1); PG8_BAR; PG8_SCHED;
            PG8_LDA(At, 0, 1); PG8_STAGE(PG8_SB(0, 0), b2, voffB); PG8_STAGE(PG8_SB(0, 1), b2 + hstep, voffB); PG8_STAGE(PG8_SA(0, 0), a2, voffA);
            PG8_WAIT_V(8); PG8_WAIT_L(0); PG8_BAR; PG8_MMA(1, 0, At, B0); PG8_MMA(1, 1, At, B1); PG8_BAR; PG8_SCHED;
            PG8_LDB(B0, 1, 0); PG8_LDB(B1, 1, 1); PG8_SCHED; PG8_LDA(At, 1, 0); PG8_STAGE(PG8_SA(0, 1), a2 + hstep, voffA);
            PG8_WAIT_V(8); PG8_WAIT_L(0); PG8_BAR; PG8_MMA(0, 0, At, B0); PG8_MMA(0, 1, At, B1); PG8_BAR; PG8_SCHED;
            PG8_LDA(At, 1, 1); PG8_STAGE(PG8_SB(1, 0), b3, voffB); PG8_STAGE(PG8_SB(1, 1), b3 + hstep, voffB); PG8_STAGE(PG8_SA(1, 0), a3, voffA);
            PG8_WAIT_V(8); PG8_WAIT_L(0); PG8_BAR; PG8_MMA(1, 0, At, B0); PG8_MMA(1, 1, At, B1); PG8_BAR; PG8_SCHED;
            } else {
            PG8_LDB(B0, 0, 0); PG8_SCHED; PG8_LDA(At, 0, 0); PG8_STAGE(PG8_SA(1, 1), a1 + hstep, voffA);
            PG8_WAIT_L(8); PG8_BAR; PG8_WAIT_L(0); PG8_MMA(0, 0, At, B0); PG8_BAR; PG8_SCHED;
            PG8_LDB(B1, 0, 1); PG8_STAGE(PG8_SB(0, 0), b2, voffB);
            PG8_BAR; PG8_WAIT_L(0); PG8_MMA(0, 1, At, B1); PG8_BAR;
            PG8_LDA(At, 0, 1); PG8_STAGE(PG8_SA(0, 0), a2, voffA);
            PG8_BAR; PG8_WAIT_L(0); PG8_MMA(1, 0, At, B0); PG8_BAR; PG8_SCHED;
            PG8_STAGE(PG8_SB(0, 1), b2 + hstep, voffB);
            PG8_WAIT_V(6); PG8_BAR; PG8_MMA(1, 1, At, B1); PG8_BAR;
            PG8_LDB(B0, 1, 0); PG8_SCHED; PG8_LDA(At, 1, 0); PG8_STAGE(PG8_SA(0, 1), a2 + hstep, voffA);
            PG8_WAIT_L(8); PG8_BAR; PG8_WAIT_L(0); PG8_MMA(0, 0, At, B0); PG8_BAR; PG8_SCHED;
            PG8_LDB(B1, 1, 1); PG8_STAGE(PG8_SB(1, 0), b3, voffB);
            PG8_BAR; PG8_WAIT_L(0); PG8_MMA(0, 1, At, B1); PG8_BAR;
            PG8_LDA(At, 1, 1); PG8_STAGE(PG8_SA(1, 0), a3, voffA);
            PG8_BAR; PG8_WAIT_L(0); PG8_MMA(1, 0, At, B0); PG8_BAR; PG8_SCHED;
            PG8_STAGE(PG8_SB(1, 1), b3 + hstep, voffB);
            PG8_WAIT_V(6); PG8_BAR; PG8_MMA(1, 1, At, B1); PG8_BAR;
            }
        }
        if constexpr (ALIGN_EPI) { if (wr == 0) PG8_BAR; }
        if constexpr (FP8) {
            asm volatile("s_nop 15\n\ts_nop 15" ::: "memory");
#pragma unroll
            for (int a = 0; a < 2; ++a)
#pragma unroll
                for (int b = 0; b < 2; ++b) asm volatile("" : "+v"(acc[a][b][0][0]), "+v"(acc[a][b][0][1]), "+v"(acc[a][b][1][0]), "+v"(acc[a][b][1][1]), "+v"(acc[a][b][2][0]), "+v"(acc[a][b][2][1]), "+v"(acc[a][b][3][0]), "+v"(acc[a][b][3][1])); }
        if constexpr (!Epi::AFTER_DRAIN) { E(acc, cur, wr, wc, fr, fq); S.done(cur); }
        if (!has_next) break;
#pragma unroll
        for (int a = 0; a < 2; ++a)
#pragma unroll
            for (int b = 0; b < 2; ++b)
#pragma unroll
                for (int m = 0; m < 4; ++m)
#pragma unroll
                    for (int n = 0; n < 2; ++n) acc[a][b][m][n] = (f32x4){0.f, 0.f, 0.f, 0.f};
        cur = nxt; cA = nA; cB = nB; ++ui;
        if constexpr (ALIGN_EPI) { if (wr == 1) PG8_BAR; }
    }
    PG8_WAIT_V(0);
    if constexpr (!ALIGN_EPI) { if (wr == 0) PG8_BAR; }
    PG8_BAR;
    if constexpr (Epi::AFTER_DRAIN) { E.fused(acc, cur, wr, wc, fr, fq, lds, wid, lane); S.done(cur); }
#undef PG8_SA
#undef PG8_SB
#undef PG8_STAGE
#undef PG8_LDA
#undef PG8_LDB
#undef PG8_MMA
#undef PG8_WAIT_V
#undef PG8_WAIT_L
#undef PG8_BAR
#undef PG8_SCHED
}
}

#ifndef PG8_SP2
#define PG8_SP2 true
#endif
#ifndef PG8_ALIGN
#define PG8_ALIGN true
#endif
namespace pg8 {
template <class Epi, class Sched, bool ALIGN_EPI, bool FP8 = false>
__device__ __forceinline__ void gemm_phase_x(PG8_LAS unsigned char* lds, const char* Abase, const int K, const Sched& S, const Epi& E, const int tid0) {
    int tid_ = tid0; asm volatile("" : "+v"(tid_));
    const int tid = tid_, wid = __builtin_amdgcn_readfirstlane(tid >> 6), lane = tid & 63, wr = wid >> 2, wc = wid & 3, fr = lane & 15, fq = lane >> 4;
    int nt_ = K / BK; if constexpr (FP8) asm volatile("" : "+s"(nt_));
    const int nt = nt_;
    int RA[2]; unsigned CA[2], voffB[2];
#pragma unroll
    for (int i = 0; i < 2; ++i) { int R, C; stage_rc(tid * 16 + i * 8192, R, C); const int Rb = Epi::PERM ? ((R & ~31) + perm32(R & 31)) : R; RA[i] = R; CA[i] = (unsigned)C * 2u; voffB[i] = (unsigned)(Rb * K + C) * 2u; }
    const size_t kstep = (size_t)(BK * 2), hstep = (size_t)HALF * K * 2;
    const unsigned ldsw = (unsigned)wid * 1024u;
    const int aoff = lds_byte(wr * 64 + fr, fq * 8), boff = lds_byte(wc * 32 + fr, fq * 8);
#define PG8_SA(b, h) (((b) * 2 + (h)) * HTB)
#define PG8_SB(b, h) ((4 + (b) * 2 + (h)) * HTB)
#define PG8_STAGE(bufoff, gbase, voff) do { _Pragma("unroll") for (int _i = 0; _i < 2; ++_i) \
        __builtin_amdgcn_global_load_lds((const unsigned*)((const char*)(gbase) + (voff)[_i]), (PG8_LAS unsigned*)(lds + (bufoff) + ldsw + _i * 8192), 16, 0, 0); } while (0)
#define PG8_STAGE_A(bufoff, kb, VO) do { _Pragma("unroll") for (int _i = 0; _i < 2; ++_i) \
        __builtin_amdgcn_global_load_lds((const unsigned*)(Abase + (size_t)(kb) + (VO)[_i]), (PG8_LAS unsigned*)(lds + (bufoff) + ldsw + _i * 8192), 16, 0, 0); } while (0)
    constexpr bool GA = Sched::GATHER;
#define PG8_LDA(dst, b, h) do { _Pragma("unroll") for (int m = 0; m < 4; ++m) { if constexpr (FP8) { dst##8[m].lo = *(const PG8_LAS v4i_*)(lds + PG8_SA(b, h) + aoff + m * 2048); dst##8[m].hi = *(const PG8_LAS v4i_*)(lds + PG8_SA(b, h) + aoff + m * 2048 + 1024); } \
        else { _Pragma("unroll") for (int k = 0; k < 2; ++k) dst[m][k] = *(const PG8_LAS bf16x8*)(lds + PG8_SA(b, h) + aoff + m * 2048 + k * 1024); } } } while (0)
#define PG8_LDB(dst, b, h) do { _Pragma("unroll") for (int n = 0; n < 2; ++n) { if constexpr (FP8) { dst##8[n].lo = *(const PG8_LAS v4i_*)(lds + PG8_SB(b, h) + boff + n * 2048); dst##8[n].hi = *(const PG8_LAS v4i_*)(lds + PG8_SB(b, h) + boff + n * 2048 + 1024); } \
        else { _Pragma("unroll") for (int k = 0; k < 2; ++k) dst[n][k] = *(const PG8_LAS bf16x8*)(lds + PG8_SB(b, h) + boff + n * 2048 + k * 1024); } } } while (0)
#define PG8_MMA(ai, bj, At, Bt) do { __builtin_amdgcn_s_setprio(1); _Pragma("unroll") for (int m = 0; m < 4; ++m) _Pragma("unroll") for (int n = 0; n < 2; ++n) { \
        if constexpr (FP8) asm volatile("v_mfma_scale_f32_16x16x128_f8f6f4 %0, %1, %2, %0, %3, %3 op_sel_hi:[0,0,0]" : "+v"(acc[ai][bj][m][n]) : "v"(Bt##8[n]), "v"(At##8[m]), "v"(one8_)); \
        else { _Pragma("unroll") for (int k = 0; k < 2; ++k) acc[ai][bj][m][n] = __builtin_amdgcn_mfma_f32_16x16x32_bf16(Bt[n][k], At[m][k], acc[ai][bj][m][n], 0, 0, 0); } } __builtin_amdgcn_s_setprio(0); } while (0)
#define PG8_WAIT_V(n) asm volatile("s_waitcnt vmcnt(" #n ")" ::: "memory")
#define PG8_WAIT_L(n) asm volatile("s_waitcnt lgkmcnt(" #n ")" ::: "memory")
#define PG8_BAR __builtin_amdgcn_s_barrier()
#define PG8_SCHED __builtin_amdgcn_sched_barrier(0)
    typename Sched::U cur, nxt; int ui = 0;
    if (!S.next(0, cur)) return;
    f32x4 acc[2][2][4][2];
#pragma unroll
    for (int a = 0; a < 2; ++a)
#pragma unroll
        for (int b = 0; b < 2; ++b)
#pragma unroll
            for (int m = 0; m < 4; ++m)
#pragma unroll
                for (int n = 0; n < 2; ++n) acc[a][b][m][n] = (f32x4){0.f, 0.f, 0.f, 0.f};
    typedef int v4i_ __attribute__((ext_vector_type(4))); typedef int v8i_ __attribute__((ext_vector_type(8)));
    bf16x8 At[4][2], B0[2][2], B1[2][2]; v8i_ At8[4], B08[2], B18[2]; int one8_ = 0x7f7f7f7f; if constexpr (FP8) asm volatile("" : "+v"(one8_));
    unsigned cva[2][2], nva[2][2]; size_t cbase = GA ? (size_t)0 : S.a_base(cur), nbase = 0;
#pragma unroll
    for (int h = 0; h < 2; ++h)
#pragma unroll
        for (int i = 0; i < 2; ++i) { cva[h][i] = (GA ? S.a_off(cur, h * HALF + RA[i]) : (unsigned)(h * HALF + RA[i]) * (unsigned)S.rowbytes) + CA[i]; nva[h][i] = cva[h][i]; }
    const char* cB = S.b_ptr(cur);
    PG8_STAGE(PG8_SB(0, 0), cB, voffB); PG8_STAGE(PG8_SB(0, 1), cB + hstep, voffB); PG8_STAGE_A(PG8_SA(0, 0), cbase, cva[0]); PG8_STAGE_A(PG8_SA(0, 1), cbase, cva[1]);
    if (wr == 1) PG8_BAR;
    PG8_WAIT_V(2); PG8_BAR;
    PG8_STAGE(PG8_SB(1, 0), cB + kstep, voffB); PG8_STAGE_A(PG8_SA(1, 0), cbase + kstep, cva[0]); PG8_STAGE(PG8_SB(1, 1), cB + hstep + kstep, voffB);
    PG8_WAIT_V(6); PG8_BAR;
    for (;;) {
        const bool has_next = S.next(ui + 1, nxt);
        const char* nB = has_next ? S.b_ptr(nxt) : cB;
        if constexpr (GA) {
#pragma unroll
            for (int h = 0; h < 2; ++h)
#pragma unroll
                for (int i = 0; i < 2; ++i) nva[h][i] = has_next ? S.a_off(nxt, h * HALF + RA[i]) + CA[i] : cva[h][i];
        } else nbase = has_next ? S.a_base(nxt) : cbase;
        for (int t = 0; t < nt; t += 2) {
            const bool last = (t == nt - 2);
            const size_t k1 = cbase + (size_t)(t + 1) * kstep, k2 = last ? nbase : cbase + (size_t)(t + 2) * kstep, k3 = k2 + kstep;
            unsigned s2[2][2];
#pragma unroll
            for (int h = 0; h < 2; ++h)
#pragma unroll
                for (int i = 0; i < 2; ++i) s2[h][i] = (GA && last) ? nva[h][i] : cva[h][i];
            const char* b2 = last ? nB : cB + (size_t)(t + 2) * kstep; const char* b3 = b2 + kstep;
            PG8_LDB(B0, 0, 0); PG8_LDB(B1, 0, 1); PG8_SCHED; PG8_LDA(At, 0, 0); PG8_STAGE_A(PG8_SA(1, 1), k1, cva[1]);
            PG8_WAIT_V(8); PG8_WAIT_L(0); PG8_BAR; PG8_MMA(0, 0, At, B0); PG8_MMA(0, 1, At, B1); PG8_BAR; PG8_SCHED;
            PG8_LDA(At, 0, 1); PG8_STAGE(PG8_SB(0, 0), b2, voffB); PG8_STAGE(PG8_SB(0, 1), b2 + hstep, voffB); PG8_STAGE_A(PG8_SA(0, 0), k2, s2[0]);
            PG8_WAIT_V(8); PG8_WAIT_L(0); PG8_BAR; PG8_MMA(1, 0, At, B0); PG8_MMA(1, 1, At, B1); PG8_BAR; PG8_SCHED;
            PG8_LDB(B0, 1, 0); PG8_LDB(B1, 1, 1); PG8_SCHED; PG8_LDA(At, 1, 0); PG8_STAGE_A(PG8_SA(0, 1), k2, s2[1]);
            PG8_WAIT_V(8); PG8_WAIT_L(0); PG8_BAR; PG8_MMA(0, 0, At, B0); PG8_MMA(0, 1, At, B1); PG8_BAR; PG8_SCHED;
            PG8_LDA(At, 1, 1); PG8_STAGE(PG8_SB(1, 0), b3, voffB); PG8_STAGE(PG8_SB(1, 1), b3 + hstep, voffB); PG8_STAGE_A(PG8_SA(1, 0), k3, s2[0]);
            PG8_WAIT_V(8); PG8_WAIT_L(0); PG8_BAR; PG8_MMA(1, 0, At, B0); PG8_MMA(1, 1, At, B1); PG8_BAR; PG8_SCHED;
        }
        if constexpr (ALIGN_EPI) { if (wr == 0) PG8_BAR; }
        if constexpr (FP8) {
            asm volatile("s_nop 15\n\ts_nop 15" ::: "memory");
#pragma unroll
            for (int a = 0; a < 2; ++a)
#pragma unroll
                for (int b = 0; b < 2; ++b) asm volatile("" : "+v"(acc[a][b][0][0]), "+v"(acc[a][b][0][1]), "+v"(acc[a][b][1][0]), "+v"(acc[a][b][1][1]), "+v"(acc[a][b][2][0]), "+v"(acc[a][b][2][1]), "+v"(acc[a][b][3][0]), "+v"(acc[a][b][3][1])); }
        E(acc, cur, wr, wc, fr, fq);
        if (!has_next) break;
#pragma unroll
        for (int a = 0; a < 2; ++a)
#pragma unroll
            for (int b = 0; b < 2; ++b)
#pragma unroll
                for (int m = 0; m < 4; ++m)
#pragma unroll
                    for (int n = 0; n < 2; ++n) acc[a][b][m][n] = (f32x4){0.f, 0.f, 0.f, 0.f};
        cur = nxt; cB = nB; cbase = nbase; ++ui;
        if constexpr (GA) {
#pragma unroll
            for (int h = 0; h < 2; ++h)
#pragma unroll
                for (int i = 0; i < 2; ++i) cva[h][i] = nva[h][i]; }
        if constexpr (ALIGN_EPI) { if (wr == 1) PG8_BAR; }
    }
    PG8_WAIT_V(0);
    if constexpr (!ALIGN_EPI) { if (wr == 0) PG8_BAR; }
    PG8_BAR;
#undef PG8_SA
#undef PG8_SB
#undef PG8_STAGE
#undef PG8_STAGE_A
#undef PG8_LDA
#undef PG8_LDB
#undef PG8_MMA
#undef PG8_WAIT_V
#undef PG8_WAIT_L
#undef PG8_BAR
#undef PG8_SCHED
}
}
namespace pg8 {
template <class Epi, class Sched, bool ALIGN_EPI, bool FP8 = false>
__device__ __forceinline__ void gemm_phase_pair(PG8_LAS unsigned char* lds, const char* Abase, const Sched& S, const Epi& E, const int tid0) {
    int tid_ = tid0; asm volatile("" : "+v"(tid_));
    const int tid = tid_, wid = __builtin_amdgcn_readfirstlane(tid >> 6), lane = tid & 63, wr = wid >> 2, wc = wid & 3, fr = lane & 15, fq = lane >> 4;
    constexpr int KB = FP8 ? 128 : 256;
    constexpr int NH = FP8 ? 2 : 4;
    int RA[2]; unsigned CA[2], voffB[2];
#pragma unroll
    for (int i = 0; i < 2; ++i) { int R, C; stage_rc(tid * 16 + i * 8192, R, C); const int Rb = Epi::PERM ? ((R & ~31) + perm32(R & 31)) : R; RA[i] = R; CA[i] = (unsigned)C * 2u; voffB[i] = (unsigned)(Rb * KB + C) * 2u; }
    const size_t kstep = (size_t)(BK * 2), hstepB = (size_t)HALF * KB * 2;
    const unsigned ldsw = (unsigned)wid * 1024u;
    const int aoff = lds_byte(wr * 64 + fr, fq * 8), boff = lds_byte(wc * 32 + fr, fq * 8);
#define PG8_SA(b, h) (((b) * 2 + (h)) * HTB)
#define PG8_SB(b, h) ((4 + (b) * 2 + (h)) * HTB)
#define PG8_STAGE(bufoff, gbase, voff) do { _Pragma("unroll") for (int _i = 0; _i < 2; ++_i) \
        __builtin_amdgcn_global_load_lds((const unsigned*)((const char*)(gbase) + (voff)[_i]), (PG8_LAS unsigned*)(lds + (bufoff) + ldsw + _i * 8192), 16, 0, 0); } while (0)
#define PG8_STAGE_A(bufoff, kb, VO) do { _Pragma("unroll") for (int _i = 0; _i < 2; ++_i) \
        __builtin_amdgcn_global_load_lds((const unsigned*)(Abase + (size_t)(kb) + (VO)[_i]), (PG8_LAS unsigned*)(lds + (bufoff) + ldsw + _i * 8192), 16, 0, 0); } while (0)
#define PG8_LDA(dst, b, h) do { _Pragma("unroll") for (int m = 0; m < 4; ++m) { if constexpr (FP8) { dst##8[m].lo = *(const PG8_LAS v4i_*)(lds + PG8_SA(b, h) + aoff + m * 2048); dst##8[m].hi = *(const PG8_LAS v4i_*)(lds + PG8_SA(b, h) + aoff + m * 2048 + 1024); } \
        else { _Pragma("unroll") for (int k = 0; k < 2; ++k) dst[m][k] = *(const PG8_LAS bf16x8*)(lds + PG8_SA(b, h) + aoff + m * 2048 + k * 1024); } } } while (0)
#define PG8_LDB(dst, b, h) do { _Pragma("unroll") for (int n = 0; n < 2; ++n) { if constexpr (FP8) { dst##8[n].lo = *(const PG8_LAS v4i_*)(lds + PG8_SB(b, h) + boff + n * 2048); dst##8[n].hi = *(const PG8_LAS v4i_*)(lds + PG8_SB(b, h) + boff + n * 2048 + 1024); } \
        else { _Pragma("unroll") for (int k = 0; k < 2; ++k) dst[n][k] = *(const PG8_LAS bf16x8*)(lds + PG8_SB(b, h) + boff + n * 2048 + k * 1024); } } } while (0)
#define PG8_MMA(ai, bj, At, Bt) do { __builtin_amdgcn_s_setprio(1); _Pragma("unroll") for (int m = 0; m < 4; ++m) _Pragma("unroll") for (int n = 0; n < 2; ++n) { \
        if constexpr (FP8) asm volatile("v_mfma_scale_f32_16x16x128_f8f6f4 %0, %1, %2, %0, %3, %3 op_sel_hi:[0,0,0]" : "+v"(acc[ai][bj][m][n]) : "v"(Bt##8[n]), "v"(At##8[m]), "v"(one8_)); \
        else { _Pragma("unroll") for (int k = 0; k < 2; ++k) acc[ai][bj][m][n] = __builtin_amdgcn_mfma_f32_16x16x32_bf16(Bt[n][k], At[m][k], acc[ai][bj][m][n], 0, 0, 0); } } __builtin_amdgcn_s_setprio(0); } while (0)
#define PG8_WAIT_V(n) asm volatile("s_waitcnt vmcnt(" #n ")" ::: "memory")
#define PG8_WAIT_L(n) asm volatile("s_waitcnt lgkmcnt(" #n ")" ::: "memory")
#define PG8_BAR __builtin_amdgcn_s_barrier()
#define PG8_SCHED __builtin_amdgcn_sched_barrier(0)
#define PG8_LOADSET(dst, u, set) do { _Pragma("unroll") for (int _h = 0; _h < 2; ++_h) _Pragma("unroll") for (int _i = 0; _i < 2; ++_i) dst[_h][_i] = S.a_off(u, set, _h * HALF + RA[_i]) + CA[_i]; } while (0)
    typename Sched::U cur, nxt; int ui = 0;
    if (!S.next(0, cur)) return;
    f32x4 acc[2][2][4][2];
#pragma unroll
    for (int a = 0; a < 2; ++a)
#pragma unroll
        for (int b = 0; b < 2; ++b)
#pragma unroll
            for (int m = 0; m < 4; ++m)
#pragma unroll
                for (int n = 0; n < 2; ++n) acc[a][b][m][n] = (f32x4){0.f, 0.f, 0.f, 0.f};
    typedef int v4i_ __attribute__((ext_vector_type(4))); typedef int v8i_ __attribute__((ext_vector_type(8)));
    bf16x8 At[4][2], B0[2][2], B1[2][2]; v8i_ At8[4], B08[2], B18[2]; int one8_ = 0x7f7f7f7f; if constexpr (FP8) asm volatile("" : "+v"(one8_));
    unsigned va[2][2], vb[2][2];
    PG8_LOADSET(va, cur, 0); PG8_LOADSET(vb, cur, 1);
    const char* bLo = S.b_ptr(cur, 0); const char* bHi = S.b_ptr(cur, 1);
    PG8_STAGE(PG8_SB(0, 0), bLo, voffB); PG8_STAGE(PG8_SB(0, 1), bLo + hstepB, voffB); PG8_STAGE_A(PG8_SA(0, 0), 0, va[0]); PG8_STAGE_A(PG8_SA(0, 1), 0, va[1]);
    if (wr == 1) PG8_BAR;
    PG8_WAIT_V(2); PG8_BAR;
    PG8_STAGE(PG8_SB(1, 0), bLo + kstep, voffB); PG8_STAGE_A(PG8_SA(1, 0), kstep, va[0]); PG8_STAGE(PG8_SB(1, 1), bLo + hstepB + kstep, voffB);
    PG8_WAIT_V(6); PG8_BAR;
    for (;;) {
        const bool has_next = S.next(ui + 1, nxt);
        const char* nbLo = has_next ? S.b_ptr(nxt, 0) : bLo;
#pragma clang loop unroll(disable)
        for (int t = 0; t < 2 * NH; t += 2) { const bool last = t == 2 * NH - 2;
            if (t == NH - 2) PG8_LOADSET(vb, cur, 1);
            if (last) { if (has_next) PG8_LOADSET(va, nxt, 0); else PG8_LOADSET(va, cur, 0); }
            const bool xa = t + 1 < NH, ya = last || (t + 2 < NH);
            unsigned X1[2], Y0[2], Y1[2];
#pragma unroll
            for (int i = 0; i < 2; ++i) { X1[i] = xa ? va[1][i] : vb[1][i]; Y0[i] = ya ? va[0][i] : vb[0][i]; Y1[i] = ya ? va[1][i] : vb[1][i]; }
            const size_t kx = (size_t)((t + 1) & (NH - 1)) * kstep, ky2 = (size_t)((t + 2) & (NH - 1)) * kstep, ky3 = ky2 + kstep;
            const char* bY = last ? nbLo : (t + 2 < NH ? bLo : bHi); const char* b2 = bY + ky2; const char* b3 = b2 + kstep;
            PG8_LDB(B0, 0, 0); PG8_LDB(B1, 0, 1); PG8_SCHED; PG8_LDA(At, 0, 0); PG8_STAGE_A(PG8_SA(1, 1), kx, X1);
            PG8_WAIT_V(8); PG8_WAIT_L(0); PG8_BAR; PG8_MMA(0, 0, At, B0); PG8_MMA(0, 1, At, B1); PG8_BAR; PG8_SCHED;
            PG8_LDA(At, 0, 1); PG8_STAGE(PG8_SB(0, 0), b2, voffB); PG8_STAGE(PG8_SB(0, 1), b2 + hstepB, voffB); PG8_STAGE_A(PG8_SA(0, 0), ky2, Y0);
            PG8_WAIT_V(8); PG8_WAIT_L(0); PG8_BAR; PG8_MMA(1, 0, At, B0); PG8_MMA(1, 1, At, B1); PG8_BAR; PG8_SCHED;
            PG8_LDB(B0, 1, 0); PG8_LDB(B1, 1, 1); PG8_SCHED; PG8_LDA(At, 1, 0); PG8_STAGE_A(PG8_SA(0, 1), ky2, Y1);
            PG8_WAIT_V(8); PG8_WAIT_L(0); PG8_BAR; PG8_MMA(0, 0, At, B0); PG8_MMA(0, 1, At, B1); PG8_BAR; PG8_SCHED;
            PG8_LDA(At, 1, 1); PG8_STAGE(PG8_SB(1, 0), b3, voffB); PG8_STAGE(PG8_SB(1, 1), b3 + hstepB, voffB); PG8_STAGE_A(PG8_SA(1, 0), ky3, Y0);
            PG8_WAIT_V(8); PG8_WAIT_L(0); PG8_BAR; PG8_MMA(1, 0, At, B0); PG8_MMA(1, 1, At, B1); PG8_BAR; PG8_SCHED;
        }
        if constexpr (ALIGN_EPI) { if (wr == 0) PG8_BAR; }
        if constexpr (FP8) {
            asm volatile("s_nop 15\n\ts_nop 15" ::: "memory");
#pragma unroll
            for (int a = 0; a < 2; ++a)
#pragma unroll
                for (int b = 0; b < 2; ++b) asm volatile("" : "+v"(acc[a][b][0][0]), "+v"(acc[a][b][0][1]), "+v"(acc[a][b][1][0]), "+v"(acc[a][b][1][1]), "+v"(acc[a][b][2][0]), "+v"(acc[a][b][2][1]), "+v"(acc[a][b][3][0]), "+v"(acc[a][b][3][1])); }
        E(acc, cur, wr, wc, fr, fq);
        if (!has_next) break;
#pragma unroll
        for (int a = 0; a < 2; ++a)
#pragma unroll
            for (int b = 0; b < 2; ++b)
#pragma unroll
                for (int m = 0; m < 4; ++m)
#pragma unroll
                    for (int n = 0; n < 2; ++n) acc[a][b][m][n] = (f32x4){0.f, 0.f, 0.f, 0.f};
        cur = nxt; bLo = nbLo; bHi = S.b_ptr(cur, 1); ++ui;
        if constexpr (ALIGN_EPI) { if (wr == 1) PG8_BAR; }
    }
    PG8_WAIT_V(0);
    if constexpr (!ALIGN_EPI) { if (wr == 0) PG8_BAR; }
    PG8_BAR;
#undef PG8_SA
#undef PG8_SB
#undef PG8_STAGE
#undef PG8_STAGE_A
#undef PG8_LDA
#undef PG8_LDB
#undef PG8_MMA
#undef PG8_WAIT_V
#undef PG8_WAIT_L
#undef PG8_BAR
#undef PG8_SCHED
#undef PG8_LOADSET
}
}
#include <hip/hip_bf16.h>
#include <cmath>
namespace attn_body {
using bf16=__hip_bfloat16;
using bf16x8=__attribute__((ext_vector_type(8)))short;
using s16x4=__attribute__((ext_vector_type(4)))short;
using f32x16=__attribute__((ext_vector_type(16)))float;
using u32x4=__attribute__((ext_vector_type(4)))unsigned;
constexpr int SEQ=4096,D=64,PQ=512,PO=1024;
constexpr int NW=8,QBLK=32,QB=QBLK*NW,KVBLK=64,NQB=SEQ/QB;
constexpr int ATTN_UNIT_ROWS=QB;
__device__ __forceinline__ int crow(int r,int hi){return (r&3)+8*(r>>2)+4*hi;}
#define SBAR() __builtin_amdgcn_sched_barrier(0)
__device__ __forceinline__ void cmask(f32x16&p0,f32x16&p1,int jb,int qrel,int hi){
  const float NEG=-INFINITY; int kb=64*jb+4*hi;
  #pragma unroll
  for(int r=0;r<16;++r){int kv=kb+(r&3)+8*(r>>2); if(kv>qrel)p0[r]=NEG; if(kv+32>qrel)p1[r]=NEG;}
}

constexpr int NSLOT=3, SLOTB=8192;
constexpr int LDS_K=0, LDS_V=NSLOT*SLOTB, LDS_WS=2*NSLOT*SLOTB, LDS_OST=LDS_WS+NW*64*4, LDS_BYTES=LDS_OST+NW*4096;
constexpr float C2=0.125f*1.4426950408889634f;
__device__ __forceinline__ void glds16(const void*gsrc,unsigned lds_dst){unsigned keep;
  asm volatile("s_mov_b32 %0, m0\n\ts_mov_b32 m0, %2\n\ts_nop 0\n\tglobal_load_lds_dwordx4 %1, off\n\ts_mov_b32 m0, %0":"=&s"(keep):"v"(gsrc),"s"(lds_dst):"memory");}
__device__ __forceinline__ float max3f(float a,float b,float c){float r;asm("v_max3_f32 %0, %1, %2, %3":"=v"(r):"v"(a),"v"(b),"v"(c));return r;}
__device__ __forceinline__ float max2f(float a,float b){float r;asm("v_max_f32_e32 %0, %1, %2":"=v"(r):"v"(a),"v"(b));return r;}
__device__ __forceinline__ float fadd_s(float a,float b){float r;asm("v_add_f32_e32 %0, %1, %2":"=v"(r):"v"(a),"v"(b));return r;}
__device__ __forceinline__ float fsub_s(float a,float b){float r;asm("v_sub_f32_e32 %0, %1, %2":"=v"(r):"v"(a),"v"(b));return r;}
typedef float f32x2_t __attribute__((ext_vector_type(2))); typedef __bf16 bf16x2_t __attribute__((ext_vector_type(2)));
__device__ __forceinline__ unsigned cvtpk_s(float lo,float hi){f32x2_t v={lo,hi};bf16x2_t b=__builtin_convertvector(v,bf16x2_t);return __builtin_bit_cast(unsigned,b);}
#define WAIT_BAR(N) asm volatile("s_waitcnt vmcnt(" #N ") lgkmcnt(0)\n\ts_barrier":::"memory")

__device__ __forceinline__ void qkt(f32x16&p0,f32x16&p1,const char*Kslot,const bf16x8*qr,const f32x16&negm,int r32,int hi){
  const char*kb=Kslot+hi*1024+r32*16;
  #pragma unroll
  for(int d0=0;d0<4;++d0){
    const bf16x8 b0=*reinterpret_cast<const bf16x8*>(kb+d0*2048);
    const bf16x8 b1=*reinterpret_cast<const bf16x8*>(kb+d0*2048+512);
    if(d0==0){p0=__builtin_amdgcn_mfma_f32_32x32x16_bf16(b0,qr[0],negm,0,0,0);p1=__builtin_amdgcn_mfma_f32_32x32x16_bf16(b1,qr[0],negm,0,0,0);}
    else{p0=__builtin_amdgcn_mfma_f32_32x32x16_bf16(b0,qr[d0],p0,0,0,0);p1=__builtin_amdgcn_mfma_f32_32x32x16_bf16(b1,qr[d0],p1,0,0,0);}}
}
typedef __attribute__((address_space(3))) const char* lds_cptr;
typedef short v4i16_t __attribute__((ext_vector_type(4)));
__device__ __forceinline__ void kload8(bf16x8*kf,lds_cptr kp){
  kf[0]=*(const __attribute__((address_space(3))) bf16x8*)(kp);      kf[1]=*(const __attribute__((address_space(3))) bf16x8*)(kp+512);
  kf[2]=*(const __attribute__((address_space(3))) bf16x8*)(kp+2048); kf[3]=*(const __attribute__((address_space(3))) bf16x8*)(kp+2560);
  kf[4]=*(const __attribute__((address_space(3))) bf16x8*)(kp+4096); kf[5]=*(const __attribute__((address_space(3))) bf16x8*)(kp+4608);
  kf[6]=*(const __attribute__((address_space(3))) bf16x8*)(kp+6144); kf[7]=*(const __attribute__((address_space(3))) bf16x8*)(kp+6656);
}
__device__ __forceinline__ void kload2(bf16x8*kf,lds_cptr kp,int j){ kf[2*j]=*(const __attribute__((address_space(3))) bf16x8*)(kp+j*2048); kf[2*j+1]=*(const __attribute__((address_space(3))) bf16x8*)(kp+j*2048+512); }
__device__ __forceinline__ s16x4 vtr(lds_cptr p){ return __builtin_bit_cast(s16x4,__builtin_amdgcn_ds_read_tr16_b64_v4i16((__attribute__((address_space(3))) v4i16_t*)p)); }
__device__ __forceinline__ float rowmax(const f32x16&p0,const f32x16&p1){
  float a=max3f(p0[0],p0[1],p1[0]),b=max3f(p0[2],p0[3],p1[1]);a=max3f(a,p1[2],p1[3]);
  #pragma unroll
  for(int r=4;r<16;r+=4){a=max3f(a,p0[r],p0[r+1]);b=max3f(b,p0[r+2],p0[r+3]);a=max3f(a,p1[r],p1[r+1]);b=max3f(b,p1[r+2],p1[r+3]);}
  const float m=max2f(a,b);
  auto rr=__builtin_amdgcn_permlane32_swap(__float_as_uint(m),__float_as_uint(m),false,false);
  return max2f(__uint_as_float(rr[0]),__uint_as_float(rr[1]));
}
__device__ __forceinline__ void pv(f32x16*o,int vb,bf16x8 pa0,bf16x8 pa1,bf16x8 pa2,bf16x8 pa3){
  #pragma unroll
  for(int d0=0;d0<2;++d0){s16x4 lo[4],hi[4];
    #pragma unroll
    for(int ks=0;ks<4;++ks){
      asm volatile("ds_read_b64_tr_b16 %0,%1 offset:%c2":"=&v"(lo[ks]):"v"(vb),"i"(d0*4096+ks*1024):"memory");
      asm volatile("ds_read_b64_tr_b16 %0,%1 offset:%c2":"=&v"(hi[ks]):"v"(vb),"i"(d0*4096+ks*1024+512):"memory");}
    asm volatile("s_waitcnt lgkmcnt(0)":::"memory");SBAR();
    #define PK(k) (bf16x8){lo[k][0],lo[k][1],lo[k][2],lo[k][3],hi[k][0],hi[k][1],hi[k][2],hi[k][3]}
    o[d0]=__builtin_amdgcn_mfma_f32_32x32x16_bf16(pa0,PK(0),o[d0],0,0,0);
    o[d0]=__builtin_amdgcn_mfma_f32_32x32x16_bf16(pa1,PK(1),o[d0],0,0,0);
    o[d0]=__builtin_amdgcn_mfma_f32_32x32x16_bf16(pa2,PK(2),o[d0],0,0,0);
    o[d0]=__builtin_amdgcn_mfma_f32_32x32x16_bf16(pa3,PK(3),o[d0],0,0,0);
    #undef PK
  }
}

template<int THRL> __device__ __forceinline__ void attn_unit(long rowbase,int qb,const bf16*Qc,const bf16*__restrict__ Kc,const bf16*__restrict__ Vc,bf16*Oc,char*shm,const int tid0){
  int tid_=tid0; asm volatile("":"+v"(tid_)); const int tid=tid_,lane=tid&63,r32=lane&31,hi=lane>>5; const int wid=__builtin_amdgcn_readfirstlane(tid>>6);
  const int q0=qb*QB;
  const bf16*Qw=Qc+(rowbase+q0+wid*QBLK)*PQ;
  const bf16*Kh=Kc+rowbase*PQ,*Vh=Vc+rowbase*PQ;
  const unsigned lds0=(unsigned)(uintptr_t)shm;
  float*wsf=(float*)(shm+LDS_WS)+wid*64;
  const bf16*ksrc=Kh+(long)lane*PQ+wid*8;
  const bf16*vsrc=Vh+(long)(16*(wid&3)+(lane>>2))*PQ+(wid>>2)*32+(lane&3)*8;
  const unsigned kdst=lds0+LDS_K+wid*1024, vdst=lds0+LDS_V+wid*1024;
  #define DMA_K(t,slot) glds16(ksrc+(long)(t)*KVBLK*PQ,(unsigned)__builtin_amdgcn_readfirstlane(kdst+(slot)))
  #define DMA_V(t,slot) glds16(vsrc+(long)(t)*KVBLK*PQ,(unsigned)__builtin_amdgcn_readfirstlane(vdst+(slot)))
  const int vb0=(int)(lds0+LDS_V)+((lane>>4)&1)*32+(lane&3)*8+(4*hi+((lane&15)>>2))*64;
  const char*Kbase=shm+LDS_K; bf16x8 kf[8];
  const lds_cptr shm3=(lds_cptr)shm; const lds_cptr kp0=shm3+LDS_K+hi*1024+r32*16; const lds_cptr vp0=shm3+LDS_V+((lane>>4)&1)*32+(lane&3)*8+(4*hi+((lane&15)>>2))*64;
  const int NT=(q0+QB)/KVBLK;
  DMA_K(0,0);DMA_V(0,0);DMA_K(1,SLOTB);
  bf16x8 qr[4];
  #pragma unroll
  for(int d0=0;d0<4;++d0)qr[d0]=*reinterpret_cast<const bf16x8*>(&Qw[(long)r32*PQ+d0*16+hi*8]);
  float mhat=0.f,l_reg=0.f;float zsrc=0.f;asm volatile("":"+v"(zsrc));
  f32x16 o[2],negm;
  #pragma unroll
  for(int r=0;r<16;++r){o[0][r]=zsrc;o[1][r]=zsrc;negm[r]=zsrc;}
  asm volatile("":"+v"(negm));
  const int qrel=wid*QBLK+r32;
  #define CMASK(P0,P1,t) do{int jb_=(t)-(NT-4); if(jb_>=0)cmask(P0,P1,jb_,qrel,hi);}while(0)
  bool resc=false;
  #define START(P0,P1) do{ const float rm=rowmax(P0,P1); resc=false; \
    { const float dl=rm; mhat=fadd_s(mhat,dl); \
      _Pragma("unroll") for(int r=0;r<16;++r){P0[r]=fsub_s(P0[r],dl);P1[r]=fsub_s(P1[r],dl);} \
      _Pragma("unroll") for(int r=0;r<16;++r)negm[r]=-mhat; asm volatile("":"+v"(negm)); } \
    _Pragma("unroll") for(int r=0;r<16;++r)P0[r]=__builtin_amdgcn_exp2f(P0[r]); }while(0)
  #define RESC() do{ if(resc){ asm volatile("s_waitcnt lgkmcnt(0)":::"memory"); \
      _Pragma("unroll") for(int d_=0;d_<2;++d_) _Pragma("unroll") for(int r=0;r<16;++r)o[d_][r]*=wsf[crow(r,hi)]; } }while(0)
  f32x16 pA0,pA1,pB0,pB1;
  int sl_prev=0,sl_cur=0,sl_next=SLOTB;
  #define ROT() do{sl_prev=sl_cur;sl_cur=sl_next;sl_next=(sl_next==(NSLOT-1)*SLOTB)?0:sl_next+SLOTB;}while(0)
  DMA_K(2,2*SLOTB);
  WAIT_BAR(3);
  qkt(pA0,pA1,Kbase,qr,negm,r32,hi);asm volatile("s_nop 15\n\ts_nop 7":"+v"(pA0),"+v"(pA1));CMASK(pA0,pA1,0);
  START(pA0,pA1);
  _Pragma("unroll") for(int r=0;r<16;++r)pA1[r]=__builtin_amdgcn_exp2f(pA1[r]);
  WAIT_BAR(0);
  DMA_K(3,0);DMA_V(1,SLOTB);
  ROT();
  kload8(kf,kp0+sl_cur);
  WAIT_BAR(2);
  s16x4 vlo[8],vhi[8]; u32x4 pw0,pw1,pw2,pw3;
  #define PKW(P,B) cvtpk_s(P[B],P[B+1])
  #define PAF(k) __builtin_bit_cast(bf16x8,pw##k)
  #define VFR(i) (bf16x8){vlo[i][0],vlo[i][1],vlo[i][2],vlo[i][3],vhi[i][0],vhi[i][1],vhi[i][2],vhi[i][3]}
  #define PIN(x) asm volatile("":"+v"(x))
  #define MX3(a,b,c) __builtin_fmaxf(__builtin_fmaxf((a),(b)),(c))
  #define GAPA(MF,A0,A1,A2,A3,W0,W1,PW) do{ MF; sacc+=A0; sacc+=A1; sacc+=A2; sacc+=A3; PIN(sacc); W0; W1; PIN(PW); SBAR(); }while(0)
  #define EX(v) __builtin_amdgcn_exp2f(v)
  #define GAPB(MF,X,B) do{ MF; X[B]=EX(X[B]); X[B+1]=EX(X[B+1]); X[B+2]=EX(X[B+2]); X[B+3]=EX(X[B+3]); PIN(X); SBAR(); }while(0)
  #define VRD(i) do{ vlo[i]=vtr(vp_+(((i)>>2)*4096+((i)&3)*1024)); vhi[i]=vtr(vp_+(((i)>>2)*4096+((i)&3)*1024+512)); }while(0)
  #define KRD(G,j) do{ if(G){ kload2(kf,kp0+sl_next,j); SBAR(); } }while(0)
  #define STEP(C0,C1,P0,P1,t,GK,GV,GL) do{ SBAR(); \
    const lds_cptr vp_=vp0+sl_prev; \
    VRD(0); SBAR(); float sacc=(P0[0]+P0[1]); \
    GAPA(C0=__builtin_amdgcn_mfma_f32_32x32x16_bf16(kf[0],qr[0],negm,0,0,0), P0[2],P0[3],P0[4],P0[5],     pw0[0]=PKW(P0,0), pw0[1]=PKW(P0,2), pw0); \
    VRD(4); SBAR(); GAPA(C1=__builtin_amdgcn_mfma_f32_32x32x16_bf16(kf[1],qr[0],negm,0,0,0), P0[6],P0[7],P0[8],P0[9],     pw0[2]=PKW(P0,4), pw0[3]=PKW(P0,6), pw0); \
    VRD(1); SBAR(); GAPA(C0=__builtin_amdgcn_mfma_f32_32x32x16_bf16(kf[2],qr[1],C0,0,0,0),   P0[10],P0[11],P0[12],P0[13], pw1[0]=PKW(P0,8), pw1[1]=PKW(P0,10), pw1); \
    VRD(5); SBAR(); GAPA(C1=__builtin_amdgcn_mfma_f32_32x32x16_bf16(kf[3],qr[1],C1,0,0,0),   P0[14],P0[15],P1[0],P1[1],   pw1[2]=PKW(P0,12),pw1[3]=PKW(P0,14), pw1); \
    VRD(2); SBAR(); GAPA(C0=__builtin_amdgcn_mfma_f32_32x32x16_bf16(kf[4],qr[2],C0,0,0,0),   P1[2],P1[3],P1[4],P1[5],     pw2[0]=PKW(P1,0), pw2[1]=PKW(P1,2), pw2); \
    VRD(6); SBAR(); GAPA(C1=__builtin_amdgcn_mfma_f32_32x32x16_bf16(kf[5],qr[2],C1,0,0,0),   P1[6],P1[7],P1[8],P1[9],     pw2[2]=PKW(P1,4), pw2[3]=PKW(P1,6), pw2); \
    VRD(3); SBAR(); GAPA(C0=__builtin_amdgcn_mfma_f32_32x32x16_bf16(kf[6],qr[3],C0,0,0,0),   P1[10],P1[11],P1[12],P1[13], pw3[0]=PKW(P1,8), pw3[1]=PKW(P1,10), pw3); \
    VRD(7); SBAR(); GAPA(C1=__builtin_amdgcn_mfma_f32_32x32x16_bf16(kf[7],qr[3],C1,0,0,0),   P1[14],P1[15],0.f,0.f,       pw3[2]=PKW(P1,12),pw3[3]=PKW(P1,14), pw3); \
    l_reg+=sacc; \
    if(GK){DMA_K((t)+3,sl_cur);} if(GV){DMA_V((t)+1,sl_next);} \
    CMASK(C0,C1,t); \
    { float a=MX3(C0[0],C0[1],C1[0]),b=MX3(C0[2],C0[3],C1[1]); a=MX3(a,C1[2],C1[3]); \
      _Pragma("unroll") for(int r=4;r<16;r+=4){a=MX3(a,C0[r],C0[r+1]);b=MX3(b,C0[r+2],C0[r+3]);a=MX3(a,C1[r],C1[r+1]);b=MX3(b,C1[r+2],C1[r+3]);} \
      float rm=__builtin_fmaxf(a,b); { auto rr=__builtin_amdgcn_permlane32_swap(__float_as_uint(rm),__float_as_uint(rm),false,false); rm=__builtin_fmaxf(__uint_as_float(rr[0]),__uint_as_float(rr[1])); } \
      resc=false; \
      if(__builtin_expect(__any(rm>(float)THRL),0)){ const float dl=__builtin_fmaxf(rm,0.f); mhat+=dl; \
        _Pragma("unroll") for(int r=0;r<16;++r){C0[r]-=dl;C1[r]-=dl;} \
        _Pragma("unroll") for(int r=0;r<16;++r)negm[r]=-mhat; asm volatile("":"+v"(negm)); \
        const float f=__builtin_amdgcn_exp2f(-dl); l_reg*=f; if(hi==0)wsf[r32]=f; resc=true; } } \
    SBAR(); \
    GAPB(o[0]=__builtin_amdgcn_mfma_f32_32x32x16_bf16(PAF(0),VFR(0),o[0],0,0,0), C0,0); \
    GAPB(o[1]=__builtin_amdgcn_mfma_f32_32x32x16_bf16(PAF(0),VFR(4),o[1],0,0,0), C0,4); \
    KRD(GL,0); GAPB(o[0]=__builtin_amdgcn_mfma_f32_32x32x16_bf16(PAF(1),VFR(1),o[0],0,0,0), C0,8); \
    KRD(GL,1); GAPB(o[1]=__builtin_amdgcn_mfma_f32_32x32x16_bf16(PAF(1),VFR(5),o[1],0,0,0), C0,12); \
    KRD(GL,2); GAPB(o[0]=__builtin_amdgcn_mfma_f32_32x32x16_bf16(PAF(2),VFR(2),o[0],0,0,0), C1,0); \
    KRD(GL,3); GAPB(o[1]=__builtin_amdgcn_mfma_f32_32x32x16_bf16(PAF(2),VFR(6),o[1],0,0,0), C1,4); \
    GAPB(o[0]=__builtin_amdgcn_mfma_f32_32x32x16_bf16(PAF(3),VFR(3),o[0],0,0,0), C1,8); \
    GAPB(o[1]=__builtin_amdgcn_mfma_f32_32x32x16_bf16(PAF(3),VFR(7),o[1],0,0,0), C1,12); \
    }while(0)
  int t=1;
  #undef CMASK
  #define CMASK(P0,P1,t) do{}while(0)
  for(;t+5<NT;t+=2){
    STEP(pB0,pB1,pA0,pA1,t,true,true,true);     WAIT_BAR(2); RESC(); ROT();
    STEP(pA0,pA1,pB0,pB1,t+1,true,true,true);   WAIT_BAR(2); RESC(); ROT();
  }
  #undef CMASK
  #define CMASK(P0,P1,t) do{int jb_=(t)-(NT-4); if(jb_>=0)cmask(P0,P1,jb_,qrel,hi);}while(0)
  #define ENDW(tt) do{ if((tt)+3<NT){WAIT_BAR(2);} else if((tt)+2<NT){WAIT_BAR(1);} else {WAIT_BAR(0);} }while(0)
  for(;t+1<NT;t+=2){
    STEP(pB0,pB1,pA0,pA1,t,(t+3<NT),(t+1<NT),(t+1<NT));       ENDW(t);   RESC(); ROT();
    STEP(pA0,pA1,pB0,pB1,t+1,(t+4<NT),(t+2<NT),(t+2<NT));     ENDW(t+1); RESC(); ROT();
  }
  STEP(pB0,pB1,pA0,pA1,NT-1,false,false,false); RESC();
  { float sacc=pB0[0]+pB0[1]; _Pragma("unroll") for(int r=2;r<16;++r)sacc+=pB0[r]; _Pragma("unroll") for(int r=0;r<16;++r)sacc+=pB1[r]; l_reg+=sacc;
    pw0=(u32x4){PKW(pB0,0),PKW(pB0,2),PKW(pB0,4),PKW(pB0,6)};pw1=(u32x4){PKW(pB0,8),PKW(pB0,10),PKW(pB0,12),PKW(pB0,14)};pw2=(u32x4){PKW(pB1,0),PKW(pB1,2),PKW(pB1,4),PKW(pB1,6)};pw3=(u32x4){PKW(pB1,8),PKW(pB1,10),PKW(pB1,12),PKW(pB1,14)};
    SBAR(); pv(o,vb0+sl_cur,PAF(0),PAF(1),PAF(2),PAF(3)); }
  #undef PKW
  #undef PAF
  #undef VFR
  #undef PIN
  #undef MX3
  #undef GAPA
  #undef GAPB
  #undef EX
  #undef VRD
  #undef KRD
  #undef STEP
  #undef ENDW
  {auto rr=__builtin_amdgcn_permlane32_swap(__float_as_uint(l_reg),__float_as_uint(l_reg),false,false);l_reg=__uint_as_float(rr[0])+__uint_as_float(rr[1]);}
  if(hi==0)wsf[32+r32]=l_reg;asm volatile("s_waitcnt lgkmcnt(0)":::"memory");
  float rli[16];
  #pragma unroll
  for(int r=0;r<16;++r)rli[r]=__builtin_amdgcn_rcpf(wsf[32+crow(r,hi)]);
  bf16*Ow=Oc+(rowbase+q0+wid*QBLK)*PO;
  { bf16*stg=(bf16*)(shm+LDS_OST)+wid*2048;
    #pragma unroll
    for(int r=0;r<16;++r){const int orow=crow(r,hi);
      #pragma unroll
      for(int d0=0;d0<2;++d0)stg[orow*64+d0*32+r32]=__float2bfloat16(o[d0][r]*rli[r]);}
    asm volatile("s_waitcnt lgkmcnt(0)":::"memory");
    #pragma unroll
    for(int i=0;i<4;++i){const int row=i*8+(lane>>3),ch=lane&7; const u32x4 v=*(const u32x4*)(stg+row*64+ch*8); ATTN_STORE16(Ow+(long)row*PO+ch*8,v);} }
  asm volatile("s_waitcnt lgkmcnt(0)\n\ts_barrier":::"memory");
  #undef DMA_K
  #undef DMA_V
  #undef CMASK
  #undef START
  #undef RESC
  #undef ROT
}
__device__ __forceinline__ void pv128(f32x16*o,int vb,bf16x8 pa0,bf16x8 pa1,bf16x8 pa2,bf16x8 pa3){
  #pragma unroll
  for(int d0=0;d0<4;++d0){s16x4 lo[4],hi[4];
    #pragma unroll
    for(int ks=0;ks<4;++ks){
      asm volatile("ds_read_b64_tr_b16 %0,%1 offset:%c2":"=&v"(lo[ks]):"v"(vb),"i"(d0*4096+ks*1024):"memory");
      asm volatile("ds_read_b64_tr_b16 %0,%1 offset:%c2":"=&v"(hi[ks]):"v"(vb),"i"(d0*4096+ks*1024+512):"memory");}
    asm volatile("s_waitcnt lgkmcnt(0)":::"memory");SBAR();
    #define PK(k) (bf16x8){lo[k][0],lo[k][1],lo[k][2],lo[k][3],hi[k][0],hi[k][1],hi[k][2],hi[k][3]}
    o[d0]=__builtin_amdgcn_mfma_f32_32x32x16_bf16(pa0,PK(0),o[d0],0,0,0);
    o[d0]=__builtin_amdgcn_mfma_f32_32x32x16_bf16(pa1,PK(1),o[d0],0,0,0);
    o[d0]=__builtin_amdgcn_mfma_f32_32x32x16_bf16(pa2,PK(2),o[d0],0,0,0);
    o[d0]=__builtin_amdgcn_mfma_f32_32x32x16_bf16(pa3,PK(3),o[d0],0,0,0);
    #undef PK
  }
}
constexpr int SLOTBV=16384, LDS_V2=NSLOT*SLOTB, LDS_WS2=LDS_V2+NSLOT*SLOTBV, LDS_OST2=LDS_WS2+NW*64*4, LDS_BYTES2=LDS_OST2+NW*4096;
template<int THRL> __device__ __forceinline__ void attn_unit128(long rowbase,int qb,const bf16*Qc,const bf16*__restrict__ Kc,const bf16*__restrict__ Vc,bf16*Oc,char*shm,const int tid0){
  int tid_=tid0; asm volatile("":"+v"(tid_)); const int tid=tid_,lane=tid&63,r32=lane&31,hi=lane>>5; const int wid=__builtin_amdgcn_readfirstlane(tid>>6);
  const int q0=qb*QB;
  const bf16*Qw=Qc+(rowbase+q0+wid*QBLK)*PQ;
  const bf16*Kh=Kc+rowbase*PQ,*Vh=Vc+rowbase*PQ;
  const unsigned lds0=(unsigned)(uintptr_t)shm;
  float*wsf=(float*)(shm+LDS_WS2)+wid*64;
  const bf16*ksrc=Kh+(long)lane*PQ+wid*8;
  const bf16*vsrc=Vh+(long)(16*(wid&3)+(lane>>2))*PQ+(wid>>2)*32+(lane&3)*8;
  const unsigned kdst=lds0+LDS_K+wid*1024, vdst=lds0+LDS_V2+wid*1024;
  #define DMA_K(t,slot) glds16(ksrc+(long)(t)*KVBLK*PQ,(unsigned)__builtin_amdgcn_readfirstlane(kdst+(slot)))
  #define DMA_V(t,slot) do{ glds16(vsrc+(long)(t)*KVBLK*PQ,(unsigned)__builtin_amdgcn_readfirstlane(vdst+2*(slot))); glds16(vsrc+64+(long)(t)*KVBLK*PQ,(unsigned)__builtin_amdgcn_readfirstlane(vdst+8192+2*(slot))); }while(0)
  const char*Kbase=shm+LDS_K; bf16x8 kf[8];
  const lds_cptr shm3=(lds_cptr)shm; const lds_cptr kp0=shm3+LDS_K+hi*1024+r32*16; const lds_cptr vp0=shm3+LDS_V2+((lane>>4)&1)*32+(lane&3)*8+(4*hi+((lane&15)>>2))*64;
  const int NT=(q0+QB)/KVBLK;
  DMA_K(0,0);DMA_V(0,0);DMA_K(1,SLOTB);
  bf16x8 qr[4];
  #pragma unroll
  for(int d0=0;d0<4;++d0)qr[d0]=*reinterpret_cast<const bf16x8*>(&Qw[(long)r32*PQ+d0*16+hi*8]);
  float mhat=0.f,l_reg=0.f;float zsrc=0.f;asm volatile("":"+v"(zsrc));
  f32x16 o[4],negm;
  #pragma unroll
  for(int r=0;r<16;++r){o[0][r]=zsrc;o[1][r]=zsrc;o[2][r]=zsrc;o[3][r]=zsrc;negm[r]=zsrc;}
  asm volatile("":"+v"(negm));
  #define CMASK(P0,P1,t) do{int jb_=(t)-(NT-4); if(jb_>=0)cmask(P0,P1,jb_,wid*QBLK+r32,hi);}while(0)
  bool resc=false;
  #define START(P0,P1) do{ const float rm=rowmax(P0,P1); resc=false; \
    { const float dl=rm; mhat=fadd_s(mhat,dl); \
      _Pragma("unroll") for(int r=0;r<16;++r){P0[r]=fsub_s(P0[r],dl);P1[r]=fsub_s(P1[r],dl);} \
      _Pragma("unroll") for(int r=0;r<16;++r)negm[r]=-mhat; asm volatile("":"+v"(negm)); } \
    _Pragma("unroll") for(int r=0;r<16;++r)P0[r]=__builtin_amdgcn_exp2f(P0[r]); }while(0)
  #define RESC() do{ if(resc){ asm volatile("s_waitcnt lgkmcnt(0)":::"memory"); \
      _Pragma("unroll") for(int d_=0;d_<4;++d_) _Pragma("unroll") for(int r=0;r<16;++r)o[d_][r]*=wsf[crow(r,hi)]; } }while(0)
  f32x16 pA0,pA1,pB0,pB1;
  int sl_prev=0,sl_cur=0,sl_next=SLOTB;
  #define ROT() do{sl_prev=sl_cur;sl_cur=sl_next;sl_next=(sl_next==(NSLOT-1)*SLOTB)?0:sl_next+SLOTB;}while(0)
  DMA_K(2,2*SLOTB);
  WAIT_BAR(3);
  qkt(pA0,pA1,Kbase,qr,negm,r32,hi);asm volatile("s_nop 15\n\ts_nop 7":"+v"(pA0),"+v"(pA1));CMASK(pA0,pA1,0);
  START(pA0,pA1);
  _Pragma("unroll") for(int r=0;r<16;++r)pA1[r]=__builtin_amdgcn_exp2f(pA1[r]);
  WAIT_BAR(0);
  DMA_K(3,0);DMA_V(1,SLOTB);
  ROT();
  kload8(kf,kp0+sl_cur);
  WAIT_BAR(3);
  s16x4 vlo[8],vhi[8]; u32x4 pw0,pw1,pw2,pw3;
  #define PKW(P,B) cvtpk_s(P[B],P[B+1])
  #define PAF(k) __builtin_bit_cast(bf16x8,pw##k)
  #define VFR(i) (bf16x8){vlo[i][0],vlo[i][1],vlo[i][2],vlo[i][3],vhi[i][0],vhi[i][1],vhi[i][2],vhi[i][3]}
  #define PIN(x) asm volatile("":"+v"(x))
  #define MX3(a,b,c) __builtin_fmaxf(__builtin_fmaxf((a),(b)),(c))
  #define GAPA(MF,A0,A1,A2,A3,W0,W1,PW) do{ MF; sacc+=A0; sacc+=A1; sacc+=A2; sacc+=A3; PIN(sacc); W0; W1; PIN(PW); SBAR(); }while(0)
  #define EX(v) __builtin_amdgcn_exp2f(v)
  #define GAPB(MF,X,B) do{ MF; X[B]=EX(X[B]); X[B+1]=EX(X[B+1]); X[B+2]=EX(X[B+2]); X[B+3]=EX(X[B+3]); PIN(X); SBAR(); }while(0)
  #define GAPB2(MF,X,B) do{ MF; X[B]=EX(X[B]); X[B+1]=EX(X[B+1]); PIN(X); SBAR(); }while(0)
  #define VRD2(i) do{ vlo[i]=vtr(vp_+((((i)>>2)+2)*4096+((i)&3)*1024)); vhi[i]=vtr(vp_+((((i)>>2)+2)*4096+((i)&3)*1024+512)); }while(0)
  #define VRD(i) do{ vlo[i]=vtr(vp_+(((i)>>2)*4096+((i)&3)*1024)); vhi[i]=vtr(vp_+(((i)>>2)*4096+((i)&3)*1024+512)); }while(0)
  #define KRD(G,j) do{ if(G){ kload2(kf,kp0+sl_next,j); SBAR(); } }while(0)
  #define STEP(C0,C1,P0,P1,t,GK,GV,GL) do{ SBAR(); \
    const lds_cptr vp_=vp0+2*sl_prev; \
    VRD(0); SBAR(); float sacc=(P0[0]+P0[1]); \
    GAPA(C0=__builtin_amdgcn_mfma_f32_32x32x16_bf16(kf[0],qr[0],negm,0,0,0), P0[2],P0[3],P0[4],P0[5],     pw0[0]=PKW(P0,0), pw0[1]=PKW(P0,2), pw0); \
    VRD(4); SBAR(); GAPA(C1=__builtin_amdgcn_mfma_f32_32x32x16_bf16(kf[1],qr[0],negm,0,0,0), P0[6],P0[7],P0[8],P0[9],     pw0[2]=PKW(P0,4), pw0[3]=PKW(P0,6), pw0); \
    VRD(1); SBAR(); GAPA(C0=__builtin_amdgcn_mfma_f32_32x32x16_bf16(kf[2],qr[1],C0,0,0,0),   P0[10],P0[11],P0[12],P0[13], pw1[0]=PKW(P0,8), pw1[1]=PKW(P0,10), pw1); \
    VRD(5); SBAR(); GAPA(C1=__builtin_amdgcn_mfma_f32_32x32x16_bf16(kf[3],qr[1],C1,0,0,0),   P0[14],P0[15],P1[0],P1[1],   pw1[2]=PKW(P0,12),pw1[3]=PKW(P0,14), pw1); \
    VRD(2); SBAR(); GAPA(C0=__builtin_amdgcn_mfma_f32_32x32x16_bf16(kf[4],qr[2],C0,0,0,0),   P1[2],P1[3],P1[4],P1[5],     pw2[0]=PKW(P1,0), pw2[1]=PKW(P1,2), pw2); \
    VRD(6); SBAR(); GAPA(C1=__builtin_amdgcn_mfma_f32_32x32x16_bf16(kf[5],qr[2],C1,0,0,0),   P1[6],P1[7],P1[8],P1[9],     pw2[2]=PKW(P1,4), pw2[3]=PKW(P1,6), pw2); \
    VRD(3); SBAR(); GAPA(C0=__builtin_amdgcn_mfma_f32_32x32x16_bf16(kf[6],qr[3],C0,0,0,0),   P1[10],P1[11],P1[12],P1[13], pw3[0]=PKW(P1,8), pw3[1]=PKW(P1,10), pw3); \
    VRD(7); SBAR(); GAPA(C1=__builtin_amdgcn_mfma_f32_32x32x16_bf16(kf[7],qr[3],C1,0,0,0),   P1[14],P1[15],0.f,0.f,       pw3[2]=PKW(P1,12),pw3[3]=PKW(P1,14), pw3); \
    l_reg+=sacc; \
    if(GK){DMA_K((t)+3,sl_cur);} if(GV){DMA_V((t)+1,sl_next);} \
    CMASK(C0,C1,t); \
    { float a=MX3(C0[0],C0[1],C1[0]),b=MX3(C0[2],C0[3],C1[1]); a=MX3(a,C1[2],C1[3]); \
      _Pragma("unroll") for(int r=4;r<16;r+=4){a=MX3(a,C0[r],C0[r+1]);b=MX3(b,C0[r+2],C0[r+3]);a=MX3(a,C1[r],C1[r+1]);b=MX3(b,C1[r+2],C1[r+3]);} \
      float rm=__builtin_fmaxf(a,b); { auto rr=__builtin_amdgcn_permlane32_swap(__float_as_uint(rm),__float_as_uint(rm),false,false); rm=__builtin_fmaxf(__uint_as_float(rr[0]),__uint_as_float(rr[1])); } \
      resc=false; \
      if(__builtin_expect(__any(rm>(float)THRL),0)){ const float dl=__builtin_fmaxf(rm,0.f); mhat+=dl; \
        _Pragma("unroll") for(int r=0;r<16;++r){C0[r]-=dl;C1[r]-=dl;} \
        _Pragma("unroll") for(int r=0;r<16;++r)negm[r]=-mhat; asm volatile("":"+v"(negm)); \
        const float f=__builtin_amdgcn_exp2f(-dl); l_reg*=f; if(hi==0)wsf[r32]=f; resc=true; } } \
    SBAR(); \
    GAPB2(o[0]=__builtin_amdgcn_mfma_f32_32x32x16_bf16(PAF(0),VFR(0),o[0],0,0,0), C0,0); VRD2(0); SBAR(); \
    GAPB2(o[1]=__builtin_amdgcn_mfma_f32_32x32x16_bf16(PAF(0),VFR(4),o[1],0,0,0), C0,2); VRD2(4); SBAR(); \
    KRD(GL,0); GAPB2(o[0]=__builtin_amdgcn_mfma_f32_32x32x16_bf16(PAF(1),VFR(1),o[0],0,0,0), C0,4); VRD2(1); SBAR(); \
    KRD(GL,1); GAPB2(o[1]=__builtin_amdgcn_mfma_f32_32x32x16_bf16(PAF(1),VFR(5),o[1],0,0,0), C0,6); VRD2(5); SBAR(); \
    KRD(GL,2); GAPB2(o[0]=__builtin_amdgcn_mfma_f32_32x32x16_bf16(PAF(2),VFR(2),o[0],0,0,0), C0,8); VRD2(2); SBAR(); \
    KRD(GL,3); GAPB2(o[1]=__builtin_amdgcn_mfma_f32_32x32x16_bf16(PAF(2),VFR(6),o[1],0,0,0), C0,10); VRD2(6); SBAR(); \
    GAPB2(o[0]=__builtin_amdgcn_mfma_f32_32x32x16_bf16(PAF(3),VFR(3),o[0],0,0,0), C0,12); VRD2(3); SBAR(); \
    GAPB2(o[1]=__builtin_amdgcn_mfma_f32_32x32x16_bf16(PAF(3),VFR(7),o[1],0,0,0), C0,14); VRD2(7); SBAR(); \
    GAPB2(o[2]=__builtin_amdgcn_mfma_f32_32x32x16_bf16(PAF(0),VFR(0),o[2],0,0,0), C1,0); \
    GAPB2(o[3]=__builtin_amdgcn_mfma_f32_32x32x16_bf16(PAF(0),VFR(4),o[3],0,0,0), C1,2); \
    GAPB2(o[2]=__builtin_amdgcn_mfma_f32_32x32x16_bf16(PAF(1),VFR(1),o[2],0,0,0), C1,4); \
    GAPB2(o[3]=__builtin_amdgcn_mfma_f32_32x32x16_bf16(PAF(1),VFR(5),o[3],0,0,0), C1,6); \
    GAPB2(o[2]=__builtin_amdgcn_mfma_f32_32x32x16_bf16(PAF(2),VFR(2),o[2],0,0,0), C1,8); \
    GAPB2(o[3]=__builtin_amdgcn_mfma_f32_32x32x16_bf16(PAF(2),VFR(6),o[3],0,0,0), C1,10); \
    GAPB2(o[2]=__builtin_amdgcn_mfma_f32_32x32x16_bf16(PAF(3),VFR(3),o[2],0,0,0), C1,12); \
    GAPB2(o[3]=__builtin_amdgcn_mfma_f32_32x32x16_bf16(PAF(3),VFR(7),o[3],0,0,0), C1,14); \
    }while(0)
  int t=1;
  #undef CMASK
  #define CMASK(P0,P1,t) do{}while(0)
  for(;t+5<NT;t+=2){
    STEP(pB0,pB1,pA0,pA1,t,true,true,true);     WAIT_BAR(3); RESC(); ROT();
    STEP(pA0,pA1,pB0,pB1,t+1,true,true,true);   WAIT_BAR(3); RESC(); ROT();
  }
  #undef CMASK
  #define CMASK(P0,P1,t) do{int jb_=(t)-(NT-4); if(jb_>=0)cmask(P0,P1,jb_,wid*QBLK+r32,hi);}while(0)
  #define ENDW(tt) do{ if((tt)+3<NT){WAIT_BAR(3);} else if((tt)+2<NT){WAIT_BAR(2);} else {WAIT_BAR(0);} }while(0)
  for(;t+1<NT;t+=2){
    STEP(pB0,pB1,pA0,pA1,t,(t+3<NT),(t+1<NT),(t+1<NT));       ENDW(t);   RESC(); ROT();
    STEP(pA0,pA1,pB0,pB1,t+1,(t+4<NT),(t+2<NT),(t+2<NT));     ENDW(t+1); RESC(); ROT();
  }
  STEP(pB0,pB1,pA0,pA1,NT-1,false,false,false); RESC();
  { float sacc=pB0[0]+pB0[1]; _Pragma("unroll") for(int r=2;r<16;++r)sacc+=pB0[r]; _Pragma("unroll") for(int r=0;r<16;++r)sacc+=pB1[r]; l_reg+=sacc;
    pw0=(u32x4){PKW(pB0,0),PKW(pB0,2),PKW(pB0,4),PKW(pB0,6)};pw1=(u32x4){PKW(pB0,8),PKW(pB0,10),PKW(pB0,12),PKW(pB0,14)};pw2=(u32x4){PKW(pB1,0),PKW(pB1,2),PKW(pB1,4),PKW(pB1,6)};pw3=(u32x4){PKW(pB1,8),PKW(pB1,10),PKW(pB1,12),PKW(pB1,14)};
    SBAR(); const int vb0=(int)(lds0+LDS_V2)+((lane>>4)&1)*32+(lane&3)*8+(4*hi+((lane&15)>>2))*64; pv128(o,vb0+2*sl_cur,PAF(0),PAF(1),PAF(2),PAF(3)); }
  #undef PKW
  #undef PAF
  #undef VFR
  #undef PIN
  #undef MX3
  #undef GAPA
  #undef GAPB
  #undef GAPB2
  #undef VRD2
  #undef EX
  #undef VRD
  #undef KRD
  #undef STEP
  #undef ENDW
  {auto rr=__builtin_amdgcn_permlane32_swap(__float_as_uint(l_reg),__float_as_uint(l_reg),false,false);l_reg=__uint_as_float(rr[0])+__uint_as_float(rr[1]);}
  if(hi==0)wsf[32+r32]=l_reg;asm volatile("s_waitcnt lgkmcnt(0)":::"memory");
  float rli[16];
  #pragma unroll
  for(int r=0;r<16;++r)rli[r]=__builtin_amdgcn_rcpf(wsf[32+crow(r,hi)]);
  bf16*Ow=Oc+(rowbase+q0+wid*QBLK)*PO;
  { bf16*stg=(bf16*)(shm+LDS_OST2)+wid*2048;
    #pragma unroll
    for(int hh=0;hh<2;++hh){
      #pragma unroll
      for(int r=0;r<16;++r){const int orow=crow(r,hi);
        #pragma unroll
        for(int d0=0;d0<2;++d0)stg[orow*64+d0*32+r32]=__float2bfloat16(o[2*hh+d0][r]*rli[r]);}
      asm volatile("s_waitcnt lgkmcnt(0)":::"memory");
      #pragma unroll
      for(int i=0;i<4;++i){const int row=i*8+(lane>>3),ch=lane&7; const u32x4 v=*(const u32x4*)(stg+row*64+ch*8); ATTN_STORE16(Ow+(long)row*PO+hh*64+ch*8,v);}
      asm volatile("s_waitcnt lgkmcnt(0)":::"memory"); } }
  asm volatile("s_waitcnt lgkmcnt(0)\n\ts_barrier":::"memory");
  #undef DMA_K
  #undef DMA_V
  #undef CMASK
  #undef START
  #undef RESC
  #undef ROT
}
constexpr int ATTN_LDS_BYTES=LDS_BYTES;
#undef SBAR
#undef WAIT_BAR
}
#define GAS __attribute__((address_space(1)))
#define LAS __attribute__((address_space(3)))
typedef unsigned v4u __attribute__((ext_vector_type(4)));
typedef float f32x4 __attribute__((ext_vector_type(4)));
typedef short bf16x8 __attribute__((ext_vector_type(8)));
typedef GAS unsigned gu32;
typedef GAS unsigned long long gu64;
#define RLX_AGENT __ATOMIC_RELAXED, __HIP_MEMORY_SCOPE_AGENT
#define LDS_WAIT() asm volatile("s_waitcnt lgkmcnt(0)" ::: "memory")
#define VM_WAIT() asm volatile("s_waitcnt vmcnt(0)" ::: "memory")
__device__ __forceinline__ int lane_id() { int l; asm volatile("v_mbcnt_lo_u32_b32 %0, -1, 0\n\tv_mbcnt_hi_u32_b32 %0, -1, %0" : "=v"(l)); return l; }
__device__ __forceinline__ unsigned long long rt() { return __builtin_amdgcn_s_memrealtime(); }
typedef float pk_f32x2 __attribute__((ext_vector_type(2))); typedef __bf16 pk_bf16x2 __attribute__((ext_vector_type(2)));
__device__ __forceinline__ unsigned pk2(float lo, float hi) { pk_f32x2 v = {lo, hi}; pk_bf16x2 b = __builtin_convertvector(v, pk_bf16x2); return __builtin_bit_cast(unsigned, b); }

#define XB_TMO      128
#define XB_XCNT(j)  (256  + 64 * (j))
#define XB_XSUB(j)  (1280 + 64 * (j))
#define XB_XGEN(j)  (2304 + 64 * (j))
#define XB_TOP      3328
#define XB_TOPGEN   3392
#define XCD_BAR_WORDS 3456
#define XB_SPIN_CAP (1u << 18)

__device__ __forceinline__ unsigned xb_ld(unsigned* p)              { return __hip_atomic_load(p, __ATOMIC_RELAXED, __HIP_MEMORY_SCOPE_AGENT); }
__device__ __forceinline__ unsigned xb_add(unsigned* p, unsigned v) { return __hip_atomic_fetch_add(p, v, __ATOMIC_RELAXED, __HIP_MEMORY_SCOPE_AGENT); }
__device__ __forceinline__ unsigned xb_xcc_id() { return (unsigned)__builtin_amdgcn_s_getreg((3 << 11) | 20) & 0xFu; }
#define XB_SPIN(cond, bar) do { unsigned _sp = 0; while (cond) { __builtin_amdgcn_s_sleep(1); \
    if ((++_sp & 255u) == 0u) { if (xb_ld(&(bar)[XB_TMO])) break; if (_sp > XB_SPIN_CAP) { atomicAdd(&(bar)[XB_TMO], 1u); break; } } } } while (0)

struct XcdBarrier {
    unsigned* bar; unsigned x;
    volatile LAS unsigned* st;
};

__device__ __forceinline__ XcdBarrier xcd_barrier_post(unsigned* bar, volatile LAS unsigned* st, const int tid0) {
    XcdBarrier b; b.bar = bar; b.x = xb_xcc_id(); b.st = st;
    if (tid0 == 0) (void)xb_add(&bar[XB_XCNT(b.x)], 1u);
    return b;
}
__device__ __forceinline__ void xcd_barrier_complete(unsigned* bar, unsigned x, unsigned& nloc, unsigned& nx) {
    const unsigned G = gridDim.x * gridDim.y * gridDim.z;
    unsigned sum, cnt, mine, sp = 0u;
    for (;;) {
        sum = 0u; cnt = 0u; mine = 0u;
#pragma unroll
        for (unsigned j = 0; j < 16; ++j) { const unsigned c = xb_ld(&bar[XB_XCNT(j)]); sum += c; cnt += (c > 0u) ? 1u : 0u; mine = (j == x) ? c : mine; }
        if (sum == G) break;
        __builtin_amdgcn_s_sleep(1);
        if ((++sp & 255u) == 0u) { if (xb_ld(&bar[XB_TMO])) break; if (sp > XB_SPIN_CAP) { atomicAdd(&bar[XB_TMO], 1u); break; } }
    }
    nloc = mine > 0u ? mine : 1u; nx = cnt > 0u ? cnt : 1u;
}

__device__ __forceinline__ void xcd_barrier(const XcdBarrier& b, const int tid0) {
    asm volatile("s_waitcnt vmcnt(0)" ::: "memory");
    __syncthreads();
    if (tid0 == 0) {
        unsigned* bar = b.bar;
        __builtin_amdgcn_s_waitcnt(0);
        unsigned nloc = b.st[0], nx = b.st[1];
        if (nloc == 0u) { xcd_barrier_complete(bar, b.x, nloc, nx); b.st[0] = nloc; b.st[1] = nx; }
        const unsigned old = xb_add(&bar[XB_XSUB(b.x)], 1u);
        const unsigned gen = old / nloc;
        if (old + 1u == (gen + 1u) * nloc) {
            __builtin_amdgcn_fence(__ATOMIC_RELEASE, "agent");
            asm volatile("s_waitcnt vmcnt(0)" ::: "memory");
            const unsigned og = xb_add(&bar[XB_TOP], 1u);
            const unsigned tg = og / nx;
            if (og + 1u == (tg + 1u) * nx) xb_add(&bar[XB_TOPGEN], 1u);
            else XB_SPIN(xb_ld(&bar[XB_TOPGEN]) == tg, bar);
            __builtin_amdgcn_fence(__ATOMIC_ACQUIRE, "agent");
            xb_add(&bar[XB_XGEN(b.x)], 1u);
            asm volatile("s_waitcnt vmcnt(0)" ::: "memory");
        } else {
            XB_SPIN(xb_ld(&bar[XB_XGEN(b.x)]) == gen, bar);
            __builtin_amdgcn_fence(__ATOMIC_ACQUIRE, "agent");
            asm volatile("s_waitcnt vmcnt(0)" ::: "memory");
        }
    }
    __syncthreads();
}
constexpr int NWAVES = 8;
constexpr int RING_OFF = 0, RING_BYTES = 131072;
constexpr int LDSCTL_OFF = RING_BYTES, MISC_OFF = LDSCTL_OFF + 320;
constexpr int LDS_BYTES = 147456;
constexpr int CW_TMO = 0, CW_CODE = 1, CW_BAR = 4096;
#ifndef I8_FROM_PN
#define I8_FROM_PN 0
#endif
constexpr float GATE_WSCALE = 32.f, H_SCALE = 16.f, WD_SCALE = 16.f;
constexpr int CW_CNT2 = 32768;
constexpr int CW_CNT = 16384;

struct Frame {
    LAS unsigned char* lds;
    volatile LAS unsigned* MISC;
    gu32* ctl;
    int tid, lane, wave;
    int vcu, G;
    unsigned char* ws;
    const float* in[30]; float* out;
};
__device__ __forceinline__ float wave_sum(float v) {
#pragma unroll
    for (int o = 1; o < 64; o <<= 1) v += __shfl_xor(v, o);
    return v;
}
__device__ __forceinline__ float fast_sigmoid(float v) { return __builtin_amdgcn_rcpf(1.f + __builtin_amdgcn_exp2f(-1.4426950408889634f * v)); }

__device__ __forceinline__ void p0_transpose_item(const float* W, int K, int N, bf16_t* WT, int dst_row0, const float* kscale, LAS float* scr, int k0, int n0, int lane) {
    const int c = lane & 7;
    f32x4 ks0 = (f32x4){1.f, 1.f, 1.f, 1.f}, ks1 = ks0;
    if (kscale) { ks0 = *(const f32x4*)(kscale + k0 + 8 * c); ks1 = *(const f32x4*)(kscale + k0 + 8 * c + 4); }
    float v[32];
#pragma unroll
    for (int i = 0; i < 32; ++i) v[i] = __builtin_nontemporal_load(W + (size_t)(k0 + 2 * i + (lane >> 5)) * N + n0 + (lane & 31));
#pragma unroll
    for (int i = 0; i < 32; ++i) scr[(2 * i + (lane >> 5)) * 33 + (lane & 31)] = v[i];
    LDS_WAIT(); asm volatile("" ::: "memory");
#pragma unroll
    for (int j = 0; j < 4; ++j) { const int n = (lane >> 3) + 8 * j; const LAS float* s = scr + (8 * c) * 33 + n;
        v4u o; o.x = pk2(s[0 * 33] * ks0.x, s[1 * 33] * ks0.y); o.y = pk2(s[2 * 33] * ks0.z, s[3 * 33] * ks0.w); o.z = pk2(s[4 * 33] * ks1.x, s[5 * 33] * ks1.y); o.w = pk2(s[6 * 33] * ks1.z, s[7 * 33] * ks1.w);
        st16(WT + (size_t)(dst_row0 + n) * K + k0 + 8 * c, o); }
    LDS_WAIT(); asm volatile("" ::: "memory");
}
__device__ __forceinline__ unsigned pk4_fp8(float a, float b, float c, float d) { unsigned r = 0u;
    a = __builtin_amdgcn_fmed3f(a, -448.f, 448.f); b = __builtin_amdgcn_fmed3f(b, -448.f, 448.f); c = __builtin_amdgcn_fmed3f(c, -448.f, 448.f); d = __builtin_amdgcn_fmed3f(d, -448.f, 448.f); r = (unsigned)__builtin_amdgcn_cvt_pk_fp8_f32(a, b, (int)r, false); r = (unsigned)__builtin_amdgcn_cvt_pk_fp8_f32(c, d, (int)r, true); return r; }
__device__ __forceinline__ void p0_transpose_item_fp8(const float* W, int K, int N, unsigned char* WT, int dst_row0, float scale, LAS float* scr, int k0, int n0, int lane, const float* kscale = nullptr) {
    const int c = lane & 7;
    f32x4 ks0 = (f32x4){scale, scale, scale, scale}, ks1 = ks0;
    if (kscale) { ks0 = *(const f32x4*)(kscale + k0 + 8 * c) * scale; ks1 = *(const f32x4*)(kscale + k0 + 8 * c + 4) * scale; }
    float v[32];
#pragma unroll
    for (int i = 0; i < 32; ++i) v[i] = __builtin_nontemporal_load(W + (size_t)(k0 + 2 * i + (lane >> 5)) * N + n0 + (lane & 31));
#pragma unroll
    for (int i = 0; i < 32; ++i) scr[(2 * i + (lane >> 5)) * 33 + (lane & 31)] = v[i];
    LDS_WAIT(); asm volatile("" ::: "memory");
#pragma unroll
    for (int j = 0; j < 4; ++j) { const int n = (lane >> 3) + 8 * j; const LAS float* s = scr + (8 * c) * 33 + n;
        wt_v2u o; o.x = pk4_fp8(s[0 * 33] * ks0.x, s[1 * 33] * ks0.y, s[2 * 33] * ks0.z, s[3 * 33] * ks0.w); o.y = pk4_fp8(s[4 * 33] * ks1.x, s[5 * 33] * ks1.y, s[6 * 33] * ks1.z, s[7 * 33] * ks1.w);
        st8(WT + (size_t)(dst_row0 + n) * K + k0 + 8 * c, o); }
    LDS_WAIT(); asm volatile("" ::: "memory");
}
__device__ __forceinline__ unsigned pk4_i8(float a, float b, float c, float d) {
    const int qa = __float2int_rn(a), qb = __float2int_rn(b), qc = __float2int_rn(c), qd = __float2int_rn(d);
    return ((unsigned)qa & 255u) | (((unsigned)qb & 255u) << 8) | (((unsigned)qc & 255u) << 16) | ((unsigned)qd << 24); }
__device__ __forceinline__ int perm_in(int n) { return (n & ~255) | (((n >> 5) & 1) << 7) | (((n >> 6) & 3) << 5) | (n & 31); }
__device__ __forceinline__ int perm_glu(int n) { const int bj = n >> 10, rem = n & 1023; return ((rem >> 7) << 8) | (bj << 7) | (rem & 127); }
template <int NR> __device__ __forceinline__ void rms_rows_to_bf16(Frame& F, const float* xrow, const float* g, bf16_t* orow, unsigned char* o8row, float* sa) {
    const GAS f32x4* xr = (const GAS f32x4*)xrow + F.lane; const GAS f32x4* gr = (const GAS f32x4*)g + F.lane;
    f32x4 v[NR][4]; float s[NR];
#pragma unroll
    for (int r = 0; r < NR; ++r)
#pragma unroll
        for (int j = 0; j < 4; ++j) v[r][j] = __builtin_nontemporal_load(xr + r * 256 + 64 * j);
#pragma unroll
    for (int r = 0; r < NR; ++r) { s[r] = 0.f;
#pragma unroll
        for (int j = 0; j < 4; ++j) s[r] += (v[r][j].x * v[r][j].x + v[r][j].y * v[r][j].y) + (v[r][j].z * v[r][j].z + v[r][j].w * v[r][j].w); }
#pragma unroll
    for (int o = 1; o < 64; o <<= 1)
#pragma unroll
        for (int r = 0; r < NR; ++r) s[r] += __shfl_xor(s[r], o);
    f32x4 gg[4];
#pragma unroll
    for (int j = 0; j < 4; ++j) gg[j] = gr[64 * j];
#pragma unroll
    for (int r = 0; r < NR; ++r) { const float rs = rsqrtf(s[r] * (1.f / DM) + EPS); GAS unsigned long long* o8 = (GAS unsigned long long*)(orow + (size_t)r * DM) + F.lane;
        float mx = 0.f;
#pragma unroll
        for (int j = 0; j < 4; ++j) { v[r][j] = v[r][j] * gg[j] * rs; mx = fmaxf(fmaxf(mx, fmaxf(fabsf(v[r][j].x), fabsf(v[r][j].y))), fmaxf(fabsf(v[r][j].z), fabsf(v[r][j].w))); }
#pragma unroll
        for (int o = 1; o < 64; o <<= 1) mx = fmaxf(mx, __shfl_xor(mx, o));
        const float qs = mx > 0.f ? 127.f / mx : 0.f; if (F.lane == 0) sa[r] = mx * (1.f / 127.f);
#pragma unroll
        for (int j = 0; j < 4; ++j) { const float a = v[r][j].x, b = v[r][j].y, c = v[r][j].z, d = v[r][j].w;
            if (I8_FROM_PN > 0) { wt_v2u w2; w2.x = pk2(a, b); w2.y = pk2(c, d); st8((void*)(o8 + 64 * j), w2); }
            ((GAS unsigned*)(o8row + (size_t)r * DM))[F.lane + 64 * j] = pk4_i8(a * qs, b * qs, c * qs, d * qs); } }
}
__device__ __forceinline__ void p0_quant_cols_wg(Frame& F, const float* W, int N, unsigned char* WT, int dst_row0, float* sw, int n0) {
    LAS unsigned* cmx = (LAS unsigned*)(F.lds + LDSCTL_OFF + 1024); LAS float* scr = (LAS float*)(F.lds + RING_OFF + F.wave * 16384);
    const int lane = F.lane, k0 = 128 * F.wave, c = lane & 7;
    if (F.tid < 32) cmx[F.tid] = 0u;
    __syncthreads();
    float v[64];
#pragma unroll
    for (int i = 0; i < 64; ++i) v[i] = __builtin_nontemporal_load(W + (size_t)(k0 + 2 * i + (lane >> 5)) * N + n0 + (lane & 31));
    float mx = 0.f;
#pragma unroll
    for (int i = 0; i < 64; ++i) mx = fmaxf(mx, fabsf(v[i]));
    mx = fmaxf(mx, __shfl_xor(mx, 32));
    if (lane < 32) __hip_atomic_fetch_max(cmx + lane, __float_as_uint(mx), __ATOMIC_RELAXED, __HIP_MEMORY_SCOPE_WORKGROUP);
    __syncthreads();
    const float cm = __uint_as_float(cmx[lane & 31]), qs = cm > 0.f ? 127.f / cm : 0.f;
    if (F.wave == 0 && lane < 32) sw[n0 + lane] = cm * (1.f / 127.f);
#pragma unroll
    for (int sb = 0; sb < 2; ++sb) {
#pragma unroll
        for (int i = 0; i < 32; ++i) scr[(2 * i + (lane >> 5)) * 33 + (lane & 31)] = v[sb * 32 + i] * qs;
        LDS_WAIT(); asm volatile("" ::: "memory");
#pragma unroll
        for (int j = 0; j < 4; ++j) { const int n = (lane >> 3) + 8 * j; const LAS float* sp = scr + (8 * c) * 33 + n;
            wt_v2u o; o.x = pk4_i8(sp[0 * 33], sp[1 * 33], sp[2 * 33], sp[3 * 33]); o.y = pk4_i8(sp[4 * 33], sp[5 * 33], sp[6 * 33], sp[7 * 33]);
            st8(WT + (size_t)(dst_row0 + n) * 1024 + k0 + 64 * sb + 8 * c, o); }
        LDS_WAIT(); asm volatile("" ::: "memory"); }
    __syncthreads();
}
__device__ __forceinline__ void p0_prologue(Frame& F) {
    LAS float* scr = (LAS float*)(F.lds + RING_OFF + F.wave * 16384);
    const int gw = F.vcu * NWAVES + F.wave, NGW = F.G * NWAVES;
    bf16_t* Win_t = (bf16_t*)(F.ws + WS_WIN); bf16_t* Wo_t = (bf16_t*)(F.ws + WS_WO); bf16_t* Wglu_t = (bf16_t*)(F.ws + WS_WGLU); bf16_t* Wout_t = (bf16_t*)(F.ws + WS_WOUT);
    constexpr int I_IN = 16 * 128, I_O = 8 * 32, I_GLU = 8 * 64, I_OUT = 16 * 32;
    constexpr int NITEMS = I_IN + I_O + I_GLU + I_OUT;
    for (int it = gw; it < NITEMS; it += NGW) {
        int r = it;
        if (r < I_IN) { const int kb = r / 128, nb = r % 128;
            if (nb < 8 * I8_FROM_PN) p0_transpose_item(F.in[3], DM, IN_COLS, Win_t, perm_in(32 * nb), nullptr, scr, 64 * kb, 32 * nb, F.lane);
            continue; } r -= I_IN;
        if (r < I_O) { const int kb = r / 32, nb = r % 32; p0_transpose_item(F.in[11], 512, DM, Wo_t, 32 * nb, nullptr, scr, 64 * kb, 32 * nb, F.lane); continue; } r -= I_O;
        if (r < I_GLU) { const int kb = r / 64, nb = r % 64; p0_transpose_item(F.in[20], 512, 2048, Wglu_t, perm_glu(32 * nb), nullptr, scr, 64 * kb, 32 * nb, F.lane); continue; } r -= I_GLU;
        { const int kb = r / 32, nb = r % 32; p0_transpose_item(F.in[21], DM, DM, Wout_t, 32 * nb, nullptr, scr, 64 * kb, 32 * nb, F.lane); }
    }
    for (int cb = 8 * I8_FROM_PN + F.vcu; cb < 128; cb += F.G)
        p0_quant_cols_wg(F, F.in[3], IN_COLS, F.ws + WS_WG8, perm_in(32 * cb) - 256 * I8_FROM_PN, (float*)(F.ws + WS_SW), 32 * cb);
    bf16_t* XN = (bf16_t*)(F.ws + WS_XN);
    for (int m = 4 * gw; m < T; m += 4 * NGW) rms_rows_to_bf16<4>(F, F.in[0] + (size_t)m * DM, F.in[2], XN + (size_t)m * DM, F.ws + WS_XN8 + (size_t)m * DM, (float*)(F.ws + WS_SA) + m);
    { float* rope = (float*)(F.ws + WS_ROPE); const int* pos = (const int*)F.in[1]; const int gt = (F.vcu * NWAVES + F.wave) * 64 + F.lane, NGT = NGW * 64;
        for (int i = gt; i < T * 8; i += NGT) { const int row = i >> 3, k = i & 7;
            double rv = (double)pos[row] * (0.15915494309189535 * exp2(-(double)k * 2.3664460711655217)); rv -= rint(rv);
            rope[row * 16 + k] = __builtin_amdgcn_cosf((float)rv); rope[row * 16 + 8 + k] = __builtin_amdgcn_sinf((float)rv); } }
    {   const float* lre = F.in[12]; const float* lim = F.in[13]; const float* ldt = F.in[14]; const float* bre = F.in[15]; const float* bim = F.in[16]; const float* cre = F.in[17]; const float* cim = F.in[18];
        bf16_t* Ft = (bf16_t*)(F.ws + WS_SSMF); bf16_t* Gt = (bf16_t*)(F.ws + WS_SSMG); bf16_t* Ht = (bf16_t*)(F.ws + WS_SSMH); float* A64 = (float*)(F.ws + WS_SSMA);
#define CPOW(lr_, li_, dt_, e_, outr, outi) do { const float m_ = __expf((lr_) * (dt_) * (float)(e_)); double rv_ = (double)(li_) * (double)(dt_) * (double)(e_) * 0.15915494309189535; rv_ -= rint(rv_); \
        outr = m_ * __builtin_amdgcn_cosf((float)rv_); outi = m_ * __builtin_amdgcn_sinf((float)rv_); } while (0)
#define CFAC(lr_, li_, dt_, fr_, fi_) do { float a1r_, a1i_; CPOW(lr_, li_, dt_, 1, a1r_, a1i_); const float nr_ = a1r_ - 1.f, ni_ = a1i_, den_ = (lr_) * (lr_) + (li_) * (li_); \
        fr_ = (nr_ * (lr_) + ni_ * (li_)) / den_; fi_ = (ni_ * (lr_) - nr_ * (li_)) / den_; } while (0)
        LAS float* sw = (LAS float*)(F.lds + RING_OFF + F.wave * 16384);
        for (int it = gw; it < 32 * 64; it += NGW) { const int g = it >> 6, d = it & 63; const int p = F.lane;
            { const float dt = __expf(ldt[g]); const float lr = lre[g * 64 + p], li = lim[g * 64 + p]; float fr, fi, wr, wi; CFAC(lr, li, dt, fr, fi); CPOW(lr, li, dt, d, wr, wi);
              sw[p * 2] = wr * fr - wi * fi; sw[p * 2 + 1] = wr * fi + wi * fr; }
            LDS_WAIT(); asm volatile("" ::: "memory");
            const int hp = F.lane >> 2, h0 = (F.lane & 3) * 4; float acc[4] = {0.f, 0.f, 0.f, 0.f};
#pragma unroll 16
            for (int q = 0; q < 64; ++q) { const float ur = sw[q * 2], ui = sw[q * 2 + 1]; const float cr = cre[(g * 16 + hp) * 64 + q], ci = cim[(g * 16 + hp) * 64 + q];
                const f32x4 br = *(const f32x4*)(bre + (g * 64 + q) * 16 + h0), bi = *(const f32x4*)(bim + (g * 64 + q) * 16 + h0);
                const float er = cr * ur - ci * ui, ei = cr * ui + ci * ur;
                acc[0] += er * br.x - ei * bi.x; acc[1] += er * br.y - ei * bi.y; acc[2] += er * br.z - ei * bi.z; acc[3] += er * br.w - ei * bi.w; }
#pragma unroll
            for (int i = 0; i < 4; ++i) { const int h = h0 + i; float v = acc[i]; if (d == 0 && h == hp) v += F.in[19][g * 16 + hp];
                Ft[((size_t)(g * 64 + d) * 64 + hp + 16 * (h >> 3)) * 8 + (h & 7)] = f2bf(v);
                if (d < 63) Ft[((size_t)(g * 64 + d + 1) * 64 + hp + 16 * (2 + (h >> 3))) * 8 + (h & 7)] = f2bf(v);
                if (d == 0) Ft[((size_t)(g * 64) * 64 + hp + 16 * (2 + (h >> 3))) * 8 + (h & 7)] = 0; }
            LDS_WAIT(); asm volatile("" ::: "memory");
        }
        const int gt = gw * 64 + F.lane, NGT = NGW * 64;
        for (int idx = gt; idx < 32 * 4 * 512; idx += NGT) { const int j = idx & 7, ln = (idx >> 3) & 63, kk = (idx >> 9) & 3, g = idx >> 11; const int hp = ln & 15, sidx = 32 * kk + 8 * (ln >> 4) + j;
            Gt[idx] = f2bf(sidx < 64 ? cre[(g * 16 + hp) * 64 + sidx] : -cim[(g * 16 + hp) * 64 + sidx - 64]); }
        for (int idx = gt; idx < 32 * 64; idx += NGT) { const int g = idx >> 6, p = idx & 63; const float dt = __expf(ldt[g]); const float lr = lre[idx], li = lim[idx]; f32x4 ab; CPOW(lr, li, dt, 1, ab.x, ab.y); CPOW(lr, li, dt, 2, ab.z, ab.w);
            ((f32x4*)(A64 + 16384))[idx] = ab; }
        for (int idx = gt; idx < 32 * 64 * 64; idx += NGT) { const int g = idx >> 12, t = (idx >> 6) & 63, p = idx & 63;
            const float dt = __expf(ldt[g]);
            { const int pp = t, jt = p;
              const float lr2 = lre[g * 64 + pp], li2 = lim[g * 64 + pp]; float fr, fi, wr0, wi0; CFAC(lr2, li2, dt, fr, fi); CPOW(lr2, li2, dt, 63 - jt, wr0, wi0);
              const float wr = wr0 * fr - wi0 * fi, wi = wr0 * fi + wi0 * fr;
              const int mt = pp >> 4, mrow = pp & 15, ks = jt >> 1;
              const f32x4* b4r = (const f32x4*)(bre + (g * 64 + pp) * 16); const f32x4* b4i = (const f32x4*)(bim + (g * 64 + pp) * 16);
#pragma unroll
              for (int hq = 0; hq < 2; ++hq) {
                  const f32x4 ra = b4r[2 * hq], rb = b4r[2 * hq + 1], ia = b4i[2 * hq], ib = b4i[2 * hq + 1]; const int kq = (jt & 1) * 2 + hq;
                  v4u o0, o1; o0.x = pk2(wr * ra.x - wi * ia.x, wr * ra.y - wi * ia.y); o0.y = pk2(wr * ra.z - wi * ia.z, wr * ra.w - wi * ia.w); o0.z = pk2(wr * rb.x - wi * ib.x, wr * rb.y - wi * ib.y); o0.w = pk2(wr * rb.z - wi * ib.z, wr * rb.w - wi * ib.w);
                  o1.x = pk2(wr * ia.x + wi * ra.x, wr * ia.y + wi * ra.y); o1.y = pk2(wr * ia.z + wi * ra.z, wr * ia.w + wi * ra.w); o1.z = pk2(wr * ib.x + wi * rb.x, wr * ib.y + wi * rb.y); o1.w = pk2(wr * ib.z + wi * rb.z, wr * ib.w + wi * rb.w);
                  st16(Ht + ((size_t)((g * 8 + mt) * 32 + ks) * 64 + mrow + 16 * kq) * 8, o0);
                  st16(Ht + ((size_t)((g * 8 + 4 + mt) * 32 + ks) * 64 + mrow + 16 * kq) * 8, o1); }
              if (jt == 0) { float ar, ai; CPOW(lr2, li2, dt, 64, ar, ai); A64[(g * 64 + pp) * 2] = ar; A64[(g * 64 + pp) * 2 + 1] = ai; } }
        }
#undef CPOW
#undef CFAC
    }
    { bf16_t* Wr = (bf16_t*)(F.ws + WS_WR); const int gt2 = gw * 64 + F.lane, NGT2 = NGW * 64;
      for (int idx = gt2; idx < 32 * 3 * 512; idx += NGT2) { const int ks = idx / 1536, rem = idx % 1536, ntl = rem >> 9, ln = (rem & 511) >> 3, j = rem & 7; const int k = 32 * ks + 8 * (ln >> 4) + j, ncol = 16 * ntl + (ln & 15);
          float v = 0.f; if (ncol < 4) v = F.in[23][k * 4 + ncol]; else if (ncol < 36) v = F.in[25][k * 32 + ncol - 4];
          Wr[idx] = f2bf(v * F.in[22][k]); } }
    if (blockIdx.x == 0 && F.wave == 0) { const float a = wave_sum(F.in[6][F.lane] * F.in[7][F.lane]), b = wave_sum(F.in[8][F.lane] * F.in[9][F.lane]);
        if (F.lane == 0) ((float*)(F.ws + WS_SCAL))[0] = expf(a) - expf(b) + LAM_INIT; }
}

__device__ __forceinline__ void expert_weights_items(Frame& F, int gwp, int ngwp) {
    LAS float* scr = (LAS float*)(F.lds + RING_OFF + F.wave * 16384);
    bf16_t* Wgu_t = (bf16_t*)(F.ws + WS_WGU); bf16_t* Wd_t = (bf16_t*)(F.ws + WS_WD);
    constexpr int I_GU = 32 * 2 * 16 * 8, I_D = 32 * 4 * 32;
    for (int it = gwp; it < I_GU + I_D; it += ngwp) { int r = it;
        if (r < I_GU) { const int e = r / 256, up = (r / 128) & 1, kb = (r % 128) / 8, nb = r % 8;
            const int n0 = 32 * nb, pn = n0 >> 7, j0 = n0 & 127;
            p0_transpose_item_fp8((up ? F.in[28] : F.in[27]) + (size_t)e * DM * 256, DM, 256, F.ws + WS_WGU + (size_t)e * 512 * DM, 256 * pn + 128 * up + j0, GATE_WSCALE, scr, 64 * kb, n0, F.lane, F.in[22]); continue; } r -= I_GU;
        { const int e = r / 128, kb = (r % 128) / 32, nb = r % 32; p0_transpose_item_fp8(F.in[29] + (size_t)e * 256 * DM, 256, DM, F.ws + WS_WD + (size_t)e * DM * 256, 32 * nb, WD_SCALE, scr, 64 * kb, 32 * nb, F.lane); } }
    __syncthreads();
}
__device__ __forceinline__ float sum_x16_x32(float s) {
    { auto rr = __builtin_amdgcn_permlane16_swap(__float_as_uint(s), __float_as_uint(s), false, false); s = __uint_as_float(rr[0]) + __uint_as_float(rr[1]); }
    { auto rr = __builtin_amdgcn_permlane32_swap(__float_as_uint(s), __float_as_uint(s), false, false); s = __uint_as_float(rr[0]) + __uint_as_float(rr[1]); }
    return s; }
__device__ __forceinline__ float from_x16(float v, int fq) {
    auto rr = __builtin_amdgcn_permlane16_swap(__float_as_uint(v), __float_as_uint(v), false, false); return __uint_as_float((fq & 1) ? rr[0] : rr[1]); }
typedef unsigned u32x2g __attribute__((ext_vector_type(2)));
__device__ __forceinline__ unsigned q8(float a, float b, float c, float d) { const unsigned x = (unsigned)(a * 255.f + 0.5f), y = (unsigned)(b * 255.f + 0.5f), z = (unsigned)(c * 255.f + 0.5f), w = (unsigned)(d * 255.f + 0.5f); return x | (y << 8) | (z << 16) | (w << 24); }
__device__ __forceinline__ void unq8(const u32x2g v, float (&f)[8]) { constexpr float k = 1.f / 255.f;
    f[0] = (float)(v.x & 255u) * k; f[1] = (float)((v.x >> 8) & 255u) * k; f[2] = (float)((v.x >> 16) & 255u) * k; f[3] = (float)(v.x >> 24) * k;
    f[4] = (float)(v.y & 255u) * k; f[5] = (float)((v.y >> 8) & 255u) * k; f[6] = (float)((v.y >> 16) & 255u) * k; f[7] = (float)(v.y >> 24) * k; }
template <int PN0, int PN1, bool I8> struct EpiInT {
    static constexpr bool PERM = true, AFTER_DRAIN = false;
    bf16_t *Qb, *Kb, *Vb, *Ub, *Gb; const float* rope; const float* qg; const float* kg; const float* sa; const float* sw;
    __device__ __forceinline__ void operator()(const pg8::f32x4 (&acc)[2][2][4][2], const pg8::Unit& u, int wr, int wc, int fr, int fq) const {
        const int row0 = u.pm * 256 + wr * 64 + fr; const int pn = u.pn + PN0;
        f32x4 cs[2][2]; float rsc[2][4];
        if constexpr (I8) {
#pragma unroll
            for (int bj = 0; bj < 2; ++bj)
#pragma unroll
                for (int n = 0; n < 2; ++n) cs[bj][n] = *(const f32x4*)(sw + 256 * pn + 64 * wc + 32 * bj + 8 * fq + 4 * n);
#pragma unroll
            for (int ai = 0; ai < 2; ++ai)
#pragma unroll
                for (int m = 0; m < 4; ++m) rsc[ai][m] = sa[row0 + ai * 128 + m * 16]; }
#define EPIIN_VAL(ai, bj, m, n) (I8 ? (f32x4){(float)__float_as_int(acc[ai][bj][m][n].x), (float)__float_as_int(acc[ai][bj][m][n].y), (float)__float_as_int(acc[ai][bj][m][n].z), (float)__float_as_int(acc[ai][bj][m][n].w)} * cs[bj][n] * rsc[ai][m] : acc[ai][bj][m][n])
        if (PN0 < 4 && pn < 4) {
            const bool isq = pn < 2; const float* g = isq ? qg : kg; bf16_t* O = isq ? Qb : Kb; const float sc = isq ? QSCALE : 1.f; const int gidx = (pn & 1) * 4 + wc;
            f32x4 gv[2][2];
#pragma unroll
            for (int bj = 0; bj < 2; ++bj)
#pragma unroll
                for (int n = 0; n < 2; ++n) gv[bj][n] = *(const f32x4*)(g + 32 * bj + 8 * fq + 4 * n);
#pragma unroll
            for (int ai = 0; ai < 2; ++ai)
#pragma unroll
                for (int m = 0; m < 4; ++m) { const int row = row0 + ai * 128 + m * 16; f32x4 v[2][2]; float s = 0.f;
#pragma unroll
                    for (int bj = 0; bj < 2; ++bj)
#pragma unroll
                        for (int n = 0; n < 2; ++n) { v[bj][n] = EPIIN_VAL(ai, bj, m, n); s += (v[bj][n].x * v[bj][n].x + v[bj][n].y * v[bj][n].y) + (v[bj][n].z * v[bj][n].z + v[bj][n].w * v[bj][n].w); }
                    s = sum_x16_x32(s);
                    const float r = rsqrtf(s * (1.f / 64.f) + EPS);
#pragma unroll
                    for (int bj = 0; bj < 2; ++bj)
#pragma unroll
                        for (int n = 0; n < 2; ++n) v[bj][n] = v[bj][n] * r * gv[bj][n];
#pragma unroll
                    for (int n = 0; n < 2; ++n) { f32x4 p; p.x = from_x16(v[0][n].x, fq); p.y = from_x16(v[0][n].y, fq); p.z = from_x16(v[0][n].z, fq); p.w = from_x16(v[0][n].w, fq);
                        if (fq < 2) { const f32x4 cs_ = *(const f32x4*)(rope + (size_t)row * 16 + 4 * n), sn = *(const f32x4*)(rope + (size_t)row * 16 + 8 + 4 * n);
                            v[0][n] = fq == 0 ? v[0][n] * cs_ - p * sn : v[0][n] * cs_ + p * sn; } }
#pragma unroll
                    for (int bj = 0; bj < 2; ++bj) { const f32x4 a = v[bj][0] * sc, b = v[bj][1] * sc; v4u w; w.x = pk2(a.x, a.y); w.y = pk2(a.z, a.w); w.z = pk2(b.x, b.y); w.w = pk2(b.z, b.w);
                        pst16(O + (size_t)row * 512 + gidx * 64 + 32 * bj + 8 * fq, w); }
                }
        } else if (PN0 < 8 && PN1 > 4 && pn < 8) {
            bf16_t* O = pn < 6 ? Vb : Ub; const int cbase = (pn & 1) * 256 + 64 * wc + 8 * fq;
#pragma unroll
            for (int ai = 0; ai < 2; ++ai)
#pragma unroll
                for (int m = 0; m < 4; ++m) { const int row = row0 + ai * 128 + m * 16;
#pragma unroll
                    for (int bj = 0; bj < 2; ++bj) { const f32x4 a = EPIIN_VAL(ai, bj, m, 0), b = EPIIN_VAL(ai, bj, m, 1); v4u w; w.x = pk2(a.x, a.y); w.y = pk2(a.z, a.w); w.z = pk2(b.x, b.y); w.w = pk2(b.z, b.w);
                        pst16(O + (size_t)row * 512 + cbase + 32 * bj, w); } }
        } else if (PN1 > 8) {
            const int cbase = (pn - 8) * 256 + 64 * wc + 8 * fq;
#pragma unroll
            for (int ai = 0; ai < 2; ++ai)
#pragma unroll
                for (int m = 0; m < 4; ++m) { const int row = row0 + ai * 128 + m * 16;
#pragma unroll
                    for (int bj = 0; bj < 2; ++bj) { const f32x4 a = EPIIN_VAL(ai, bj, m, 0), b = EPIIN_VAL(ai, bj, m, 1); u32x2g w;
                        w.x = q8(fast_sigmoid(a.x), fast_sigmoid(a.y), fast_sigmoid(a.z), fast_sigmoid(a.w)); w.y = q8(fast_sigmoid(b.x), fast_sigmoid(b.y), fast_sigmoid(b.z), fast_sigmoid(b.w));
                        pst8((unsigned char*)Gb + (size_t)row * 2048 + cbase + 32 * bj, w); } }
        }
#undef EPIIN_VAL
    }
};


__device__ __forceinline__ void unpack8(const v4u w, float (&f)[8]) { f[0] = __uint_as_float(w.x << 16); f[1] = __uint_as_float(w.x & 0xffff0000u); f[2] = __uint_as_float(w.y << 16); f[3] = __uint_as_float(w.y & 0xffff0000u);
    f[4] = __uint_as_float(w.z << 16); f[5] = __uint_as_float(w.z & 0xffff0000u); f[6] = __uint_as_float(w.w << 16); f[7] = __uint_as_float(w.w & 0xffff0000u); }
struct EpiOA {
    static constexpr bool PERM = true, AFTER_DRAIN = false;
    const bf16_t* Gb; bf16_t* MA;
    __device__ __forceinline__ void operator()(const pg8::f32x4 (&acc)[2][2][4][2], const pg8::Unit& u, int wr, int wc, int fr, int fq) const {
        const int row0 = u.pm * 256 + wr * 64 + fr, col0 = u.pn * 256 + wc * 32 + 8 * fq;
        u32x2g gv[2][4][2];
#pragma unroll
        for (int ai = 0; ai < 2; ++ai)
#pragma unroll
            for (int m = 0; m < 4; ++m)
#pragma unroll
                for (int bj = 0; bj < 2; ++bj) gv[ai][m][bj] = *(const u32x2g*)((const unsigned char*)Gb + (size_t)(row0 + ai * 128 + m * 16) * 2048 + col0 + bj * 128);
#pragma unroll
        for (int ai = 0; ai < 2; ++ai)
#pragma unroll
            for (int m = 0; m < 4; ++m) { const size_t row = row0 + ai * 128 + m * 16;
#pragma unroll
                for (int bj = 0; bj < 2; ++bj) { float gg[8]; unq8(gv[ai][m][bj], gg);
                    const f32x4 a = acc[ai][bj][m][0], b = acc[ai][bj][m][1]; v4u w; w.x = pk2(a.x * gg[0], a.y * gg[1]); w.y = pk2(a.z * gg[2], a.w * gg[3]); w.z = pk2(b.x * gg[4], b.y * gg[5]); w.w = pk2(b.z * gg[6], b.w * gg[7]);
                    pst16(MA + row * DM + col0 + bj * 128, w); } }
    }
};
struct EpiGlu {
    static constexpr bool PERM = true, AFTER_DRAIN = false;
    const bf16_t* Gb; const bf16_t* MA; bf16_t* MG;
    __device__ __forceinline__ void operator()(const pg8::f32x4 (&acc)[2][2][4][2], const pg8::Unit& u, int wr, int wc, int fr, int fq) const {
        const int row0 = u.pm * 256 + wr * 64 + fr, col = u.pn * 128 + wc * 32 + 8 * fq;
        u32x2g gv[2][4]; v4u mv[2][4];
#pragma unroll
        for (int ai = 0; ai < 2; ++ai)
#pragma unroll
            for (int m = 0; m < 4; ++m) { const size_t row = row0 + ai * 128 + m * 16; gv[ai][m] = *(const u32x2g*)((const unsigned char*)Gb + row * 2048 + 1024 + col); mv[ai][m] = *(const v4u*)(MA + row * DM + col); }
#pragma unroll
        for (int ai = 0; ai < 2; ++ai)
#pragma unroll
            for (int m = 0; m < 4; ++m) { const size_t row = row0 + ai * 128 + m * 16; float gg[8], ma[8]; unq8(gv[ai][m], gg); unpack8(mv[ai][m], ma);
                const f32x4 z1a = acc[ai][0][m][0], z1b = acc[ai][0][m][1], z2a = acc[ai][1][m][0], z2b = acc[ai][1][m][1]; v4u w;
                w.x = pk2(ma[0] + gg[0] * z1a.x * fast_sigmoid(z2a.x), ma[1] + gg[1] * z1a.y * fast_sigmoid(z2a.y)); w.y = pk2(ma[2] + gg[2] * z1a.z * fast_sigmoid(z2a.z), ma[3] + gg[3] * z1a.w * fast_sigmoid(z2a.w));
                w.z = pk2(ma[4] + gg[4] * z1b.x * fast_sigmoid(z2b.x), ma[5] + gg[5] * z1b.y * fast_sigmoid(z2b.y)); w.w = pk2(ma[6] + gg[6] * z1b.z * fast_sigmoid(z2b.z), ma[7] + gg[7] * z1b.w * fast_sigmoid(z2b.w));
                pst16(MG + row * DM + col, w); }
    }
};
struct EpiOut {
    static constexpr bool PERM = true, AFTER_DRAIN = false;
    const float* x; float* out; bf16_t* X1b; unsigned char* X1b8;
    __device__ __forceinline__ void operator()(const pg8::f32x4 (&acc)[2][2][4][2], const pg8::Unit& u, int wr, int wc, int fr, int fq) const {
        const int row0 = u.pm * 256 + wr * 64 + fr, col0 = u.pn * 256 + wc * 32 + 8 * fq;
        f32x4 xv[4][2][2], sv[4][2][2];
#pragma unroll
        for (int m = 0; m < 4; ++m)
#pragma unroll
            for (int bj = 0; bj < 2; ++bj) { const size_t o = (size_t)(row0 + m * 16) * DM + col0 + bj * 128; xv[m][bj][0] = __builtin_nontemporal_load((const f32x4*)(x + o)); xv[m][bj][1] = __builtin_nontemporal_load((const f32x4*)(x + o + 4)); }
#pragma unroll
        for (int m = 0; m < 4; ++m)
#pragma unroll
            for (int bj = 0; bj < 2; ++bj) { sv[m][bj][0] = acc[0][bj][m][0] + xv[m][bj][0]; sv[m][bj][1] = acc[0][bj][m][1] + xv[m][bj][1]; }
#pragma unroll
        for (int m = 0; m < 4; ++m)
#pragma unroll
            for (int bj = 0; bj < 2; ++bj) { const size_t o = (size_t)(row0 + 128 + m * 16) * DM + col0 + bj * 128; xv[m][bj][0] = __builtin_nontemporal_load((const f32x4*)(x + o)); xv[m][bj][1] = __builtin_nontemporal_load((const f32x4*)(x + o + 4)); }
#pragma unroll
        for (int ai = 0; ai < 2; ++ai) {
            if (ai == 1) {
#pragma unroll
                for (int m = 0; m < 4; ++m)
#pragma unroll
                    for (int bj = 0; bj < 2; ++bj) { sv[m][bj][0] = acc[1][bj][m][0] + xv[m][bj][0]; sv[m][bj][1] = acc[1][bj][m][1] + xv[m][bj][1]; } }
#pragma unroll
            for (int m = 0; m < 4; ++m)
#pragma unroll
                for (int bj = 0; bj < 2; ++bj) { const size_t o = (size_t)(row0 + ai * 128 + m * 16) * DM + col0 + bj * 128; const f32x4 a = sv[m][bj][0], b = sv[m][bj][1];
                    v4u w; w.x = pk2(a.x, a.y); w.y = pk2(a.z, a.w); w.z = pk2(b.x, b.y); w.w = pk2(b.z, b.w); pst16(X1b + o, w);
                    wt_v2u w8; w8.x = pk4_fp8(a.x, a.y, a.z, a.w); w8.y = pk4_fp8(b.x, b.y, b.z, b.w); pst8(X1b8 + o, w8); } }
    }
};

struct RotOrder {
    pg8::StaticOrder so; int n, rot;
    __device__ __forceinline__ bool next(int i, pg8::Unit& u) const { if (i >= n) return false; int j = i + rot; if (j >= n) j -= n; return so.next(j, u); }
    __device__ __forceinline__ void a_ready(const pg8::Unit&) const {}
    __device__ __forceinline__ void done(const pg8::Unit&) const {}
};

struct ChainOrder {
    pg8::StaticOrder so;
    __device__ __forceinline__ bool next(int i, pg8::Unit& u) const { pg8::Unit t; if (!so.next(i / 3, t)) return false; const int part = i % 3;
        if (part == 0) { u.pm = t.pm; u.pn = t.pn; } else { u.pm = t.pm + T / 256; u.pn = 4 + 2 * t.pn + (part - 1); } return true; }
    __device__ __forceinline__ void a_ready(const pg8::Unit&) const {}
    __device__ __forceinline__ void done(const pg8::Unit&) const {}
};
struct EpiOAGlu {
    static constexpr bool PERM = true, AFTER_DRAIN = false;
    EpiOA a; EpiGlu b;
    __device__ __forceinline__ void operator()(const pg8::f32x4 (&acc)[2][2][4][2], const pg8::Unit& u, int wr, int wc, int fr, int fq) const {
        if (u.pn < 4) a(acc, u, wr, wc, fr, fq);
        else { asm volatile("s_waitcnt vmcnt(0)" ::: "memory"); pg8::Unit v; v.pm = u.pm - T / 256; v.pn = u.pn - 4; b(acc, v, wr, wc, fr, fq); }
    }
};

__device__ __forceinline__ float gelu_tanh_f(float x) { const float u = 0.7978845608028654f * (x + 0.044715f * x * x * x); const float e = __builtin_amdgcn_exp2f(2.885390081777927f * u); return 0.5f * x * (2.f - 2.f * __builtin_amdgcn_rcpf(e + 1.f)); }
#define SSM_DMA(gsrc, ldsdst) __builtin_amdgcn_global_load_lds((const unsigned*)(gsrc), (LAS unsigned*)(ldsdst), 16, 0, 0)
__device__ __forceinline__ void ssm_phase(Frame& F) {
    for (int pair = F.vcu; pair < 256; pair += F.G) {
    int lane = F.lane; asm volatile("" : "+v"(lane));
    const int b = pair & 7, g = pair >> 3; const int w = F.wave, nt = w & 3, tp = w >> 2, n = lane & 15, kq = lane >> 4;
    LAS unsigned char* L = F.lds + RING_OFF;
    LAS float* ES = (LAS float*)(L + 65536);
    const bf16_t* up = (const bf16_t*)(F.ws + WS_U) + ((size_t)b * SEQ + (16 * nt + n) * 64 + (kq >> 1)) * 512 + g * 16 + 8 * (kq & 1);
    bf16x8 U[32];
#pragma unroll
    for (int jp = 0; jp < 32; ++jp) U[jp] = *(const GAS bf16x8*)(up + (size_t)(2 * jp) * 512);
    const GAS bf16x8* Hw = (const GAS bf16x8*)(F.ws + WS_SSMH) + ((size_t)(g * 8 + w) * 32) * 64 + lane;
#define SSM_HBATCH(kb, buf) do { _Pragma("unroll") for (int q_ = 0; q_ < 4; ++q_) SSM_DMA(Hw + (size_t)(4 * (kb) + q_) * 64, L + (buf) * 32768 + (4 * w + q_) * 1024); } while (0)
    SSM_HBATCH(0, 0); SSM_HBATCH(1, 1);
    f32x4 E[4];
#pragma unroll
    for (int mt = 0; mt < 4; ++mt) E[mt] = (f32x4){0.f, 0.f, 0.f, 0.f};
#pragma unroll
    for (int kb = 0; kb < 8; ++kb) {
        if (kb < 7) asm volatile("s_waitcnt vmcnt(4)\n\ts_barrier" ::: "memory"); else asm volatile("s_waitcnt vmcnt(0)\n\ts_barrier" ::: "memory");
        const LAS bf16x8* hb = (const LAS bf16x8*)(L + (kb & 1) * 32768) + (tp * 16) * 64 + lane;
#pragma unroll
        for (int k4 = 0; k4 < 4; ++k4)
#pragma unroll
            for (int mt = 0; mt < 4; ++mt) E[mt] = __builtin_amdgcn_mfma_f32_16x16x32_bf16(hb[(mt * 4 + k4) * 64], U[4 * kb + k4], E[mt], 0, 0, 0);
        if (kb < 6) { asm volatile("s_waitcnt lgkmcnt(0)\n\ts_barrier" ::: "memory"); SSM_HBATCH(kb + 2, kb & 1); }
    }
#pragma unroll
    for (int mt = 0; mt < 4; ++mt)
#pragma unroll
        for (int i = 0; i < 4; ++i) ES[(16 * (4 * tp + mt) + 4 * kq + i) * 65 + 16 * nt + n] = E[mt][i];
    asm volatile("s_waitcnt lgkmcnt(0)\n\ts_barrier" ::: "memory");
    { const GAS bf16x8* Fg = (const GAS bf16x8*)(F.ws + WS_SSMF + (size_t)g * 65536) + lane;
#pragma unroll
      for (int q = 0; q < 8; ++q) SSM_DMA(Fg + (size_t)(8 * w + q) * 64, L + (8 * w + q) * 1024); }
    if (w == 0) { const float* A64 = (const float*)(F.ws + WS_SSMA) + (g * 64 + lane) * 2; const float ar = A64[0], ai = A64[1]; float sr = 0.f, si = 0.f;
        for (int c = 0; c < 64; ++c) { const float er = ES[lane * 65 + c], ei = ES[(64 + lane) * 65 + c]; ES[lane * 65 + c] = sr; ES[(64 + lane) * 65 + c] = si;
            const float nr = ar * sr - ai * si + er, ni = ar * si + ai * sr + ei; sr = nr; si = ni; } }
    int ln3 = lane; asm volatile("" : "+v"(ln3));
    const int n3 = ln3 & 15, kq3 = ln3 >> 4;
    bf16x8 CF[4];
#pragma unroll
    for (int kk = 0; kk < 4; ++kk) CF[kk] = *((const GAS bf16x8*)(F.ws + WS_SSMG) + (size_t)(g * 4 + kk) * 64 + ln3);
    float zr[16], zi[16], a2r[16], a2i[16];
#pragma unroll
    for (int q = 0; q < 16; ++q) { const f32x4 ab = ((const GAS f32x4*)((const float*)(F.ws + WS_SSMA) + 16384))[g * 64 + 32 * (q >> 3) + 8 * kq3 + (q & 7)]; a2r[q] = ab.z; a2i[q] = ab.w; zr[q] = tp ? ab.z : ab.x; zi[q] = tp ? ab.w : ab.y; }
    asm volatile("s_waitcnt vmcnt(0) lgkmcnt(0)\n\ts_barrier" ::: "memory");
#pragma unroll
    for (int q = 0; q < 16; ++q) { const int p = 32 * (q >> 3) + 8 * kq3 + (q & 7); const float sr = ES[p * 65 + 16 * nt + n3], si = ES[(64 + p) * 65 + 16 * nt + n3];
        const float r0 = zr[q] * sr - zi[q] * si, i0 = zr[q] * si + zi[q] * sr; zr[q] = r0; zi[q] = i0; }
    const LAS bf16x8* Fl = (const LAS bf16x8*)L + tp * 64 + ln3;
    bf16_t* yp = (bf16_t*)(F.ws + WS_Y2) + ((size_t)b * SEQ + (16 * nt + n3) * 64 + tp) * 512 + g * 16 + 4 * kq3;
#pragma unroll
    for (int tt = 0; tt < 32; ++tt) {
        f32x4 acc = (f32x4){0.f, 0.f, 0.f, 0.f};
#pragma unroll
        for (int kk = 0; kk < 4; ++kk) { const float* z = (kk < 2) ? zr : zi; const int o8 = 8 * (kk & 1); v4u zw; zw.x = pk2(z[o8], z[o8 + 1]); zw.y = pk2(z[o8 + 2], z[o8 + 3]); zw.z = pk2(z[o8 + 4], z[o8 + 5]); zw.w = pk2(z[o8 + 6], z[o8 + 7]);
            acc = __builtin_amdgcn_mfma_f32_16x16x32_bf16(CF[kk], __builtin_bit_cast(bf16x8, zw), acc, 0, 0, 0); }
#pragma unroll
        for (int jp = 0; jp <= tt; ++jp) acc = __builtin_amdgcn_mfma_f32_16x16x32_bf16(Fl[128 * (tt - jp)], U[jp], acc, 0, 0, 0);
        typedef unsigned u32x2v __attribute__((ext_vector_type(2))); u32x2v o; o.x = pk2(gelu_tanh_f(acc.x), gelu_tanh_f(acc.y)); o.y = pk2(gelu_tanh_f(acc.z), gelu_tanh_f(acc.w));
        st8(yp + (size_t)(2 * tt) * 512, o);
        if (tt < 31) {
#pragma unroll
            for (int q = 0; q < 16; ++q) { const float r0 = zr[q] * a2r[q] - zi[q] * a2i[q], i0 = zr[q] * a2i[q] + zi[q] * a2r[q]; zr[q] = r0; zi[q] = i0; } }
        asm volatile("" ::: "memory"); }
    asm volatile("s_waitcnt lgkmcnt(0)\n\ts_barrier" ::: "memory");
    }
}
#undef SSM_HBATCH

__device__ __forceinline__ void attn_post(Frame& F, int b, int h, int qb, const bf16_t* Ob, bf16_t* OAb, float lam) {
    int ln = lane_id(); asm volatile("s_waitcnt vmcnt(0)" : "+v"(ln) :: "memory");
    const int row = b * SEQ + qb * 256 + F.wave * 32 + (ln >> 1), half = ln & 1;
    const bf16_t* p0 = Ob + (size_t)row * 1024 + h * 128 + half * 64; const bf16_t* p1 = p0 + 512;
    float o[64]; float ss = 0.f;
#pragma unroll
    for (int j = 0; j < 8; ++j) { const v4u a = *(const GAS v4u*)(p0 + 8 * j), c = *(const GAS v4u*)(p1 + 8 * j);
        const unsigned aw[4] = {a.x, a.y, a.z, a.w}, cw[4] = {c.x, c.y, c.z, c.w};
#pragma unroll
        for (int k = 0; k < 4; ++k) { const float x0 = __uint_as_float(aw[k] << 16) - lam * __uint_as_float(cw[k] << 16), x1 = __uint_as_float(aw[k] & 0xffff0000u) - lam * __uint_as_float(cw[k] & 0xffff0000u);
            o[8 * j + 2 * k] = x0; o[8 * j + 2 * k + 1] = x1; ss += x0 * x0 + x1 * x1; } }
    ss += __shfl_xor(ss, 1);
    const float r = rsqrtf(ss * (1.f / 128.f) + EPS) * (1.f - LAM_INIT);
    const float* sg = F.in[10] + half * 64; bf16_t* q = OAb + (size_t)row * 512 + h * 128 + half * 64;
#pragma unroll
    for (int j = 0; j < 8; ++j) { const f32x4 g0 = *(const f32x4*)(sg + 8 * j), g1 = *(const f32x4*)(sg + 8 * j + 4); v4u w;
        w.x = pk2(o[8 * j] * r * g0.x, o[8 * j + 1] * r * g0.y); w.y = pk2(o[8 * j + 2] * r * g0.z, o[8 * j + 3] * r * g0.w);
        w.z = pk2(o[8 * j + 4] * r * g1.x, o[8 * j + 5] * r * g1.y); w.w = pk2(o[8 * j + 6] * r * g1.z, o[8 * j + 7] * r * g1.w);
        st16(q + 8 * j, w); }
}
__device__ __forceinline__ void attn_phase(Frame& F, char* lds) {
    using abf = attn_body::bf16;
    const abf* Qb = (const abf*)(F.ws + WS_Q); const abf* Kb = (const abf*)(F.ws + WS_K); const abf* Vb = (const abf*)(F.ws + WS_V); abf* Ob = (abf*)(F.ws + WS_OB);
    const float lam = ((const float*)(F.ws + WS_SCAL))[0];
    for (int v = F.vcu; v < 256; v += F.G) {
    const int bh = v >> 3, s = v & 7, b = bh >> 2, h = bh & 3;
#pragma clang loop unroll(disable)
    for (int it = 0; it < 4; ++it) { const int qb = it < 2 ? s : 15 - s, c = it & 1;
        attn_body::attn_unit128<8>((long)b * SEQ, qb, Qb + (2 * h + c) * 64, Kb + (2 * h + c) * 64, Vb + h * 128, Ob + c * 512 + h * 128, lds, F.wave * 64 + lane_id());
        if (it & 1) attn_post(F, b, h, qb, (const bf16_t*)Ob, (bf16_t*)(F.ws + WS_OA), lam);
    }
    }
}

constexpr int LDS_TAB = LDSCTL_OFF + 1024;
__device__ __forceinline__ void router_phase(Frame& F) {
    LAS unsigned char* L = F.lds + RING_OFF; LAS unsigned* tab = (LAS unsigned*)(F.lds + LDS_TAB);
    { const GAS v4u* src = (const GAS v4u*)(F.ws + WS_WR);
#pragma unroll
      for (int i = 0; i < 12; ++i) ((LAS v4u*)L)[F.tid + 512 * i] = src[F.tid + 512 * i]; }
    const int lane = F.lane, m = lane & 15, kq = lane >> 4;
    LAS float* scr = (LAS float*)(L + 98304 + F.wave * 4096);
    const bf16_t* X1b = (const bf16_t*)(F.ws + WS_X1B); int* ltok = (int*)(F.ws + WS_LTOK); float* lw = (float*)(F.ws + WS_LW); float* lrs = (float*)(F.ws + WS_LR);
    for (int tile = F.vcu * NWAVES + F.wave; tile < T / 16; tile += F.G * NWAVES) {
        if (F.tid < 64) tab[192 + F.tid] = 0u; else if (F.tid < 176) tab[320 + F.tid - 64] = 0u;
        __syncthreads();
        const int row0 = tile * 16; const bf16_t* ap = X1b + (size_t)(row0 + m) * DM + 8 * kq;
        bf16x8 A[32];
#pragma unroll
        for (int ks = 0; ks < 32; ++ks) A[ks] = *(const GAS bf16x8*)(ap + 32 * ks);
        f32x4 acc[3]; float ss = 0.f;
#pragma unroll
        for (int q = 0; q < 3; ++q) acc[q] = (f32x4){0.f, 0.f, 0.f, 0.f};
#pragma unroll
        for (int ks = 0; ks < 32; ++ks) {
#pragma unroll
            for (int j = 0; j < 8; ++j) { const float v = bf2f((bf16_t)A[ks][j]); ss += v * v; }
#pragma unroll
            for (int q = 0; q < 3; ++q) acc[q] = __builtin_amdgcn_mfma_f32_16x16x32_bf16(A[ks], *(const LAS bf16x8*)(L + ((ks * 3 + q) * 64 + lane) * 16), acc[q], 0, 0, 0); }
        ss += __shfl_xor(ss, 16); ss += __shfl_xor(ss, 32);
        const float r = rsqrtf(ss * (1.f / DM) + EPS);
#pragma unroll
        for (int q = 0; q < 3; ++q)
#pragma unroll
            for (int i = 0; i < 4; ++i) scr[(4 * kq + i) * 49 + 16 * q + m] = acc[q][i];
        LDS_WAIT(); asm volatile("" ::: "memory");
        int l1 = 0, l2 = 0, rk1 = 0, rk2 = 0, pid = 0, rk3 = 0; float w1 = 0.f, w2 = 0.f;
        if (lane < 16) { const LAS float* lr = scr + lane * 49; const float* brg = F.in[24]; const float* bre = F.in[26];
            int grp = 0; float mx = lr[0] * r + brg[0]; float lg[4]; lg[0] = mx;
#pragma unroll
            for (int c = 1; c < 4; ++c) { lg[c] = lr[c] * r + brg[c]; if (lg[c] > mx) { mx = lg[c]; grp = c; } }
            float den = 0.f;
#pragma unroll
            for (int c = 0; c < 4; ++c) den += __expf(lg[c] - mx);
            const float pg = 1.f / den;
            const LAS float* le = lr + 4 + grp * 8; const float* be = bre + grp * 8;
            float v1 = -INFINITY, v2 = -INFINITY; int i1 = 0, i2 = 0;
#pragma unroll
            for (int e = 0; e < 8; ++e) { const float v = le[e] * r + be[e]; if (v > v1) { v2 = v1; i2 = i1; v1 = v; i1 = e; } else if (v > v2) { v2 = v; i2 = e; } }
            const float e2 = __expf(v2 - v1); w1 = pg / (1.f + e2); w2 = pg * e2 / (1.f + e2);
            l1 = grp * 8 + i1; l2 = 32 + grp * 8 + i2;
            rk1 = (int)__hip_atomic_fetch_add(tab + 192 + l1, 1u, __ATOMIC_RELAXED, __HIP_MEMORY_SCOPE_WORKGROUP); rk2 = (int)__hip_atomic_fetch_add(tab + 192 + l2, 1u, __ATOMIC_RELAXED, __HIP_MEMORY_SCOPE_WORKGROUP);
            { const int lo = i1 < i2 ? i1 : i2, hi = i1 < i2 ? i2 : i1; pid = grp * 28 + lo * 8 - (lo * (lo + 1)) / 2 + hi - lo - 1; }
            rk3 = (int)__hip_atomic_fetch_add(tab + 320 + pid, 1u, __ATOMIC_RELAXED, __HIP_MEMORY_SCOPE_WORKGROUP); }
        __syncthreads();
        if (F.tid < 64) { const unsigned c = tab[192 + F.tid]; tab[256 + F.tid] = c ? __hip_atomic_fetch_add(F.ctl + CW_CNT + 64 * F.tid, c, RLX_AGENT) : 0u; }
        else if (F.tid < 176) { const int q = F.tid - 64; const unsigned c = tab[320 + q]; tab[432 + q] = c ? __hip_atomic_fetch_add(F.ctl + CW_CNT2 + 64 * q, c, RLX_AGENT) : 0u; }
        __syncthreads();
        if (lane < 16) { const int row = row0 + lane; const size_t p1 = (size_t)l1 * T + tab[256 + l1] + rk1, p2 = (size_t)l2 * T + tab[256 + l2] + rk2;
            ltok[p1] = row; lw[p1] = w1; lrs[p1] = r; ltok[p2] = row; lw[p2] = w2; lrs[p2] = r;
            ((int*)(F.ws + WS_PTOK))[(size_t)pid * T + tab[432 + pid] + rk3] = row;
            ((int4*)(F.ws + WS_RINFO))[row] = make_int4(l1, (int)(tab[256 + l1] + rk1), l2, (int)(tab[256 + l2] + rk2)); }
        __syncthreads();
    }
}
struct MoeUnit { int mt, l, tl, pn, cnt, ord; };
template <bool GATHER_> struct MoeSched {
    using U = MoeUnit; static constexpr bool GATHER = GATHER_;
    const LAS unsigned* tab; const LAS unsigned* tokbuf; int G, c, npn, l_lo, l_hi, rowbytes; const int* ltok; const char* Bbase; size_t bexp, bpn; int u_lo, u_hi;
    __device__ __forceinline__ int rd(int i) const { return __builtin_amdgcn_readfirstlane((int)tab[i]); }
    __device__ __forceinline__ bool next(int i, U& u) const {
        const int mt_lo = rd(64 + l_lo), mt_hi = rd(64 + l_hi); long Lidx;
        if ((G & 15) == 0) { const int mr = (c >> 4) * 8 + (c & 7), pn_ = (c >> 3) & 1; Lidx = (long)u_lo + (long)i * G + 2 * mr + pn_; } else Lidx = (long)u_lo + (long)i * G + c;
        if (Lidx >= (long)(mt_hi - mt_lo) * npn || Lidx >= (long)u_hi) return false;
        const int mt = mt_lo + (int)(Lidx / npn); u.pn = (int)(Lidx % npn); u.mt = mt; const int l = rd(320 + mt);
        u.l = l; u.tl = mt - rd(64 + l); u.cnt = rd(l); u.ord = i; return true; }
    __device__ __forceinline__ unsigned a_off(const U& u, int r) const { return tokbuf[(u.ord & 7) * 256 + r] * (unsigned)rowbytes; }
    __device__ __forceinline__ size_t a_base(const U& u) const { return (size_t)u.mt * 256 * (size_t)rowbytes; }
    __device__ __forceinline__ const char* b_ptr(const U& u) const { return Bbase + (size_t)(u.l & 31) * bexp + (size_t)u.pn * bpn; }
};
__device__ __forceinline__ void moe_tables(Frame& F) {
    LAS unsigned* tab = (LAS unsigned*)(F.lds + LDS_TAB);
    if (F.tid < 64) { const unsigned c = __hip_atomic_load(F.ctl + CW_CNT + 64 * F.tid, RLX_AGENT), t = (c + 255u) >> 8; unsigned inc = t;
#pragma unroll
        for (int o = 1; o < 64; o <<= 1) { const unsigned v = __shfl_up(inc, o); if ((F.tid & 63) >= o) inc += v; }
        tab[F.tid] = c; tab[64 + F.tid] = inc - t; if (F.tid == 63) tab[128] = inc;
        for (unsigned mt = inc - t; mt < inc && mt < 336u; ++mt) tab[320 + mt] = (unsigned)F.tid; }
    __syncthreads();
}
constexpr int LDS_TOK = LDSCTL_OFF + 4096;
template <class S_> __device__ __forceinline__ void moe_stage_tokens(Frame& F, const S_& S) {
    LAS unsigned* tb = (LAS unsigned*)(F.lds + LDS_TOK);
#pragma unroll
    for (int base = 0; base < 8; base += 4) { const int i = base + (F.tid >> 7), r0 = F.tid & 127; MoeUnit u;
        if (S.next(i, u)) { const int p0 = u.tl * 256 + r0, p1 = p0 + 128; const int* lt = S.ltok + (size_t)u.l * T;
            const unsigned a = p0 < u.cnt ? (unsigned)lt[p0] : 0u, b = p1 < u.cnt ? (unsigned)lt[p1] : 0u; tb[i * 256 + r0] = a; tb[i * 256 + r0 + 128] = b; } }
    __syncthreads();
}
struct EpiMoe1 {
    static constexpr bool PERM = true, AFTER_DRAIN = false;
    const float* lw; const float* lrs; unsigned char* Hb; float wsc;
    __device__ __forceinline__ void operator()(const pg8::f32x4 (&acc)[2][2][4][2], const MoeUnit& u, int wr, int wc, int fr, int fq) const {
        int lane_ = fr + 16 * fq; asm volatile("" : "+v"(lane_)); fr = lane_ & 15; fq = lane_ >> 4;
        const int col = u.pn * 128 + wc * 32 + 8 * fq;
        float wv[2][4], rv[2][4];
#pragma unroll
        for (int ai = 0; ai < 2; ++ai)
#pragma unroll
            for (int m = 0; m < 4; ++m) { const size_t p = (size_t)u.l * T + u.tl * 256 + ai * 128 + wr * 64 + m * 16 + fr; wv[ai][m] = lw[p]; rv[ai][m] = lrs[p] * wsc; }
#pragma unroll
        for (int ai = 0; ai < 2; ++ai)
#pragma unroll
            for (int m = 0; m < 4; ++m) { const int r = ai * 128 + wr * 64 + m * 16 + fr; const float w = wv[ai][m], rs = rv[ai][m];
                const f32x4 ga = acc[ai][0][m][0] * rs, gb = acc[ai][0][m][1] * rs, ua = acc[ai][1][m][0] * (rs * w * H_SCALE), ub = acc[ai][1][m][1] * (rs * w * H_SCALE); wt_v2u o;
                o.x = pk4_fp8(ga.x * fast_sigmoid(ga.x) * ua.x, ga.y * fast_sigmoid(ga.y) * ua.y, ga.z * fast_sigmoid(ga.z) * ua.z, ga.w * fast_sigmoid(ga.w) * ua.w);
                o.y = pk4_fp8(gb.x * fast_sigmoid(gb.x) * ub.x, gb.y * fast_sigmoid(gb.y) * ub.y, gb.z * fast_sigmoid(gb.z) * ub.z, gb.w * fast_sigmoid(gb.w) * ub.w);
                pst8(Hb + ((size_t)u.mt * 256 + r) * 256 + col, o); }
    }
};
constexpr int P2_CNT = 130, P2_PREFIX = 242, P2_MAP = 356, P2_PAIR = 724;
__device__ __forceinline__ void moe_tables2(Frame& F) {
    LAS unsigned* tab = (LAS unsigned*)(F.lds + LDS_TAB);
    if (F.tid < 64) { const int ln = F.tid;
        const unsigned c0 = __hip_atomic_load(F.ctl + CW_CNT2 + 64 * ln, RLX_AGENT), c1 = ln < 48 ? __hip_atomic_load(F.ctl + CW_CNT2 + 64 * (64 + ln), RLX_AGENT) : 0u;
        const unsigned t0 = (c0 + 255u) >> 8, t1 = (c1 + 255u) >> 8; unsigned i0 = t0, i1 = t1;
#pragma unroll
        for (int o = 1; o < 64; o <<= 1) { const unsigned v0 = __shfl_up(i0, o), v1 = __shfl_up(i1, o); if (ln >= o) { i0 += v0; i1 += v1; } }
        const unsigned tot0 = __shfl(i0, 63), lo0 = i0 - t0, lo1 = tot0 + i1 - t1;
        tab[P2_CNT + ln] = c0; tab[P2_PREFIX + ln] = lo0;
        for (unsigned mt = lo0; mt < lo0 + t0 && mt < 368u; ++mt) tab[P2_MAP + mt] = (unsigned)ln;
        if (ln < 48) { tab[P2_CNT + 64 + ln] = c1; tab[P2_PREFIX + 64 + ln] = lo1; for (unsigned mt = lo1; mt < lo1 + t1 && mt < 368u; ++mt) tab[P2_MAP + mt] = (unsigned)(64 + ln); }
        if (ln == 47) tab[P2_PREFIX + 112] = lo1 + t1; }
    else if (F.tid >= 128 && F.tid < 156) { const int k = F.tid - 128; int lo = 0, off = 0; while (k >= off + 7 - lo) { off += 7 - lo; ++lo; } tab[P2_PAIR + k] = (unsigned)(lo | ((lo + 1 + k - off) << 8)); }
    __syncthreads();
}
struct PairUnit { int mt, pid, tl, pn, cnt, ord; };
struct PairSched {
    using U = PairUnit;
    const LAS unsigned* tab; const LAS unsigned* tokbuf; int G, c; const char* Wd;
    __device__ __forceinline__ int rd(int i) const { return __builtin_amdgcn_readfirstlane((int)tab[i]); }
    __device__ __forceinline__ bool next(int i, U& u) const {
        int mt, pn;
        if ((G & 31) == 0) { const int slot = c >> 3, per = G >> 2; int w = (slot >> 2) * 8 + (c & 7) + (i & 1); w = w >= per ? w - per : w; mt = i * per + w; pn = slot & 3; }
        else { const long idx = (long)i * G + c; mt = (int)(idx >> 2); pn = (int)(idx & 3); }
        if (i >= 4 || mt >= rd(P2_PREFIX + 112)) return false;
        u.mt = mt; u.pn = pn; const int pid = rd(P2_MAP + mt); u.pid = pid; u.tl = mt - rd(P2_PREFIX + pid); u.cnt = rd(P2_CNT + pid); u.ord = i; return true; }
    __device__ __forceinline__ unsigned a_off(const U& u, int set, int r) const { return tokbuf[((u.ord & 3) * 2 + set) * 256 + r]; }
    __device__ __forceinline__ const char* b_ptr(const U& u, int set) const { const int g = u.pid / 28, pe = rd(P2_PAIR + u.pid - g * 28), e = g * 8 + (set ? (pe >> 8) : (pe & 255));
        return Wd + (size_t)e * ((size_t)DM * 256) + (size_t)u.pn * ((size_t)256 * 256); }
};
__device__ __forceinline__ void moe_stage_pairs(Frame& F, const PairSched& S) {
    LAS unsigned* tb = (LAS unsigned*)(F.lds + LDS_TOK); const LAS unsigned* tab = (const LAS unsigned*)(F.lds + LDS_TAB);
    const int* ptok = (const int*)(F.ws + WS_PTOK); const int4* rinfo = (const int4*)(F.ws + WS_RINFO);
    const int i = F.tid >> 7, r0 = F.tid & 127; PairUnit u;
    if (S.next(i, u)) { int tk[2]; int4 ri[2];
#pragma unroll
        for (int h = 0; h < 2; ++h) { const int p = u.tl * 256 + r0 + 128 * h; tk[h] = p < u.cnt ? ptok[(size_t)u.pid * T + p] : -1; }
#pragma unroll
        for (int h = 0; h < 2; ++h) ri[h] = rinfo[tk[h] < 0 ? 0 : tk[h]];
#pragma unroll
        for (int h = 0; h < 2; ++h) { const unsigned r1 = (tab[64 + ri[h].x] * 256u + (unsigned)ri[h].y) * 256u, r2 = (tab[64 + ri[h].z] * 256u + (unsigned)ri[h].w) * 256u;     const bool f = (ri[h].x & 31) < (ri[h].z & 31), ok = tk[h] >= 0;
            const int r = r0 + 128 * h; tb[(i * 2 + 0) * 256 + r] = ok ? (f ? r1 : r2) : 0u; tb[(i * 2 + 1) * 256 + r] = ok ? (f ? r2 : r1) : 0u; tb[2048 + i * 256 + r] = (unsigned)tk[h]; } }
    __syncthreads();
}
struct EpiPair {
    static constexpr bool PERM = true, AFTER_DRAIN = false;
    const LAS int* toks; const bf16_t* X1b; float* out; float sc;
    __device__ __forceinline__ void operator()(const pg8::f32x4 (&acc)[2][2][4][2], const PairUnit& u, int wr, int wc, int fr, int fq) const {
        const int lane_ = lane_id(); fr = lane_ & 15; fq = lane_ >> 4;
        const int col0 = u.pn * 256 + wc * 32 + 8 * fq;
        int tok[2][4];
#pragma unroll
        for (int ai = 0; ai < 2; ++ai)
#pragma unroll
            for (int m = 0; m < 4; ++m) tok[ai][m] = toks[(u.ord & 3) * 256 + ai * 128 + wr * 64 + m * 16 + fr];
        v4u xv[2][4][2];
#pragma unroll
        for (int ai = 0; ai < 2; ++ai)
#pragma unroll
            for (int m = 0; m < 4; ++m)
#pragma unroll
                for (int bj = 0; bj < 2; ++bj) xv[ai][m][bj] = *(const v4u*)(X1b + (size_t)(tok[ai][m] < 0 ? 0 : tok[ai][m]) * DM + col0 + bj * 128);
#pragma unroll
        for (int ai = 0; ai < 2; ++ai) {
#pragma unroll
            for (int m = 0; m < 4; ++m) if (tok[ai][m] >= 0) {
#pragma unroll
                for (int bj = 0; bj < 2; ++bj) { const v4u x = xv[ai][m][bj]; f32x4 a = acc[ai][bj][m][0] * sc, b = acc[ai][bj][m][1] * sc;
                    a.x += __uint_as_float(x.x << 16); a.y += __uint_as_float(x.x & 0xffff0000u); a.z += __uint_as_float(x.y << 16); a.w += __uint_as_float(x.y & 0xffff0000u);
                    b.x += __uint_as_float(x.z << 16); b.y += __uint_as_float(x.z & 0xffff0000u); b.z += __uint_as_float(x.w << 16); b.w += __uint_as_float(x.w & 0xffff0000u);
                    float* o = out + (size_t)tok[ai][m] * DM + col0 + bj * 128; pst16(o, __builtin_bit_cast(v4u, a)); pst16(o + 4, __builtin_bit_cast(v4u, b)); } } }
    }
};
struct Args { const float* in[30]; float* out; unsigned char* ws; int ph_lo, ph_hi, li, use_bar; };
constexpr int N_PHASES = 12;
template <int LO, int HI> __global__ void __launch_bounds__(NWAVES * 64, 2) skel_fwd(Args args) {
    extern __shared__ __attribute__((aligned(16))) unsigned char lds[];
    Frame F;
    F.lds = (LAS unsigned char*)lds;
    F.MISC = (volatile LAS unsigned*)(F.lds + MISC_OFF);
    const int wave0 = __builtin_amdgcn_readfirstlane((int)threadIdx.x >> 6);
#define MKTID (wave0 * 64 + lane_id())
    F.tid = MKTID; F.lane = F.tid & 63; F.wave = wave0;
    F.G = gridDim.x; { const int bx = blockIdx.x; F.vcu = (F.G % 8 == 0) ? (bx % 8) * (F.G / 8) + bx / 8 : bx; }
    F.ws = args.ws; F.ctl = (gu32*)(args.ws + WS_CTL); F.out = args.out;
#pragma unroll
    for (int i = 0; i < 30; ++i) F.in[i] = args.in[i];
    for (int u = F.tid; u < (LDS_BYTES - LDSCTL_OFF) / 4; u += NWAVES * 64) ((LAS unsigned*)(F.lds + LDSCTL_OFF))[u] = 0u;
    __syncthreads();
    XcdBarrier bar; bar.bar = (unsigned*)(F.ctl + CW_BAR); bar.x = 0; bar.st = nullptr;
    if (args.use_bar) bar = xcd_barrier_post((unsigned*)(F.ctl + CW_BAR), F.MISC + 8, MKTID);
#define GRID_BAR() do { if (args.use_bar) xcd_barrier(bar, MKTID); } while (0)
    constexpr int lo = LO, hi = HI;
#define IN(k) (lo <= (k) && (k) < hi)
#define REFRESH() do { int t_ = MKTID; asm volatile("" : "+v"(t_)); F.tid = t_; F.lane = t_ & 63; F.wave = wave0; } while (0)
#define BOTH(k) (IN(k) && IN((k) + 1))

    if (IN(0)) { REFRESH(); p0_prologue(F); if (BOTH(0)) GRID_BAR(); }

    if (IN(1)) {
        const float* sa = (const float*)(F.ws + WS_SA); const float* sw = (const float*)(F.ws + WS_SW);
        if constexpr (I8_FROM_PN > 0) { const int nw = (T / 256) * I8_FROM_PN; pg8::Gemm g{(const bf16_t*)(F.ws + WS_XN), (const bf16_t*)(F.ws + WS_WIN), T, 256 * I8_FROM_PN, DM}; RotOrder S; S.so.init(T, 256 * I8_FROM_PN, F.G, (int)blockIdx.x);
          S.n = (nw % F.G == 0) ? nw / F.G : 0; S.rot = S.n ? (int)((blockIdx.x >> 3) % (unsigned)S.n) : 0; if (S.n == 0) S.n = 1 << 30;
          EpiInT<0, I8_FROM_PN, false> E{(bf16_t*)(F.ws + WS_Q), (bf16_t*)(F.ws + WS_K), (bf16_t*)(F.ws + WS_V), (bf16_t*)(F.ws + WS_U), (bf16_t*)(F.ws + WS_G), (const float*)(F.ws + WS_ROPE), F.in[4], F.in[5], sa, sw};
          pg8::gemm_phase<EpiInT<0, I8_FROM_PN, false>, RotOrder, PG8_ALIGN, PG8_SP2>(F.lds + RING_OFF, g, S, E, MKTID); }
        { const int nw = (T / 256) * (16 - I8_FROM_PN); pg8::Gemm g{(const bf16_t*)(F.ws + WS_XN8), (const bf16_t*)(F.ws + WS_WG8), T, 256 * (16 - I8_FROM_PN), DM / 2}; RotOrder S; S.so.init(T, 256 * (16 - I8_FROM_PN), F.G, (int)blockIdx.x);
          S.n = (nw % F.G == 0) ? nw / F.G : 0; S.rot = S.n ? (int)((blockIdx.x >> 3) % (unsigned)S.n) : 0; if (S.n == 0) S.n = 1 << 30;
          EpiInT<I8_FROM_PN, 16, true> E{(bf16_t*)(F.ws + WS_Q), (bf16_t*)(F.ws + WS_K), (bf16_t*)(F.ws + WS_V), (bf16_t*)(F.ws + WS_U), (bf16_t*)(F.ws + WS_G), (const float*)(F.ws + WS_ROPE), F.in[4], F.in[5], sa, sw};
          pg8::gemm_phase<EpiInT<I8_FROM_PN, 16, true>, RotOrder, PG8_ALIGN, PG8_SP2, false, true>(F.lds + RING_OFF, g, S, E, MKTID); }
        if (BOTH(1)) GRID_BAR();
    }
    if (IN(2)) { REFRESH(); ssm_phase(F); }
    if (IN(3)) { REFRESH(); attn_phase(F, (char*)lds + RING_OFF); if (BOTH(3)) GRID_BAR(); }
    if (IN(4)) {
        pg8::Gemm g{(const bf16_t*)(F.ws + WS_OA), (const bf16_t*)(F.ws + WS_WO), 2 * T, 3072, 512}; ChainOrder S; S.so.init(T, DM, F.G, (int)blockIdx.x);
        EpiOAGlu E{EpiOA{(const bf16_t*)(F.ws + WS_G), (bf16_t*)(F.ws + WS_MA)}, EpiGlu{(const bf16_t*)(F.ws + WS_G), (const bf16_t*)(F.ws + WS_MA), (bf16_t*)(F.ws + WS_MG)}};
        pg8::gemm_phase<EpiOAGlu, ChainOrder, PG8_ALIGN, PG8_SP2>(F.lds + RING_OFF, g, S, E, MKTID);
        if (IN(6)) GRID_BAR();
    }
    if (IN(6)) {
        pg8::Gemm g{(const bf16_t*)(F.ws + WS_MG), (const bf16_t*)(F.ws + WS_WOUT), T, DM, DM}; pg8::StaticOrder S; S.init(T, DM, F.G, (int)blockIdx.x);
        EpiOut E{F.in[0], F.out, (bf16_t*)(F.ws + WS_X1B), F.ws + WS_X1B8};
        REFRESH(); const int late = F.vcu & 1, gwp = (F.vcu >> 1) * NWAVES + F.wave, ngwp = (F.G >> 1) * NWAVES;
        if ((F.G & 1) == 0 && late) { expert_weights_items(F, 2 * gwp + 1, 2 * ngwp); }
        pg8::gemm_phase<EpiOut, pg8::StaticOrder, PG8_ALIGN, PG8_SP2>(F.lds + RING_OFF, g, S, E, MKTID);
        REFRESH();
        if ((F.G & 1) != 0) expert_weights_items(F, F.vcu * NWAVES + F.wave, F.G * NWAVES); else if (!late) expert_weights_items(F, 2 * gwp, 2 * ngwp);
        if (BOTH(6)) GRID_BAR();
    }
    if (IN(7)) { REFRESH(); router_phase(F); if (BOTH(7)) GRID_BAR(); }
    if (IN(8)) { REFRESH(); moe_tables(F);
        MoeSched<true> S{(const LAS unsigned*)(F.lds + LDS_TAB), (const LAS unsigned*)(F.lds + LDS_TOK), F.G, (int)blockIdx.x, 2, 0, 64, DM, (const int*)(F.ws + WS_LTOK), (const char*)(F.ws + WS_WGU), (size_t)512 * DM, (size_t)256 * DM, 0, 1 << 30};
        moe_stage_tokens(F, S);
        EpiMoe1 E{(const float*)(F.ws + WS_LW), (const float*)(F.ws + WS_LR), F.ws + WS_HB, 1.f / GATE_WSCALE};
        pg8::gemm_phase_x<EpiMoe1, MoeSched<true>, true, true>(F.lds + RING_OFF, (const char*)(F.ws + WS_X1B8), DM / 2, S, E, MKTID);
        if (BOTH(8)) GRID_BAR(); }
    if (IN(9)) { REFRESH(); moe_tables(F); moe_tables2(F);
        PairSched S{(const LAS unsigned*)(F.lds + LDS_TAB), (const LAS unsigned*)(F.lds + LDS_TOK), F.G, (int)blockIdx.x, (const char*)(F.ws + WS_WD)};
        moe_stage_pairs(F, S);
        EpiPair E{(const LAS int*)(F.lds + LDS_TOK + 8192), (const bf16_t*)(F.ws + WS_X1B), F.out, 1.f / (H_SCALE * WD_SCALE)};
        pg8::gemm_phase_pair<EpiPair, PairSched, true, true>(F.lds + RING_OFF, (const char*)(F.ws + WS_HB), S, E, MKTID); }
#undef IN
#undef BOTH
}
#ifndef MK_PER_PHASE
#define MK_PER_PHASE 0
#endif
template <int LO, int HI> static bool launch_phases(const Args& a, int grid, hipStream_t stream) {
    static bool attr = false;
    if (!attr) { if (hipFuncSetAttribute((const void*)skel_fwd<LO, HI>, hipFuncAttributeMaxDynamicSharedMemorySize, LDS_BYTES) != hipSuccess) { fprintf(stderr, "kernel_launch: hipFuncSetAttribute failed (%d bytes of dynamic LDS)\n", LDS_BYTES); return false; } attr = true; }
    hipLaunchKernelGGL((skel_fwd<LO, HI>), dim3(grid), dim3(NWAVES * 64), LDS_BYTES, stream, a);
    const hipError_t le = hipPeekAtLastError();
    if (le != hipSuccess) { fprintf(stderr, "kernel_launch: launch of phases [%d,%d) failed: %s\n", LO, HI, hipGetErrorName(le)); return false; }
    return true;
}
extern "C" void kernel_launch(void* const* d_in, const int* in_sizes, int n_in, void* d_out, int out_size, void* d_ws, size_t ws_size, hipStream_t stream) {
    static int grid = 0;
    if (grid == 0) {
        if (n_in != 30 || in_sizes[0] != T * DM || out_size != T * DM || ws_size < WS_END) { fprintf(stderr, "kernel_launch: unexpected shapes: n_in %d, out %d, ws %zu; nothing launched\n", n_in, out_size, ws_size); grid = -1; return; }
        int dev = 0, cus = 0;
        if (hipGetDevice(&dev) != hipSuccess || hipDeviceGetAttribute(&cus, hipDeviceAttributeMultiprocessorCount, dev) != hipSuccess || cus < 8) { fprintf(stderr, "kernel_launch: device query failed; nothing launched\n"); grid = -1; return; }
        grid = cus > 256 ? 256 : cus;
    }
    if (grid < 0) return;
    if (hipMemsetAsync((char*)d_ws + WS_CTL, 0, CTL_ZERO_BYTES, stream) != hipSuccess) { fprintf(stderr, "kernel_launch: hipMemsetAsync failed\n"); return; }
    Args a{};
    for (int i = 0; i < 30; ++i) a.in[i] = (const float*)d_in[i];
    a.out = (float*)d_out; a.ws = (unsigned char*)d_ws;
#if MK_PER_PHASE
    a.use_bar = 0;
    launch_phases<0, 1>(a, grid, stream) && launch_phases<1, 2>(a, grid, stream) && launch_phases<2, 4>(a, grid, stream) && launch_phases<4, 5>(a, grid, stream) && launch_phases<5, 6>(a, grid, stream) &&
        launch_phases<6, 7>(a, grid, stream) && launch_phases<7, 8>(a, grid, stream) && launch_phases<8, 9>(a, grid, stream) && launch_phases<9, 10>(a, grid, stream) && launch_phases<10, 11>(a, grid, stream);
#else
    a.use_bar = 1; a.ph_lo = 0; a.ph_hi = 11;
    launch_phases<0, 11>(a, grid, stream);
#endif
}
```

```cpp
#include <hip/hip_runtime.h>
#include <hip/hip_bf16.h>
#include <cstdio>
#include <cstdint>
#include <cmath>

constexpr int DM = 1024, BATCH = 8, SEQ = 4096, T = BATCH * SEQ;
constexpr int IN_COLS = 4096;
constexpr float EPS = 1e-6f, ROPE_THETA = 500000.0f, LAM_INIT = 0.2f;
constexpr float QSCALE = 0.125f * 1.4426950408889634f;
typedef unsigned short bf16_t;
__device__ __forceinline__ float bf2f(bf16_t v) { return __uint_as_float(((unsigned)v) << 16); }
__device__ __forceinline__ bf16_t f2bf(float f) { unsigned u = __float_as_uint(f); return (bf16_t)((u + 0x7fffu + ((u >> 16) & 1u)) >> 16); }

#ifndef WT_STORES
#define WT_STORES 0
#endif
typedef unsigned wt_v4u __attribute__((ext_vector_type(4))); typedef unsigned wt_v2u __attribute__((ext_vector_type(2)));
__device__ __forceinline__ void st16(void* p, wt_v4u v) { if (WT_STORES) asm volatile("global_store_dwordx4 %0, %1, off sc1\n\ts_nop 1" :: "v"(p), "v"(v) : "memory"); else *(wt_v4u*)p = v; }
__device__ __forceinline__ void st8(void* p, wt_v2u v) { if (WT_STORES) asm volatile("global_store_dwordx2 %0, %1, off sc1\n\ts_nop 1" :: "v"(p), "v"(v) : "memory"); else *(wt_v2u*)p = v; }
__device__ __forceinline__ void pst16(void* p, wt_v4u v) { *(wt_v4u*)p = v; }
__device__ __forceinline__ void pst8(void* p, wt_v2u v) { *(wt_v2u*)p = v; }
#define ATTN_STORE16(p,v) st16((void*)(p), (v))

constexpr size_t MiB = 1u << 20;
constexpr size_t WS_CTL = 0, CTL_ZERO_BYTES = 1 * MiB;
constexpr size_t WS_SCAL = 1 * MiB, WS_ROPE = 2 * MiB, WS_WIN = 4 * MiB, WS_WO = 12 * MiB, WS_WGLU = 13 * MiB, WS_WOUT = 15 * MiB, WS_WGU = 17 * MiB, WS_WD = 49 * MiB,
                 WS_WR = 65 * MiB, WS_SSMF = 66 * MiB, WS_SSMG = 68 * MiB, WS_SSMH = 76 * MiB, WS_SSMA = 84 * MiB, WS_RINFO = 85 * MiB, WS_LISTS = 86 * MiB;
constexpr size_t WS_XN = 96 * MiB, WS_Q = 160 * MiB, WS_K = 192 * MiB, WS_V = 224 * MiB, WS_U = 256 * MiB, WS_G = 288 * MiB, WS_OA = 416 * MiB, WS_Y2 = 448 * MiB, WS_END = 480 * MiB;
constexpr size_t WS_OB = WS_XN, WS_X1B = WS_OA, WS_MA = WS_Q, WS_MG = WS_V, WS_HB = WS_G;
constexpr size_t WS_XN8 = 416 * MiB, WS_WG8 = 8 * MiB, WS_SA = 1 * MiB + 256 * 1024, WS_SW = 1 * MiB + 512 * 1024;
constexpr size_t WS_XN8_LEGACY = 0;
constexpr size_t WS_X1B8 = 96 * MiB;
constexpr size_t WS_PTOK = 360 * MiB;
constexpr size_t WS_LTOK = 332 * MiB, WS_LW = 340 * MiB, WS_LR = 348 * MiB;
namespace pg8 {
#define PG8_LAS __attribute__((address_space(3)))
typedef unsigned short bf16_t;
typedef short bf16x8 __attribute__((ext_vector_type(8)));
typedef float f32x4 __attribute__((ext_vector_type(4)));
typedef unsigned u32x4 __attribute__((ext_vector_type(4)));
constexpr int BM = 256, BK = 64, HALF = 128, HTB = HALF * BK * 2  , STAGE_BYTES = 8 * HTB, NXCD = 8, WGM = 8;

__host__ __device__ __forceinline__ int lds_byte(int r, int c) { const int st = (r >> 4) * 2 + (c >> 5), rr = r & 15, cc = c & 31, ob = rr * 64 + cc * 2; return st * 1024 + (ob ^ (((ob >> 9) & 1) << 5)); }
__host__ __device__ __forceinline__ void stage_rc(int b, int& R, int& C) { const int st = b / 1024, sb = b % 1024, swz = sb ^ (((sb >> 9) & 1) << 5); R = (st >> 1) * 16 + swz / 64; C = (st & 1) * 32 + (swz % 64) / 2; }
__host__ __device__ __forceinline__ int perm32(int rho) { const int n = rho >> 4, i = rho & 15; return 8 * (i >> 2) + 4 * n + (i & 3); }

struct Unit { int pm, pn; };
struct Gemm { const bf16_t* A; const bf16_t* Bt; int M, N, K; };

struct StaticOrder {
    int nM, nN, nwg, G, c;
    __host__ __device__ void init(int M, int N, int G_, int c_) { nM = M / BM; nN = N / BM; nwg = nM * nN; G = G_; c = c_; }
    __host__ __device__ bool next(int i, Unit& u) const {
        const long L = (long)i * G + c; if (L >= nwg) return false;
        int wgid = (int)L; { const int q = nwg / NXCD, r = nwg % NXCD, xcd = wgid % NXCD, off = wgid / NXCD; wgid = (xcd < r ? xcd * (q + 1) : r * (q + 1) + (xcd - r) * q) + off; }
        const int nig = WGM * nN, gid = wgid / nig, fm = gid * WGM, gsz = (nM - fm) < WGM ? (nM - fm) : WGM;
        u.pm = fm + ((wgid % nig) % gsz); u.pn = (wgid % nig) / gsz; return true;
    }
    __device__ __forceinline__ void a_ready(const Unit&) const {}
    __device__ __forceinline__ void done(const Unit&) const {}
};

__device__ __forceinline__ unsigned cvt_pk_bf16(float lo, float hi) { unsigned r; asm volatile("v_cvt_pk_bf16_f32 %0, %1, %2" : "=v"(r) : "v"(lo), "v"(hi)); return r; }
typedef float f32x2 __attribute__((ext_vector_type(2)));
__device__ __forceinline__ f32x2 gelu_pk(f32x2 v) {
    const f32x2 av = __builtin_elementwise_abs(v), d = av * 0.2316418882f + 1.0f;
    f32x2 t; t.x = __builtin_amdgcn_rcpf(d.x); t.y = __builtin_amdgcn_rcpf(d.y);
    f32x2 q = t * 0.5307027145f + (-0.7265760135f); q = q * t + 0.7107068705f; q = q * t + (-0.142248368f); q = q * t + 0.127414796f; q = q * t;
    const f32x2 s = (v * v) * (-0.72134752044f);
    f32x2 e; e.x = __builtin_amdgcn_exp2f(s.x); e.y = __builtin_amdgcn_exp2f(s.y);
    const f32x2 m = v * (q * e), r = v - m;
    f32x2 o; o.x = v.x < 0.f ? m.x : r.x; o.y = v.y < 0.f ? m.y : r.y; return o;
}

template <int ACT  > struct EpiBf16 {
    static constexpr bool PERM = true, AFTER_DRAIN = false; static_assert(ACT == 0 || ACT == 1, "EpiBf16: ACT is 0 (none) or 1 (gelu_pk)");
    bf16_t* O; int ldc; const float* bias; int split_cols; size_t split_stride; float scale0;
    __device__ __forceinline__ void operator()(const f32x4 (&acc)[2][2][4][2], const Unit& u, int wr, int wc, int fr, int fq) const {
        const int row0 = u.pm * BM + wr * 64 + fr; int colt = u.pn * BM; bf16_t* base = O;
        float sc = 1.f; if (split_cols) { const int t = colt / split_cols; base += (size_t)t * split_stride; colt -= t * split_cols; if (t == 0) sc = scale0; }
        const int col0 = colt + wc * 32 + 8 * fq, bcol0 = u.pn * BM + wc * 32 + 8 * fq;
        f32x4 bv[2][2];
#pragma unroll
        for (int bj = 0; bj < 2; ++bj)
#pragma unroll
            for (int n = 0; n < 2; ++n) bv[bj][n] = bias ? *(const f32x4*)(bias + bcol0 + bj * HALF + 4 * n) : (f32x4){0.f, 0.f, 0.f, 0.f};
#pragma unroll
        for (int ai = 0; ai < 2; ++ai)
#pragma unroll
            for (int m = 0; m < 4; ++m) { bf16_t* rowp = base + (size_t)(row0 + ai * HALF + m * 16) * ldc + col0;
#pragma unroll
                for (int bj = 0; bj < 2; ++bj) { f32x4 v0 = acc[ai][bj][m][0] + bv[bj][0], v1 = acc[ai][bj][m][1] + bv[bj][1];
                    if (ACT == 1) { f32x2 a = gelu_pk((f32x2){v0[0], v0[1]}), b = gelu_pk((f32x2){v0[2], v0[3]}), c = gelu_pk((f32x2){v1[0], v1[1]}), d = gelu_pk((f32x2){v1[2], v1[3]});
                        v0 = (f32x4){a.x, a.y, b.x, b.y}; v1 = (f32x4){c.x, c.y, d.x, d.y}; }
                    v0 = v0 * sc; v1 = v1 * sc; u32x4 w; w.x = cvt_pk_bf16(v0[0], v0[1]); w.y = cvt_pk_bf16(v0[2], v0[3]); w.z = cvt_pk_bf16(v1[0], v1[1]); w.w = cvt_pk_bf16(v1[2], v1[3]);
                    *(u32x4*)(rowp + bj * HALF) = w; } }
    }
};

template <class Epi, class Sched, bool ALIGN_EPI = false, bool SP2 = false, bool FP8 = false, bool INT8 = false>
__device__ __forceinline__ void gemm_phase(PG8_LAS unsigned char* lds, const Gemm g, const Sched& S, const Epi& E, const int tid0) {
    int tid_ = tid0; asm volatile("" : "+v"(tid_));
    const int tid = tid_, wid = __builtin_amdgcn_readfirstlane(tid >> 6), lane = tid & 63, wr = wid >> 2, wc = wid & 3, fr = lane & 15, fq = lane >> 4;
    const int K = g.K; int nt_ = K / BK; if constexpr (FP8) asm volatile("" : "+s"(nt_));
    const int nt = nt_;
    unsigned voffA[2], voffB[2];
#pragma unroll
    for (int i = 0; i < 2; ++i) { int R, C; stage_rc(tid * 16 + i * 8192, R, C); const int Rb = Epi::PERM ? ((R & ~31) + perm32(R & 31)) : R;
        voffA[i] = (unsigned)(R * K + C) * 2u; voffB[i] = (unsigned)(Rb * K + C) * 2u; }
    const size_t kstep = (size_t)(BK * 2);
    const size_t hstep = (size_t)HALF * K * 2;
    const size_t tstep = 2 * hstep;
    const unsigned ldsw = (unsigned)wid * 1024u;
    const int aoff = lds_byte(wr * 64 + fr, fq * 8), boff = lds_byte(wc * 32 + fr, fq * 8);
#define PG8_SA(b, h) (((b) * 2 + (h)) * HTB)
#define PG8_SB(b, h) ((4 + (b) * 2 + (h)) * HTB)
#define PG8_STAGE(bufoff, gbase, voff) do { _Pragma("unroll") for (int _i = 0; _i < 2; ++_i) \
        __builtin_amdgcn_global_load_lds((const unsigned*)((const char*)(gbase) + (voff)[_i]), (PG8_LAS unsigned*)(lds + (bufoff) + ldsw + _i * 8192), 16, 0, 0); } while (0)
#define PG8_LDA(dst, b, h) do { _Pragma("unroll") for (int m = 0; m < 4; ++m) { if constexpr (FP8) { dst##8[m].lo = *(const PG8_LAS v4i_*)(lds + PG8_SA(b, h) + aoff + m * 2048); dst##8[m].hi = *(const PG8_LAS v4i_*)(lds + PG8_SA(b, h) + aoff + m * 2048 + 1024); } \
        else { _Pragma("unroll") for (int k = 0; k < 2; ++k) dst[m][k] = *(const PG8_LAS bf16x8*)(lds + PG8_SA(b, h) + aoff + m * 2048 + k * 1024); } } } while (0)
#define PG8_LDB(dst, b, h) do { _Pragma("unroll") for (int n = 0; n < 2; ++n) { if constexpr (FP8) { dst##8[n].lo = *(const PG8_LAS v4i_*)(lds + PG8_SB(b, h) + boff + n * 2048); dst##8[n].hi = *(const PG8_LAS v4i_*)(lds + PG8_SB(b, h) + boff + n * 2048 + 1024); } \
        else { _Pragma("unroll") for (int k = 0; k < 2; ++k) dst[n][k] = *(const PG8_LAS bf16x8*)(lds + PG8_SB(b, h) + boff + n * 2048 + k * 1024); } } } while (0)
#define PG8_MMA(ai, bj, At, Bt) do { __builtin_amdgcn_s_setprio(1); _Pragma("unroll") for (int m = 0; m < 4; ++m) _Pragma("unroll") for (int n = 0; n < 2; ++n) { \
        if constexpr (FP8) asm volatile("v_mfma_scale_f32_16x16x128_f8f6f4 %0, %1, %2, %0, %3, %3 op_sel_hi:[0,0,0]" : "+v"(acc[ai][bj][m][n]) : "v"(Bt##8[n]), "v"(At##8[m]), "v"(one8_)); \
        else if constexpr (INT8) { _Pragma("unroll") for (int k = 0; k < 2; ++k) acc[ai][bj][m][n] = __builtin_bit_cast(f32x4, __builtin_amdgcn_mfma_i32_16x16x64_i8(__builtin_bit_cast(v4i_, Bt[n][k]), __builtin_bit_cast(v4i_, At[m][k]), __builtin_bit_cast(v4i_, acc[ai][bj][m][n]), 0, 0, 0)); } \
        else { _Pragma("unroll") for (int k = 0; k < 2; ++k) acc[ai][bj][m][n] = __builtin_amdgcn_mfma_f32_16x16x32_bf16(Bt[n][k], At[m][k], acc[ai][bj][m][n], 0, 0, 0); } } __builtin_amdgcn_s_setprio(0); } while (0)
#define PG8_WAIT_V(n) asm volatile("s_waitcnt vmcnt(" #n ")" ::: "memory")
#define PG8_WAIT_L(n) asm volatile("s_waitcnt lgkmcnt(" #n ")" ::: "memory")
#define PG8_BAR __builtin_amdgcn_s_barrier()
#define PG8_SCHED __builtin_amdgcn_sched_barrier(0)
    Unit cur, nxt; int ui = 0;
    if (!S.next(0, cur)) return;
    f32x4 acc[2][2][4][2];
#pragma unroll
    for (int a = 0; a < 2; ++a)
#pragma unroll
        for (int b = 0; b < 2; ++b)
#pragma unroll
            for (int m = 0; m < 4; ++m)
#pragma unroll
                for (int n = 0; n < 2; ++n) acc[a][b][m][n] = (f32x4){0.f, 0.f, 0.f, 0.f};
    typedef int v4i_ __attribute__((ext_vector_type(4))); typedef int v8i_ __attribute__((ext_vector_type(8)));
    bf16x8 At[4][2], B0[2][2], B1[2][2]; v8i_ At8[4], B08[2], B18[2]; int one8_ = 0x7f7f7f7f; if constexpr (FP8) asm volatile("" : "+v"(one8_));
    const char* cA = (const char*)g.A + (size_t)cur.pm * tstep; const char* cB = (const char*)g.Bt + (size_t)cur.pn * tstep;
    S.a_ready(cur);
    if constexpr (SP2) {
        PG8_STAGE(PG8_SB(0, 0), cB, voffB); PG8_STAGE(PG8_SB(0, 1), cB + hstep, voffB); PG8_STAGE(PG8_SA(0, 0), cA, voffA); PG8_STAGE(PG8_SA(0, 1), cA + hstep, voffA);
        if (wr == 1) PG8_BAR;
        PG8_WAIT_V(2); PG8_BAR;
        PG8_STAGE(PG8_SB(1, 0), cB + kstep, voffB); PG8_STAGE(PG8_SA(1, 0), cA + kstep, voffA); PG8_STAGE(PG8_SB(1, 1), cB + hstep + kstep, voffB);
        PG8_WAIT_V(6); PG8_BAR;
    } else {
        PG8_STAGE(PG8_SB(0, 0), cB, voffB); PG8_STAGE(PG8_SA(0, 0), cA, voffA); PG8_STAGE(PG8_SB(0, 1), cB + hstep, voffB); PG8_STAGE(PG8_SA(0, 1), cA + hstep, voffA);
        if (wr == 1) PG8_BAR;
        PG8_WAIT_V(4); PG8_BAR;
        PG8_STAGE(PG8_SB(1, 0), cB + kstep, voffB); PG8_STAGE(PG8_SA(1, 0), cA + kstep, voffA); PG8_STAGE(PG8_SB(1, 1), cB + hstep + kstep, voffB);
        PG8_WAIT_V(6); PG8_BAR;
    }
    for (;;) {
        const bool has_next = S.next(ui + 1, nxt);
        const char* nA = has_next ? (const char*)g.A + (size_t)nxt.pm * tstep : cA; const char* nB = has_next ? (const char*)g.Bt + (size_t)nxt.pn * tstep : cB;
        for (int t = 0; t < nt; t += 2) {
            const bool last = (t == nt - 2);
            const char* a1 = cA + (size_t)(t + 1) * kstep;
            const char* a2 = last ? nA : cA + (size_t)(t + 2) * kstep; const char* b2 = last ? nB : cB + (size_t)(t + 2) * kstep;
            const char* a3 = a2 + kstep; const char* b3 = b2 + kstep;
            if (last && has_next) S.a_ready(nxt);
            if constexpr (SP2) {
            PG8_LDB(B0, 0, 0); PG8_LDB(B1, 0, 1); PG8_SCHED; PG8_LDA(At, 0, 0); PG8_STAGE(PG8_SA(1, 1), a1 + hstep, voffA);
            PG8_WAIT_V(8); PG8_WAIT_L(0); PG8_BAR; PG8_MMA(0, 0, At, B0); PG8_MMA(0, 1, At, B1); PG8_BAR; PG8_SCHED;
            PG8_LDA(At, 0, 1); PG8_STAGE(PG8_SB(0, 0), b2, voffB); PG8_STAGE(PG8_SB(0, 1), b2 + hstep, voffB); PG8_STAGE(PG8_SA(0, 0), a2, voffA);
            PG8_WAIT_V(8); PG8_WAIT_L(0); PG8_BAR; PG8_MMA(1, 0, At, B0); PG8_MMA(1, 1, At, B1); PG8_BAR; PG8_SCHED;
            PG8_LDB(B0, 1, 0); PG8_LDB(B1, 1, 1); PG8_SCHED; PG8_LDA(At, 1, 0); PG8_STAGE(PG8_SA(0, 1), a2 + hstep, voffA);
            PG8_WAIT_V(8); PG8_WAIT_L(0); PG8_BAR; PG8_MMA(0, 0, At, B0); PG8_MMA(0, 1, At, B1); PG8_BAR; PG8_SCHED;
            PG8_LDA(At, 1, 1); PG8_STAGE(PG8_SB(1, 0), b3, voffB); PG8_STAGE(PG8_SB(1, 1), b3 + hstep, voffB); PG8_STAGE(PG8_SA(1, 0), a3, voffA);
            PG8_WAIT_V(8); PG8_WAIT_L(0); PG8_BAR; PG8_MMA(1, 0, At, B0); PG8_MMA(1, 1, At, B1); PG8_BAR; PG8_SCHED;
            } else {
            PG8_LDB(B0, 0, 0); PG8_SCHED; PG8_LDA(At, 0, 0); PG8_STAGE(PG8_SA(1, 1), a1 + hstep, voffA);
            PG8_WAIT_L(8); PG8_BAR; PG8_WAIT_L(0); PG8_MMA(0, 0, At, B0); PG8_BAR; PG8_SCHED;
            PG8_LDB(B1, 0, 1); PG8_STAGE(PG8_SB(0, 0), b2, voffB);
            PG8_BAR; PG8_WAIT_L(0); PG8_MMA(0, 1, At, B1); PG8_BAR;
            PG8_LDA(At, 0, 1); PG8_STAGE(PG8_SA(0, 0), a2, voffA);
            PG8_BAR; PG8_WAIT_L(0); PG8_MMA(1, 0, At, B0); PG8_BAR; PG8_SCHED;
            PG8_STAGE(PG8_SB(0, 1), b2 + hstep, voffB);
            PG8_WAIT_V(6); PG8_BAR; PG8_MMA(1, 1, At, B1); PG8_BAR;
            PG8_LDB(B0, 1, 0); PG8_SCHED; PG8_LDA(At, 1, 0); PG8_STAGE(PG8_SA(0, 1), a2 + hstep, voffA);
            PG8_WAIT_L(8); PG8_BAR; PG8_WAIT_L(0); PG8_MMA(0, 0, At, B0); PG8_BAR; PG8_SCHED;
            PG8_LDB(B1, 1, 1); PG8_STAGE(PG8_SB(1, 0), b3, voffB);
            PG8_BAR; PG8_WAIT_L(0); PG8_MMA(0, 1, At, B1); PG8_BAR;
            PG8_LDA(At, 1, 1); PG8_STAGE(PG8_SA(1, 0), a3, voffA);
            PG8_BAR; PG8_WAIT_L(0); PG8_MMA(1, 0, At, B0); PG8_BAR; PG8_SCHED;
            PG8_STAGE(PG8_SB(1, 1), b3 + hstep, voffB);
            PG8_WAIT_V(6); PG8_BAR; PG8_MMA(1, 1, At, B1); PG8_BAR;
            }
        }
        if constexpr (ALIGN_EPI) { if (wr == 0) PG8_BAR; }
        if constexpr (FP8) {
            asm volatile("s_nop 15\n\ts_nop 15" ::: "memory");
#pragma unroll
            for (int a = 0; a < 2; ++a)
#pragma unroll
                for (int b = 0; b < 2; ++b) asm volatile("" : "+v"(acc[a][b][0][0]), "+v"(acc[a][b][0][1]), "+v"(acc[a][b][1][0]), "+v"(acc[a][b][1][1]), "+v"(acc[a][b][2][0]), "+v"(acc[a][b][2][1]), "+v"(acc[a][b][3][0]), "+v"(acc[a][b][3][1])); }
        if constexpr (!Epi::AFTER_DRAIN) { E(acc, cur, wr, wc, fr, fq); S.done(cur); }
        if (!has_next) break;
#pragma unroll
        for (int a = 0; a < 2; ++a)
#pragma unroll
            for (int b = 0; b < 2; ++b)
#pragma unroll
                for (int m = 0; m < 4; ++m)
#pragma unroll
                    for (int n = 0; n < 2; ++n) acc[a][b][m][n] = (f32x4){0.f, 0.f, 0.f, 0.f};
        cur = nxt; cA = nA; cB = nB; ++ui;
        if constexpr (ALIGN_EPI) { if (wr == 1) PG8_BAR; }
    }
    PG8_WAIT_V(0);
    if constexpr (!ALIGN_EPI) { if (wr == 0) PG8_BAR; }
    PG8_BAR;
    if constexpr (Epi::AFTER_DRAIN) { E.fused(acc, cur, wr, wc, fr, fq, lds, wid, lane); S.done(cur); }
#undef PG8_SA
#undef PG8_SB
#undef PG8_STAGE
#undef PG8_LDA
#undef PG8_LDB
#undef PG8_MMA
#undef PG8_WAIT_V
#undef PG8_WAIT_L
#undef PG8_BAR
#undef PG8_SCHED
}
}

#ifndef PG8_SP2
#define PG8_SP2 true
#endif
#ifndef PG8_ALIGN
#define PG8_ALIGN true
#endif
namespace pg8 {
template <class Epi, class Sched, bool ALIGN_EPI, bool FP8 = false>
__device__ __forceinline__ void gemm_phase_x(PG8_LAS unsigned char* lds, const char* Abase, const int K, const Sched& S, const Epi& E, const int tid0) {
    int tid_ = tid0; asm volatile("" : "+v"(tid_));
    const int tid = tid_, wid = __builtin_amdgcn_readfirstlane(tid >> 6), lane = tid & 63, wr = wid >> 2, wc = wid & 3, fr = lane & 15, fq = lane >> 4;
    int nt_ = K / BK; if constexpr (FP8) asm volatile("" : "+s"(nt_));
    const int nt = nt_;
    int RA[2]; unsigned CA[2], voffB[2];
#pragma unroll
    for (int i = 0; i < 2; ++i) { int R, C; stage_rc(tid * 16 + i * 8192, R, C); const int Rb = Epi::PERM ? ((R & ~31) + perm32(R & 31)) : R; RA[i] = R; CA[i] = (unsigned)C * 2u; voffB[i] = (unsigned)(Rb * K + C) * 2u; }
    const size_t kstep = (size_t)(BK * 2), hstep = (size_t)HALF * K * 2;
    const unsigned ldsw = (unsigned)wid * 1024u;
    const int aoff = lds_byte(wr * 64 + fr, fq * 8), boff = lds_byte(wc * 32 + fr, fq * 8);
#define PG8_SA(b, h) (((b) * 2 + (h)) * HTB)
#define PG8_SB(b, h) ((4 + (b) * 2 + (h)) * HTB)
#define PG8_STAGE(bufoff, gbase, voff) do { _Pragma("unroll") for (int _i = 0; _i < 2; ++_i) \
        __builtin_amdgcn_global_load_lds((const unsigned*)((const char*)(gbase) + (voff)[_i]), (PG8_LAS unsigned*)(lds + (bufoff) + ldsw + _i * 8192), 16, 0, 0); } while (0)
#define PG8_STAGE_A(bufoff, kb, VO) do { _Pragma("unroll") for (int _i = 0; _i < 2; ++_i) \
        __builtin_amdgcn_global_load_lds((const unsigned*)(Abase + (size_t)(kb) + (VO)[_i]), (PG8_LAS unsigned*)(lds + (bufoff) + ldsw + _i * 8192), 16, 0, 0); } while (0)
    constexpr bool GA = Sched::GATHER;
#define PG8_LDA(dst, b, h) do { _Pragma("unroll") for (int m = 0; m < 4; ++m) { if constexpr (FP8) { dst##8[m].lo = *(const PG8_LAS v4i_*)(lds + PG8_SA(b, h) + aoff + m * 2048); dst##8[m].hi = *(const PG8_LAS v4i_*)(lds + PG8_SA(b, h) + aoff + m * 2048 + 1024); } \
        else { _Pragma("unroll") for (int k = 0; k < 2; ++k) dst[m][k] = *(const PG8_LAS bf16x8*)(lds + PG8_SA(b, h) + aoff + m * 2048 + k * 1024); } } } while (0)
#define PG8_LDB(dst, b, h) do { _Pragma("unroll") for (int n = 0; n < 2; ++n) { if constexpr (FP8) { dst##8[n].lo = *(const PG8_LAS v4i_*)(lds + PG8_SB(b, h) + boff + n * 2048); dst##8[n].hi = *(const PG8_LAS v4i_*)(lds + PG8_SB(b, h) + boff + n * 2048 + 1024); } \
        else { _Pragma("unroll") for (int k = 0; k < 2; ++k) dst[n][k] = *(const PG8_LAS bf16x8*)(lds + PG8_SB(b, h) + boff + n * 2048 + k * 1024); } } } while (0)
#define PG8_MMA(ai, bj, At, Bt) do { __builtin_amdgcn_s_setprio(1); _Pragma("unroll") for (int m = 0; m < 4; ++m) _Pragma("unroll") for (int n = 0; n < 2; ++n) { \
        if constexpr (FP8) asm volatile("v_mfma_scale_f32_16x16x128_f8f6f4 %0, %1, %2, %0, %3, %3 op_sel_hi:[0,0,0]" : "+v"(acc[ai][bj][m][n]) : "v"(Bt##8[n]), "v"(At##8[m]), "v"(one8_)); \
        else { _Pragma("unroll") for (int k = 0; k < 2; ++k) acc[ai][bj][m][n] = __builtin_amdgcn_mfma_f32_16x16x32_bf16(Bt[n][k], At[m][k], acc[ai][bj][m][n], 0, 0, 0); } } __builtin_amdgcn_s_setprio(0); } while (0)
#define PG8_WAIT_V(n) asm volatile("s_waitcnt vmcnt(" #n ")" ::: "memory")
#define PG8_WAIT_L(n) asm volatile("s_waitcnt lgkmcnt(" #n ")" ::: "memory")
#define PG8_BAR __builtin_amdgcn_s_barrier()
#define PG8_SCHED __builtin_amdgcn_sched_barrier(0)
    typename Sched::U cur, nxt; int ui = 0;
    if (!S.next(0, cur)) return;
    f32x4 acc[2][2][4][2];
#pragma unroll
    for (int a = 0; a < 2; ++a)
#pragma unroll
        for (int b = 0; b < 2; ++b)
#pragma unroll
            for (int m = 0; m < 4; ++m)
#pragma unroll
                for (int n = 0; n < 2; ++n) acc[a][b][m][n] = (f32x4){0.f, 0.f, 0.f, 0.f};
    typedef int v4i_ __attribute__((ext_vector_type(4))); typedef int v8i_ __attribute__((ext_vector_type(8)));
    bf16x8 At[4][2], B0[2][2], B1[2][2]; v8i_ At8[4], B08[2], B18[2]; int one8_ = 0x7f7f7f7f; if constexpr (FP8) asm volatile("" : "+v"(one8_));
    unsigned cva[2][2], nva[2][2]; size_t cbase = GA ? (size_t)0 : S.a_base(cur), nbase = 0;
#pragma unroll
    for (int h = 0; h < 2; ++h)
#pragma unroll
        for (int i = 0; i < 2; ++i) { cva[h][i] = (GA ? S.a_off(cur, h * HALF + RA[i]) : (unsigned)(h * HALF + RA[i]) * (unsigned)S.rowbytes) + CA[i]; nva[h][i] = cva[h][i]; }
    const char* cB = S.b_ptr(cur);
    PG8_STAGE(PG8_SB(0, 0), cB, voffB); PG8_STAGE(PG8_SB(0, 1), cB + hstep, voffB); PG8_STAGE_A(PG8_SA(0, 0), cbase, cva[0]); PG8_STAGE_A(PG8_SA(0, 1), cbase, cva[1]);
    if (wr == 1) PG8_BAR;
    PG8_WAIT_V(2); PG8_BAR;
    PG8_STAGE(PG8_SB(1, 0), cB + kstep, voffB); PG8_STAGE_A(PG8_SA(1, 0), cbase + kstep, cva[0]); PG8_STAGE(PG8_SB(1, 1), cB + hstep + kstep, voffB);
    PG8_WAIT_V(6); PG8_BAR;
    for (;;) {
        const bool has_next = S.next(ui + 1, nxt);
        const char* nB = has_next ? S.b_ptr(nxt) : cB;
        if constexpr (GA) {
#pragma unroll
            for (int h = 0; h < 2; ++h)
#pragma unroll
                for (int i = 0; i < 2; ++i) nva[h][i] = has_next ? S.a_off(nxt, h * HALF + RA[i]) + CA[i] : cva[h][i];
        } else nbase = has_next ? S.a_base(nxt) : cbase;
        for (int t = 0; t < nt; t += 2) {
            const bool last = (t == nt - 2);
            const size_t k1 = cbase + (size_t)(t + 1) * kstep, k2 = last ? nbase : cbase + (size_t)(t + 2) * kstep, k3 = k2 + kstep;
            unsigned s2[2][2];
#pragma unroll
            for (int h = 0; h < 2; ++h)
#pragma unroll
                for (int i = 0; i < 2; ++i) s2[h][i] = (GA && last) ? nva[h][i] : cva[h][i];
            const char* b2 = last ? nB : cB + (size_t)(t + 2) * kstep; const char* b3 = b2 + kstep;
            PG8_LDB(B0, 0, 0); PG8_LDB(B1, 0, 1); PG8_SCHED; PG8_LDA(At, 0, 0); PG8_STAGE_A(PG8_SA(1, 1), k1, cva[1]);
            PG8_WAIT_V(8); PG8_WAIT_L(0); PG8_BAR; PG8_MMA(0, 0, At, B0); PG8_MMA(0, 1, At, B1); PG8_BAR; PG8_SCHED;
            PG8_LDA(At, 0, 1); PG8_STAGE(PG8_SB(0, 0), b2, voffB); PG8_STAGE(PG8_SB(0, 1), b2 + hstep, voffB); PG8_STAGE_A(PG8_SA(0, 0), k2, s2[0]);
            PG8_WAIT_V(8); PG8_WAIT_L(0); PG8_BAR; PG8_MMA(1, 0, At, B0); PG8_MMA(1, 1, At, B1); PG8_BAR; PG8_SCHED;
            PG8_LDB(B0, 1, 0); PG8_LDB(B1, 1, 1); PG8_SCHED; PG8_LDA(At, 1, 0); PG8_STAGE_A(PG8_SA(0, 1), k2, s2[1]);
            PG8_WAIT_V(8); PG8_WAIT_L(0); PG8_BAR; PG8_MMA(0, 0, At, B0); PG8_MMA(0, 1, At, B1); PG8_BAR; PG8_SCHED;
            PG8_LDA(At, 1, 1); PG8_STAGE(PG8_SB(1, 0), b3, voffB); PG8_STAGE(PG8_SB(1, 1), b3 + hstep, voffB); PG8_STAGE_A(PG8_SA(1, 0), k3, s2[0]);
            PG8_WAIT_V(8); PG8_WAIT_L(0); PG8_BAR; PG8_MMA(1, 0, At, B0); PG8_MMA(1, 1, At, B1); PG8_BAR; PG8_SCHED;
        }
        if constexpr (ALIGN_EPI) { if (wr == 0) PG8_BAR; }
        if constexpr (FP8) {
            asm volatile("s_nop 15\n\ts_nop 15" ::: "memory");
#pragma unroll
            for (int a = 0; a < 2; ++a)
#pragma unroll
                for (int b = 0; b < 2; ++b) asm volatile("" : "+v"(acc[a][b][0][0]), "+v"(acc[a][b][0][1]), "+v"(acc[a][b][1][0]), "+v"(acc[a][b][1][1]), "+v"(acc[a][b][2][0]), "+v"(acc[a][b][2][1]), "+v"(acc[a][b][3][0]), "+v"(acc[a][b][3][1])); }
        E(acc, cur, wr, wc, fr, fq);
        if (!has_next) break;
#pragma unroll
        for (int a = 0; a < 2; ++a)
#pragma unroll
            for (int b = 0; b < 2; ++b)
#pragma unroll
                for (int m = 0; m < 4; ++m)
#pragma unroll
                    for (int n = 0; n < 2; ++n) acc[a][b][m][n] = (f32x4){0.f, 0.f, 0.f, 0.f};
        cur = nxt; cB = nB; cbase = nbase; ++ui;
        if constexpr (GA) {
#pragma unroll
            for (int h = 0; h < 2; ++h)
#pragma unroll
                for (int i = 0; i < 2; ++i) cva[h][i] = nva[h][i]; }
        if constexpr (ALIGN_EPI) { if (wr == 1) PG8_BAR; }
    }
    PG8_WAIT_V(0);
    if constexpr (!ALIGN_EPI) { if (wr == 0) PG8_BAR; }
    PG8_BAR;
#undef PG8_SA
#undef PG8_SB
#undef PG8_STAGE
#undef PG8_STAGE_A
#undef PG8_LDA
#undef PG8_LDB
#undef PG8_MMA
#undef PG8_WAIT_V
#undef PG8_WAIT_L
#undef PG8_BAR
#undef PG8_SCHED
}
}
namespace pg8 {
template <class Epi, class Sched, bool ALIGN_EPI, bool FP8 = false>
__device__ __forceinline__ void gemm_phase_pair(PG8_LAS unsigned char* lds, const char* Abase, const Sched& S, const Epi& E, const int tid0) {
    int tid_ = tid0; asm volatile("" : "+v"(tid_));
    const int tid = tid_, wid = __builtin_amdgcn_readfirstlane(tid >> 6), lane = tid & 63, wr = wid >> 2, wc = wid & 3, fr = lane & 15, fq = lane >> 4;
    constexpr int KB = FP8 ? 128 : 256;
    constexpr int NH = FP8 ? 2 : 4;
    int RA[2]; unsigned CA[2], voffB[2];
#pragma unroll
    for (int i = 0; i < 2; ++i) { int R, C; stage_rc(tid * 16 + i * 8192, R, C); const int Rb = Epi::PERM ? ((R & ~31) + perm32(R & 31)) : R; RA[i] = R; CA[i] = (unsigned)C * 2u; voffB[i] = (unsigned)(Rb * KB + C) * 2u; }
    const size_t kstep = (size_t)(BK * 2), hstepB = (size_t)HALF * KB * 2;
    const unsigned ldsw = (unsigned)wid * 1024u;
    const int aoff = lds_byte(wr * 64 + fr, fq * 8), boff = lds_byte(wc * 32 + fr, fq * 8);
#define PG8_SA(b, h) (((b) * 2 + (h)) * HTB)
#define PG8_SB(b, h) ((4 + (b) * 2 + (h)) * HTB)
#define PG8_STAGE(bufoff, gbase, voff) do { _Pragma("unroll") for (int _i = 0; _i < 2; ++_i) \
        __builtin_amdgcn_global_load_lds((const unsigned*)((const char*)(gbase) + (voff)[_i]), (PG8_LAS unsigned*)(lds + (bufoff) + ldsw + _i * 8192), 16, 0, 0); } while (0)
#define PG8_STAGE_A(bufoff, kb, VO) do { _Pragma("unroll") for (int _i = 0; _i < 2; ++_i) \
        __builtin_amdgcn_global_load_lds((const unsigned*)(Abase + (size_t)(kb) + (VO)[_i]), (PG8_LAS unsigned*)(lds + (bufoff) + ldsw + _i * 8192), 16, 0, 0); } while (0)
#define PG8_LDA(dst, b, h) do { _Pragma("unroll") for (int m = 0; m < 4; ++m) { if constexpr (FP8) { dst##8[m].lo = *(const PG8_LAS v4i_*)(lds + PG8_SA(b, h) + aoff + m * 2048); dst##8[m].hi = *(const PG8_LAS v4i_*)(lds + PG8_SA(b, h) + aoff + m * 2048 + 1024); } \
        else { _Pragma("unroll") for (int k = 0; k < 2; ++k) dst[m][k] = *(const PG8_LAS bf16x8*)(lds + PG8_SA(b, h) + aoff + m * 2048 + k * 1024); } } } while (0)
#define PG8_LDB(dst, b, h) do { _Pragma("unroll") for (int n = 0; n < 2; ++n) { if constexpr (FP8) { dst##8[n].lo = *(const PG8_LAS v4i_*)(lds + PG8_SB(b, h) + boff + n * 2048); dst##8[n].hi = *(const PG8_LAS v4i_*)(lds + PG8_SB(b, h) + boff + n * 2048 + 1024); } \
        else { _Pragma("unroll") for (int k = 0; k < 2; ++k) dst[n][k] = *(const PG8_LAS bf16x8*)(lds + PG8_SB(b, h) + boff + n * 2048 + k * 1024); } } } while (0)
#define PG8_MMA(ai, bj, At, Bt) do { __builtin_amdgcn_s_setprio(1); _Pragma("unroll") for (int m = 0; m < 4; ++m) _Pragma("unroll") for (int n = 0; n < 2; ++n) { \
        if constexpr (FP8) asm volatile("v_mfma_scale_f32_16x16x128_f8f6f4 %0, %1, %2, %0, %3, %3 op_sel_hi:[0,0,0]" : "+v"(acc[ai][bj][m][n]) : "v"(Bt##8[n]), "v"(At##8[m]), "v"(one8_)); \
        else { _Pragma("unroll") for (int k = 0; k < 2; ++k) acc[ai][bj][m][n] = __builtin_amdgcn_mfma_f32_16x16x32_bf16(Bt[n][k], At[m][k], acc[ai][bj][m][n], 0, 0, 0); } } __builtin_amdgcn_s_setprio(0); } while (0)
#define PG8_WAIT_V(n) asm volatile("s_waitcnt vmcnt(" #n ")" ::: "memory")
#define PG8_WAIT_L(n) asm volatile("s_waitcnt lgkmcnt(" #n ")" ::: "memory")
#define PG8_BAR __builtin_amdgcn_s_barrier()
#define PG8_SCHED __builtin_amdgcn_sched_barrier(0)
#define PG8_LOADSET(dst, u, set) do { _Pragma("unroll") for (int _h = 0; _h < 2; ++_h) _Pragma("unroll") for (int _i = 0; _i < 2; ++_i) dst[_h][_i] = S.a_off(u, set, _h * HALF + RA[_i]) + CA[_i]; } while (0)
    typename Sched::U cur, nxt; int ui = 0;
    if (!S.next(0, cur)) return;
    f32x4 acc[2][2][4][2];
#pragma unroll
    for (int a = 0; a < 2; ++a)
#pragma unroll
        for (int b = 0; b < 2; ++b)
#pragma unroll
            for (int m = 0; m < 4; ++m)
#pragma unroll
                for (int n = 0; n < 2; ++n) acc[a][b][m][n] = (f32x4){0.f, 0.f, 0.f, 0.f};
    typedef int v4i_ __attribute__((ext_vector_type(4))); typedef int v8i_ __attribute__((ext_vector_type(8)));
    bf16x8 At[4][2], B0[2][2], B1[2][2]; v8i_ At8[4], B08[2], B18[2]; int one8_ = 0x7f7f7f7f; if constexpr (FP8) asm volatile("" : "+v"(one8_));
    unsigned va[2][2], vb[2][2];
    PG8_LOADSET(va, cur, 0); PG8_LOADSET(vb, cur, 1);
    const char* bLo = S.b_ptr(cur, 0); const char* bHi = S.b_ptr(cur, 1);
    PG8_STAGE(PG8_SB(0, 0), bLo, voffB); PG8_STAGE(PG8_SB(0, 1), bLo + hstepB, voffB); PG8_STAGE_A(PG8_SA(0, 0), 0, va[0]); PG8_STAGE_A(PG8_SA(0, 1), 0, va[1]);
    if (wr == 1) PG8_BAR;
    PG8_WAIT_V(2); PG8_BAR;
    PG8_STAGE(PG8_SB(1, 0), bLo + kstep, voffB); PG8_STAGE_A(PG8_SA(1, 0), kstep, va[0]); PG8_STAGE(PG8_SB(1, 1), bLo + hstepB + kstep, voffB);
    PG8_WAIT_V(6); PG8_BAR;
    for (;;) {
        const bool has_next = S.next(ui + 1, nxt);
        const char* nbLo = has_next ? S.b_ptr(nxt, 0) : bLo;
#pragma clang loop unroll(disable)
        for (int t = 0; t < 2 * NH; t += 2) { const bool last = t == 2 * NH - 2;
            if (t == NH - 2) PG8_LOADSET(vb, cur, 1);
            if (last) { if (has_next) PG8_LOADSET(va, nxt, 0); else PG8_LOADSET(va, cur, 0); }
            const bool xa = t + 1 < NH, ya = last || (t + 2 < NH);
            unsigned X1[2], Y0[2], Y1[2];
#pragma unroll
            for (int i = 0; i < 2; ++i) { X1[i] = xa ? va[1][i] : vb[1][i]; Y0[i] = ya ? va[0][i] : vb[0][i]; Y1[i] = ya ? va[1][i] : vb[1][i]; }
            const size_t kx = (size_t)((t + 1) & (NH - 1)) * kstep, ky2 = (size_t)((t + 2) & (NH - 1)) * kstep, ky3 = ky2 + kstep;
            const char* bY = last ? nbLo : (t + 2 < NH ? bLo : bHi); const char* b2 = bY + ky2; const char* b3 = b2 + kstep;
            PG8_LDB(B0, 0, 0); PG8_LDB(B1, 0, 1); PG8_SCHED; PG8_LDA(At, 0, 0); PG8_STAGE_A(PG8_SA(1, 1), kx, X1);
            PG8_WAIT_V(8); PG8_WAIT_L(0); PG8_BAR; PG8_MMA(0, 0, At, B0); PG8_MMA(0, 1, At, B1); PG8_BAR; PG8_SCHED;
            PG8_LDA(At, 0, 1); PG8_STAGE(PG8_SB(0, 0), b2, voffB); PG8_STAGE(PG8_SB(0, 1), b2 + hstepB, voffB); PG8_STAGE_A(PG8_SA(0, 0), ky2, Y0);
            PG8_WAIT_V(8); PG8_WAIT_L(0); PG8_BAR; PG8_MMA(1, 0, At, B0); PG8_MMA(1, 1, At, B1); PG8_BAR; PG8_SCHED;
            PG8_LDB(B0, 1, 0); PG8_LDB(B1, 1, 1); PG8_SCHED; PG8_LDA(At, 1, 0); PG8_STAGE_A(PG8_SA(0, 1), ky2, Y1);
            PG8_WAIT_V(8); PG8_WAIT_L(0); PG8_BAR; PG8_MMA(0, 0, At, B0); PG8_MMA(0, 1, At, B1); PG8_BAR; PG8_SCHED;
            PG8_LDA(At, 1, 1); PG8_STAGE(PG8_SB(1, 0), b3, voffB); PG8_STAGE(PG8_SB(1, 1), b3 + hstepB, voffB); PG8_STAGE_A(PG8_SA(1, 0), ky3, Y0);
            PG8_WAIT_V(8); PG8_WAIT_L(0); PG8_BAR; PG8_MMA(1, 0, At, B0); PG8_MMA(1, 1, At, B1); PG8_BAR; PG8_SCHED;
        }
        if constexpr (ALIGN_EPI) { if (wr == 0) PG8_BAR; }
        if constexpr (FP8) {
            asm volatile("s_nop 15\n\ts_nop 15" ::: "memory");
#pragma unroll
            for (int a = 0; a < 2; ++a)
#pragma unroll
                for (int b = 0; b < 2; ++b) asm volatile("" : "+v"(acc[a][b][0][0]), "+v"(acc[a][b][0][1]), "+v"(acc[a][b][1][0]), "+v"(acc[a][b][1][1]), "+v"(acc[a][b][2][0]), "+v"(acc[a][b][2][1]), "+v"(acc[a][b][3][0]), "+v"(acc[a][b][3][1])); }
        E(acc, cur, wr, wc, fr, fq);
        if (!has_next) break;
#pragma unroll
        for (int a = 0; a < 2; ++a)
#pragma unroll
            for (int b = 0; b < 2; ++b)
#pragma unroll
                for (int m = 0; m < 4; ++m)
#pragma unroll
                    for (int n = 0; n < 2; ++n) acc[a][b][m][n] = (f32x4){0.f, 0.f, 0.f, 0.f};
        cur = nxt; bLo = nbLo; bHi = S.b_ptr(cur, 1); ++ui;
        if constexpr (ALIGN_EPI) { if (wr == 1) PG8_BAR; }
    }
    PG8_WAIT_V(0);
    if constexpr (!ALIGN_EPI) { if (wr == 0) PG8_BAR; }
    PG8_BAR;
#undef PG8_SA
#undef PG8_SB
#undef PG8_STAGE
#undef PG8_STAGE_A
#undef PG8_LDA
#undef PG8_LDB
#undef PG8_MMA
#undef PG8_WAIT_V
#undef PG8_WAIT_L
#undef PG8_BAR
#undef PG8_SCHED
#undef PG8_LOADSET
}
}
#include <hip/hip_bf16.h>
#include <cmath>
namespace attn_body {
using bf16=__hip_bfloat16;
using bf16x8=__attribute__((ext_vector_type(8)))short;
using s16x4=__attribute__((ext_vector_type(4)))short;
using f32x16=__attribute__((ext_vector_type(16)))float;
using u32x4=__attribute__((ext_vector_type(4)))unsigned;
constexpr int SEQ=4096,D=64,PQ=512,PO=1024;
constexpr int NW=8,QBLK=32,QB=QBLK*NW,KVBLK=64,NQB=SEQ/QB;
constexpr int ATTN_UNIT_ROWS=QB;
__device__ __forceinline__ int crow(int r,int hi){return (r&3)+8*(r>>2)+4*hi;}
#define SBAR() __builtin_amdgcn_sched_barrier(0)
__device__ __forceinline__ void cmask(f32x16&p0,f32x16&p1,int jb,int qrel,int hi){
  const float NEG=-INFINITY; int kb=64*jb+4*hi;
  #pragma unroll
  for(int r=0;r<16;++r){int kv=kb+(r&3)+8*(r>>2); if(kv>qrel)p0[r]=NEG; if(kv+32>qrel)p1[r]=NEG;}
}

constexpr int NSLOT=3, SLOTB=8192;
constexpr int LDS_K=0, LDS_V=NSLOT*SLOTB, LDS_WS=2*NSLOT*SLOTB, LDS_OST=LDS_WS+NW*64*4, LDS_BYTES=LDS_OST+NW*4096;
constexpr float C2=0.125f*1.4426950408889634f;
__device__ __forceinline__ void glds16(const void*gsrc,unsigned lds_dst){unsigned keep;
  asm volatile("s_mov_b32 %0, m0\n\ts_mov_b32 m0, %2\n\ts_nop 0\n\tglobal_load_lds_dwordx4 %1, off\n\ts_mov_b32 m0, %0":"=&s"(keep):"v"(gsrc),"s"(lds_dst):"memory");}
__device__ __forceinline__ float max3f(float a,float b,float c){float r;asm("v_max3_f32 %0, %1, %2, %3":"=v"(r):"v"(a),"v"(b),"v"(c));return r;}
__device__ __forceinline__ float max2f(float a,float b){float r;asm("v_max_f32_e32 %0, %1, %2":"=v"(r):"v"(a),"v"(b));return r;}
__device__ __forceinline__ float fadd_s(float a,float b){float r;asm("v_add_f32_e32 %0, %1, %2":"=v"(r):"v"(a),"v"(b));return r;}
__device__ __forceinline__ float fsub_s(float a,float b){float r;asm("v_sub_f32_e32 %0, %1, %2":"=v"(r):"v"(a),"v"(b));return r;}
typedef float f32x2_t __attribute__((ext_vector_type(2))); typedef __bf16 bf16x2_t __attribute__((ext_vector_type(2)));
__device__ __forceinline__ unsigned cvtpk_s(float lo,float hi){f32x2_t v={lo,hi};bf16x2_t b=__builtin_convertvector(v,bf16x2_t);return __builtin_bit_cast(unsigned,b);}
#define WAIT_BAR(N) asm volatile("s_waitcnt vmcnt(" #N ") lgkmcnt(0)\n\ts_barrier":::"memory")

__device__ __forceinline__ void qkt(f32x16&p0,f32x16&p1,const char*Kslot,const bf16x8*qr,const f32x16&negm,int r32,int hi){
  const char*kb=Kslot+hi*1024+r32*16;
  #pragma unroll
  for(int d0=0;d0<4;++d0){
    const bf16x8 b0=*reinterpret_cast<const bf16x8*>(kb+d0*2048);
    const bf16x8 b1=*reinterpret_cast<const bf16x8*>(kb+d0*2048+512);
    if(d0==0){p0=__builtin_amdgcn_mfma_f32_32x32x16_bf16(b0,qr[0],negm,0,0,0);p1=__builtin_amdgcn_mfma_f32_32x32x16_bf16(b1,qr[0],negm,0,0,0);}
    else{p0=__builtin_amdgcn_mfma_f32_32x32x16_bf16(b0,qr[d0],p0,0,0,0);p1=__builtin_amdgcn_mfma_f32_32x32x16_bf16(b1,qr[d0],p1,0,0,0);}}
}
typedef __attribute__((address_space(3))) const char* lds_cptr;
typedef short v4i16_t __attribute__((ext_vector_type(4)));
__device__ __forceinline__ void kload8(bf16x8*kf,lds_cptr kp){
  kf[0]=*(const __attribute__((address_space(3))) bf16x8*)(kp);      kf[1]=*(const __attribute__((address_space(3))) bf16x8*)(kp+512);
  kf[2]=*(const __attribute__((address_space(3))) bf16x8*)(kp+2048); kf[3]=*(const __attribute__((address_space(3))) bf16x8*)(kp+2560);
  kf[4]=*(const __attribute__((address_space(3))) bf16x8*)(kp+4096); kf[5]=*(const __attribute__((address_space(3))) bf16x8*)(kp+4608);
  kf[6]=*(const __attribute__((address_space(3))) bf16x8*)(kp+6144); kf[7]=*(const __attribute__((address_space(3))) bf16x8*)(kp+6656);
}
__device__ __forceinline__ void kload2(bf16x8*kf,lds_cptr kp,int j){ kf[2*j]=*(const __attribute__((address_space(3))) bf16x8*)(kp+j*2048); kf[2*j+1]=*(const __attribute__((address_space(3))) bf16x8*)(kp+j*2048+512); }
__device__ __forceinline__ s16x4 vtr(lds_cptr p){ return __builtin_bit_cast(s16x4,__builtin_amdgcn_ds_read_tr16_b64_v4i16((__attribute__((address_space(3))) v4i16_t*)p)); }
__device__ __forceinline__ float rowmax(const f32x16&p0,const f32x16&p1){
  float a=max3f(p0[0],p0[1],p1[0]),b=max3f(p0[2],p0[3],p1[1]);a=max3f(a,p1[2],p1[3]);
  #pragma unroll
  for(int r=4;r<16;r+=4){a=max3f(a,p0[r],p0[r+1]);b=max3f(b,p0[r+2],p0[r+3]);a=max3f(a,p1[r],p1[r+1]);b=max3f(b,p1[r+2],p1[r+3]);}
  const float m=max2f(a,b);
  auto rr=__builtin_amdgcn_permlane32_swap(__float_as_uint(m),__float_as_uint(m),false,false);
  return max2f(__uint_as_float(rr[0]),__uint_as_float(rr[1]));
}
__device__ __forceinline__ void pv(f32x16*o,int vb,bf16x8 pa0,bf16x8 pa1,bf16x8 pa2,bf16x8 pa3){
  #pragma unroll
  for(int d0=0;d0<2;++d0){s16x4 lo[4],hi[4];
    #pragma unroll
    for(int ks=0;ks<4;++ks){
      asm volatile("ds_read_b64_tr_b16 %0,%1 offset:%c2":"=&v"(lo[ks]):"v"(vb),"i"(d0*4096+ks*1024):"memory");
      asm volatile("ds_read_b64_tr_b16 %0,%1 offset:%c2":"=&v"(hi[ks]):"v"(vb),"i"(d0*4096+ks*1024+512):"memory");}
    asm volatile("s_waitcnt lgkmcnt(0)":::"memory");SBAR();
    #define PK(k) (bf16x8){lo[k][0],lo[k][1],lo[k][2],lo[k][3],hi[k][0],hi[k][1],hi[k][2],hi[k][3]}
    o[d0]=__builtin_amdgcn_mfma_f32_32x32x16_bf16(pa0,PK(0),o[d0],0,0,0);
    o[d0]=__builtin_amdgcn_mfma_f32_32x32x16_bf16(pa1,PK(1),o[d0],0,0,0);
    o[d0]=__builtin_amdgcn_mfma_f32_32x32x16_bf16(pa2,PK(2),o[d0],0,0,0);
    o[d0]=__builtin_amdgcn_mfma_f32_32x32x16_bf16(pa3,PK(3),o[d0],0,0,0);
    #undef PK
  }
}

template<int THRL> __device__ __forceinline__ void attn_unit(long rowbase,int qb,const bf16*Qc,const bf16*__restrict__ Kc,const bf16*__restrict__ Vc,bf16*Oc,char*shm,const int tid0){
  int tid_=tid0; asm volatile("":"+v"(tid_)); const int tid=tid_,lane=tid&63,r32=lane&31,hi=lane>>5; const int wid=__builtin_amdgcn_readfirstlane(tid>>6);
  const int q0=qb*QB;
  const bf16*Qw=Qc+(rowbase+q0+wid*QBLK)*PQ;
  const bf16*Kh=Kc+rowbase*PQ,*Vh=Vc+rowbase*PQ;
  const unsigned lds0=(unsigned)(uintptr_t)shm;
  float*wsf=(float*)(shm+LDS_WS)+wid*64;
  const bf16*ksrc=Kh+(long)lane*PQ+wid*8;
  const bf16*vsrc=Vh+(long)(16*(wid&3)+(lane>>2))*PQ+(wid>>2)*32+(lane&3)*8;
  const unsigned kdst=lds0+LDS_K+wid*1024, vdst=lds0+LDS_V+wid*1024;
  #define DMA_K(t,slot) glds16(ksrc+(long)(t)*KVBLK*PQ,(unsigned)__builtin_amdgcn_readfirstlane(kdst+(slot)))
  #define DMA_V(t,slot) glds16(vsrc+(long)(t)*KVBLK*PQ,(unsigned)__builtin_amdgcn_readfirstlane(vdst+(slot)))
  const int vb0=(int)(lds0+LDS_V)+((lane>>4)&1)*32+(lane&3)*8+(4*hi+((lane&15)>>2))*64;
  const char*Kbase=shm+LDS_K; bf16x8 kf[8];
  const lds_cptr shm3=(lds_cptr)shm; const lds_cptr kp0=shm3+LDS_K+hi*1024+r32*16; const lds_cptr vp0=shm3+LDS_V+((lane>>4)&1)*32+(lane&3)*8+(4*hi+((lane&15)>>2))*64;
  const int NT=(q0+QB)/KVBLK;
  DMA_K(0,0);DMA_V(0,0);DMA_K(1,SLOTB);
  bf16x8 qr[4];
  #pragma unroll
  for(int d0=0;d0<4;++d0)qr[d0]=*reinterpret_cast<const bf16x8*>(&Qw[(long)r32*PQ+d0*16+hi*8]);
  float mhat=0.f,l_reg=0.f;float zsrc=0.f;asm volatile("":"+v"(zsrc));
  f32x16 o[2],negm;
  #pragma unroll
  for(int r=0;r<16;++r){o[0][r]=zsrc;o[1][r]=zsrc;negm[r]=zsrc;}
  asm volatile("":"+v"(negm));
  const int qrel=wid*QBLK+r32;
  #define CMASK(P0,P1,t) do{int jb_=(t)-(NT-4); if(jb_>=0)cmask(P0,P1,jb_,qrel,hi);}while(0)
  bool resc=false;
  #define START(P0,P1) do{ const float rm=rowmax(P0,P1); resc=false; \
    { const float dl=rm; mhat=fadd_s(mhat,dl); \
      _Pragma("unroll") for(int r=0;r<16;++r){P0[r]=fsub_s(P0[r],dl);P1[r]=fsub_s(P1[r],dl);} \
      _Pragma("unroll") for(int r=0;r<16;++r)negm[r]=-mhat; asm volatile("":"+v"(negm)); } \
    _Pragma("unroll") for(int r=0;r<16;++r)P0[r]=__builtin_amdgcn_exp2f(P0[r]); }while(0)
  #define RESC() do{ if(resc){ asm volatile("s_waitcnt lgkmcnt(0)":::"memory"); \
      _Pragma("unroll") for(int d_=0;d_<2;++d_) _Pragma("unroll") for(int r=0;r<16;++r)o[d_][r]*=wsf[crow(r,hi)]; } }while(0)
  f32x16 pA0,pA1,pB0,pB1;
  int sl_prev=0,sl_cur=0,sl_next=SLOTB;
  #define ROT() do{sl_prev=sl_cur;sl_cur=sl_next;sl_next=(sl_next==(NSLOT-1)*SLOTB)?0:sl_next+SLOTB;}while(0)
  DMA_K(2,2*SLOTB);
  WAIT_BAR(3);
  qkt(pA0,pA1,Kbase,qr,negm,r32,hi);asm volatile("s_nop 15\n\ts_nop 7":"+v"(pA0),"+v"(pA1));CMASK(pA0,pA1,0);
  START(pA0,pA1);
  _Pragma("unroll") for(int r=0;r<16;++r)pA1[r]=__builtin_amdgcn_exp2f(pA1[r]);
  WAIT_BAR(0);
  DMA_K(3,0);DMA_V(1,SLOTB);
  ROT();
  kload8(kf,kp0+sl_cur);
  WAIT_BAR(2);
  s16x4 vlo[8],vhi[8]; u32x4 pw0,pw1,pw2,pw3;
  #define PKW(P,B) cvtpk_s(P[B],P[B+1])
  #define PAF(k) __builtin_bit_cast(bf16x8,pw##k)
  #define VFR(i) (bf16x8){vlo[i][0],vlo[i][1],vlo[i][2],vlo[i][3],vhi[i][0],vhi[i][1],vhi[i][2],vhi[i][3]}
  #define PIN(x) asm volatile("":"+v"(x))
  #define MX3(a,b,c) __builtin_fmaxf(__builtin_fmaxf((a),(b)),(c))
  #define GAPA(MF,A0,A1,A2,A3,W0,W1,PW) do{ MF; sacc+=A0; sacc+=A1; sacc+=A2; sacc+=A3; PIN(sacc); W0; W1; PIN(PW); SBAR(); }while(0)
  #define EX(v) __builtin_amdgcn_exp2f(v)
  #define GAPB(MF,X,B) do{ MF; X[B]=EX(X[B]); X[B+1]=EX(X[B+1]); X[B+2]=EX(X[B+2]); X[B+3]=EX(X[B+3]); PIN(X); SBAR(); }while(0)
  #define VRD(i) do{ vlo[i]=vtr(vp_+(((i)>>2)*4096+((i)&3)*1024)); vhi[i]=vtr(vp_+(((i)>>2)*4096+((i)&3)*1024+512)); }while(0)
  #define KRD(G,j) do{ if(G){ kload2(kf,kp0+sl_next,j); SBAR(); } }while(0)
  #define STEP(C0,C1,P0,P1,t,GK,GV,GL) do{ SBAR(); \
    const lds_cptr vp_=vp0+sl_prev; \
    VRD(0); SBAR(); float sacc=(P0[0]+P0[1]); \
    GAPA(C0=__builtin_amdgcn_mfma_f32_32x32x16_bf16(kf[0],qr[0],negm,0,0,0), P0[2],P0[3],P0[4],P0[5],     pw0[0]=PKW(P0,0), pw0[1]=PKW(P0,2), pw0); \
    VRD(4); SBAR(); GAPA(C1=__builtin_amdgcn_mfma_f32_32x32x16_bf16(kf[1],qr[0],negm,0,0,0), P0[6],P0[7],P0[8],P0[9],     pw0[2]=PKW(P0,4), pw0[3]=PKW(P0,6), pw0); \
    VRD(1); SBAR(); GAPA(C0=__builtin_amdgcn_mfma_f32_32x32x16_bf16(kf[2],qr[1],C0,0,0,0),   P0[10],P0[11],P0[12],P0[13], pw1[0]=PKW(P0,8), pw1[1]=PKW(P0,10), pw1); \
    VRD(5); SBAR(); GAPA(C1=__builtin_amdgcn_mfma_f32_32x32x16_bf16(kf[3],qr[1],C1,0,0,0),   P0[14],P0[15],P1[0],P1[1],   pw1[2]=PKW(P0,12),pw1[3]=PKW(P0,14), pw1); \
    VRD(2); SBAR(); GAPA(C0=__builtin_amdgcn_mfma_f32_32x32x16_bf16(kf[4],qr[2],C0,0,0,0),   P1[2],P1[3],P1[4],P1[5],     pw2[0]=PKW(P1,0), pw2[1]=PKW(P1,2), pw2); \
    VRD(6); SBAR(); GAPA(C1=__builtin_amdgcn_mfma_f32_32x32x16_bf16(kf[5],qr[2],C1,0,0,0),   P1[6],P1[7],P1[8],P1[9],     pw2[2]=PKW(P1,4), pw2[3]=PKW(P1,6), pw2); \
    VRD(3); SBAR(); GAPA(C0=__builtin_amdgcn_mfma_f32_32x32x16_bf16(kf[6],qr[3],C0,0,0,0),   P1[10],P1[11],P1[12],P1[13], pw3[0]=PKW(P1,8), pw3[1]=PKW(P1,10), pw3); \
    VRD(7); SBAR(); GAPA(C1=__builtin_amdgcn_mfma_f32_32x32x16_bf16(kf[7],qr[3],C1,0,0,0),   P1[14],P1[15],0.f,0.f,       pw3[2]=PKW(P1,12),pw3[3]=PKW(P1,14), pw3); \
    l_reg+=sacc; \
    if(GK){DMA_K((t)+3,sl_cur);} if(GV){DMA_V((t)+1,sl_next);} \
    CMASK(C0,C1,t); \
    { float a=MX3(C0[0],C0[1],C1[0]),b=MX3(C0[2],C0[3],C1[1]); a=MX3(a,C1[2],C1[3]); \
      _Pragma("unroll") for(int r=4;r<16;r+=4){a=MX3(a,C0[r],C0[r+1]);b=MX3(b,C0[r+2],C0[r+3]);a=MX3(a,C1[r],C1[r+1]);b=MX3(b,C1[r+2],C1[r+3]);} \
      float rm=__builtin_fmaxf(a,b); { auto rr=__builtin_amdgcn_permlane32_swap(__float_as_uint(rm),__float_as_uint(rm),false,false); rm=__builtin_fmaxf(__uint_as_float(rr[0]),__uint_as_float(rr[1])); } \
      resc=false; \
      if(__builtin_expect(__any(rm>(float)THRL),0)){ const float dl=__builtin_fmaxf(rm,0.f); mhat+=dl; \
        _Pragma("unroll") for(int r=0;r<16;++r){C0[r]-=dl;C1[r]-=dl;} \
        _Pragma("unroll") for(int r=0;r<16;++r)negm[r]=-mhat; asm volatile("":"+v"(negm)); \
        const float f=__builtin_amdgcn_exp2f(-dl); l_reg*=f; if(hi==0)wsf[r32]=f; resc=true; } } \
    SBAR(); \
    GAPB(o[0]=__builtin_amdgcn_mfma_f32_32x32x16_bf16(PAF(0),VFR(0),o[0],0,0,0), C0,0); \
    GAPB(o[1]=__builtin_amdgcn_mfma_f32_32x32x16_bf16(PAF(0),VFR(4),o[1],0,0,0), C0,4); \
    KRD(GL,0); GAPB(o[0]=__builtin_amdgcn_mfma_f32_32x32x16_bf16(PAF(1),VFR(1),o[0],0,0,0), C0,8); \
    KRD(GL,1); GAPB(o[1]=__builtin_amdgcn_mfma_f32_32x32x16_bf16(PAF(1),VFR(5),o[1],0,0,0), C0,12); \
    KRD(GL,2); GAPB(o[0]=__builtin_amdgcn_mfma_f32_32x32x16_bf16(PAF(2),VFR(2),o[0],0,0,0), C1,0); \
    KRD(GL,3); GAPB(o[1]=__builtin_amdgcn_mfma_f32_32x32x16_bf16(PAF(2),VFR(6),o[1],0,0,0), C1,4); \
    GAPB(o[0]=__builtin_amdgcn_mfma_f32_32x32x16_bf16(PAF(3),VFR(3),o[0],0,0,0), C1,8); \
    GAPB(o[1]=__builtin_amdgcn_mfma_f32_32x32x16_bf16(PAF(3),VFR(7),o[1],0,0,0), C1,12); \
    }while(0)
  int t=1;
  #undef CMASK
  #define CMASK(P0,P1,t) do{}while(0)
  for(;t+5<NT;t+=2){
    STEP(pB0,pB1,pA0,pA1,t,true,true,true);     WAIT_BAR(2); RESC(); ROT();
    STEP(pA0,pA1,pB0,pB1,t+1,true,true,true);   WAIT_BAR(2); RESC(); ROT();
  }
  #undef CMASK
  #define CMASK(P0,P1,t) do{int jb_=(t)-(NT-4); if(jb_>=0)cmask(P0,P1,jb_,qrel,hi);}while(0)
  #define ENDW(tt) do{ if((tt)+3<NT){WAIT_BAR(2);} else if((tt)+2<NT){WAIT_BAR(1);} else {WAIT_BAR(0);} }while(0)
  for(;t+1<NT;t+=2){
    STEP(pB0,pB1,pA0,pA1,t,(t+3<NT),(t+1<NT),(t+1<NT));       ENDW(t);   RESC(); ROT();
    STEP(pA0,pA1,pB0,pB1,t+1,(t+4<NT),(t+2<NT),(t+2<NT));     ENDW(t+1); RESC(); ROT();
  }
  STEP(pB0,pB1,pA0,pA1,NT-1,false,false,false); RESC();
  { float sacc=pB0[0]+pB0[1]; _Pragma("unroll") for(int r=2;r<16;++r)sacc+=pB0[r]; _Pragma("unroll") for(int r=0;r<16;++r)sacc+=pB1[r]; l_reg+=sacc;
    pw0=(u32x4){PKW(pB0,0),PKW(pB0,2),PKW(pB0,4),PKW(pB0,6)};pw1=(u32x4){PKW(pB0,8),PKW(pB0,10),PKW(pB0,12),PKW(pB0,14)};pw2=(u32x4){PKW(pB1,0),PKW(pB1,2),PKW(pB1,4),PKW(pB1,6)};pw3=(u32x4){PKW(pB1,8),PKW(pB1,10),PKW(pB1,12),PKW(pB1,14)};
    SBAR(); pv(o,vb0+sl_cur,PAF(0),PAF(1),PAF(2),PAF(3)); }
  #undef PKW
  #undef PAF
  #undef VFR
  #undef PIN
  #undef MX3
  #undef GAPA
  #undef GAPB
  #undef EX
  #undef VRD
  #undef KRD
  #undef STEP
  #undef ENDW
  {auto rr=__builtin_amdgcn_permlane32_swap(__float_as_uint(l_reg),__float_as_uint(l_reg),false,false);l_reg=__uint_as_float(rr[0])+__uint_as_float(rr[1]);}
  if(hi==0)wsf[32+r32]=l_reg;asm volatile("s_waitcnt lgkmcnt(0)":::"memory");
  float rli[16];
  #pragma unroll
  for(int r=0;r<16;++r)rli[r]=__builtin_amdgcn_rcpf(wsf[32+crow(r,hi)]);
  bf16*Ow=Oc+(rowbase+q0+wid*QBLK)*PO;
  { bf16*stg=(bf16*)(shm+LDS_OST)+wid*2048;
    #pragma unroll
    for(int r=0;r<16;++r){const int orow=crow(r,hi);
      #pragma unroll
      for(int d0=0;d0<2;++d0)stg[orow*64+d0*32+r32]=__float2bfloat16(o[d0][r]*rli[r]);}
    asm volatile("s_waitcnt lgkmcnt(0)":::"memory");
    #pragma unroll
    for(int i=0;i<4;++i){const int row=i*8+(lane>>3),ch=lane&7; const u32x4 v=*(const u32x4*)(stg+row*64+ch*8); ATTN_STORE16(Ow+(long)row*PO+ch*8,v);} }
  asm volatile("s_waitcnt lgkmcnt(0)\n\ts_barrier":::"memory");
  #undef DMA_K
  #undef DMA_V
  #undef CMASK
  #undef START
  #undef RESC
  #undef ROT
}
__device__ __forceinline__ void pv128(f32x16*o,int vb,bf16x8 pa0,bf16x8 pa1,bf16x8 pa2,bf16x8 pa3){
  #pragma unroll
  for(int d0=0;d0<4;++d0){s16x4 lo[4],hi[4];
    #pragma unroll
    for(int ks=0;ks<4;++ks){
      asm volatile("ds_read_b64_tr_b16 %0,%1 offset:%c2":"=&v"(lo[ks]):"v"(vb),"i"(d0*4096+ks*1024):"memory");
      asm volatile("ds_read_b64_tr_b16 %0,%1 offset:%c2":"=&v"(hi[ks]):"v"(vb),"i"(d0*4096+ks*1024+512):"memory");}
    asm volatile("s_waitcnt lgkmcnt(0)":::"memory");SBAR();
    #define PK(k) (bf16x8){lo[k][0],lo[k][1],lo[k][2],lo[k][3],hi[k][0],hi[k][1],hi[k][2],hi[k][3]}
    o[d0]=__builtin_amdgcn_mfma_f32_32x32x16_bf16(pa0,PK(0),o[d0],0,0,0);
    o[d0]=__builtin_amdgcn_mfma_f32_32x32x16_bf16(pa1,PK(1),o[d0],0,0,0);
    o[d0]=__builtin_amdgcn_mfma_f32_32x32x16_bf16(pa2,PK(2),o[d0],0,0,0);
    o[d0]=__builtin_amdgcn_mfma_f32_32x32x16_bf16(pa3,PK(3),o[d0],0,0,0);
    #undef PK
  }
}
constexpr int SLOTBV=16384, LDS_V2=NSLOT*SLOTB, LDS_WS2=LDS_V2+NSLOT*SLOTBV, LDS_OST2=LDS_WS2+NW*64*4, LDS_BYTES2=LDS_OST2+NW*4096;
template<int THRL> __device__ __forceinline__ void attn_unit128(long rowbase,int qb,const bf16*Qc,const bf16*__restrict__ Kc,const bf16*__restrict__ Vc,bf16*Oc,char*shm,const int tid0){
  int tid_=tid0; asm volatile("":"+v"(tid_)); const int tid=tid_,lane=tid&63,r32=lane&31,hi=lane>>5; const int wid=__builtin_amdgcn_readfirstlane(tid>>6);
  const int q0=qb*QB;
  const bf16*Qw=Qc+(rowbase+q0+wid*QBLK)*PQ;
  const bf16*Kh=Kc+rowbase*PQ,*Vh=Vc+rowbase*PQ;
  const unsigned lds0=(unsigned)(uintptr_t)shm;
  float*wsf=(float*)(shm+LDS_WS2)+wid*64;
  const bf16*ksrc=Kh+(long)lane*PQ+wid*8;
  const bf16*vsrc=Vh+(long)(16*(wid&3)+(lane>>2))*PQ+(wid>>2)*32+(lane&3)*8;
  const unsigned kdst=lds0+LDS_K+wid*1024, vdst=lds0+LDS_V2+wid*1024;
  #define DMA_K(t,slot) glds16(ksrc+(long)(t)*KVBLK*PQ,(unsigned)__builtin_amdgcn_readfirstlane(kdst+(slot)))
  #define DMA_V(t,slot) do{ glds16(vsrc+(long)(t)*KVBLK*PQ,(unsigned)__builtin_amdgcn_readfirstlane(vdst+2*(slot))); glds16(vsrc+64+(long)(t)*KVBLK*PQ,(unsigned)__builtin_amdgcn_readfirstlane(vdst+8192+2*(slot))); }while(0)
  const char*Kbase=shm+LDS_K; bf16x8 kf[8];
  const lds_cptr shm3=(lds_cptr)shm; const lds_cptr kp0=shm3+LDS_K+hi*1024+r32*16; const lds_cptr vp0=shm3+LDS_V2+((lane>>4)&1)*32+(lane&3)*8+(4*hi+((lane&15)>>2))*64;
  const int NT=(q0+QB)/KVBLK;
  DMA_K(0,0);DMA_V(0,0);DMA_K(1,SLOTB);
  bf16x8 qr[4];
  #pragma unroll
  for(int d0=0;d0<4;++d0)qr[d0]=*reinterpret_cast<const bf16x8*>(&Qw[(long)r32*PQ+d0*16+hi*8]);
  float mhat=0.f,l_reg=0.f;float zsrc=0.f;asm volatile("":"+v"(zsrc));
  f32x16 o[4],negm;
  #pragma unroll
  for(int r=0;r<16;++r){o[0][r]=zsrc;o[1][r]=zsrc;o[2][r]=zsrc;o[3][r]=zsrc;negm[r]=zsrc;}
  asm volatile("":"+v"(negm));
  #define CMASK(P0,P1,t) do{int jb_=(t)-(NT-4); if(jb_>=0)cmask(P0,P1,jb_,wid*QBLK+r32,hi);}while(0)
  bool resc=false;
  #define START(P0,P1) do{ const float rm=rowmax(P0,P1); resc=false; \
    { const float dl=rm; mhat=fadd_s(mhat,dl); \
      _Pragma("unroll") for(int r=0;r<16;++r){P0[r]=fsub_s(P0[r],dl);P1[r]=fsub_s(P1[r],dl);} \
      _Pragma("unroll") for(int r=0;r<16;++r)negm[r]=-mhat; asm volatile("":"+v"(negm)); } \
    _Pragma("unroll") for(int r=0;r<16;++r)P0[r]=__builtin_amdgcn_exp2f(P0[r]); }while(0)
  #define RESC() do{ if(resc){ asm volatile("s_waitcnt lgkmcnt(0)":::"memory"); \
      _Pragma("unroll") for(int d_=0;d_<4;++d_) _Pragma("unroll") for(int r=0;r<16;++r)o[d_][r]*=wsf[crow(r,hi)]; } }while(0)
  f32x16 pA0,pA1,pB0,pB1;
  int sl_prev=0,sl_cur=0,sl_next=SLOTB;
  #define ROT() do{sl_prev=sl_cur;sl_cur=sl_next;sl_next=(sl_next==(NSLOT-1)*SLOTB)?0:sl_next+SLOTB;}while(0)
  DMA_K(2,2*SLOTB);
  WAIT_BAR(3);
  qkt(pA0,pA1,Kbase,qr,negm,r32,hi);asm volatile("s_nop 15\n\ts_nop 7":"+v"(pA0),"+v"(pA1));CMASK(pA0,pA1,0);
  START(pA0,pA1);
  _Pragma("unroll") for(int r=0;r<16;++r)pA1[r]=__builtin_amdgcn_exp2f(pA1[r]);
  WAIT_BAR(0);
  DMA_K(3,0);DMA_V(1,SLOTB);
  ROT();
  kload8(kf,kp0+sl_cur);
  WAIT_BAR(3);
  s16x4 vlo[8],vhi[8]; u32x4 pw0,pw1,pw2,pw3;
  #define PKW(P,B) cvtpk_s(P[B],P[B+1])
  #define PAF(k) __builtin_bit_cast(bf16x8,pw##k)
  #define VFR(i) (bf16x8){vlo[i][0],vlo[i][1],vlo[i][2],vlo[i][3],vhi[i][0],vhi[i][1],vhi[i][2],vhi[i][3]}
  #define PIN(x) asm volatile("":"+v"(x))
  #define MX3(a,b,c) __builtin_fmaxf(__builtin_fmaxf((a),(b)),(c))
  #define GAPA(MF,A0,A1,A2,A3,W0,W1,PW) do{ MF; sacc+=A0; sacc+=A1; sacc+=A2; sacc+=A3; PIN(sacc); W0; W1; PIN(PW); SBAR(); }while(0)
  #define EX(v) __builtin_amdgcn_exp2f(v)
  #define GAPB(MF,X,B) do{ MF; X[B]=EX(X[B]); X[B+1]=EX(X[B+1]); X[B+2]=EX(X[B+2]); X[B+3]=EX(X[B+3]); PIN(X); SBAR(); }while(0)
  #define GAPB2(MF,X,B) do{ MF; X[B]=EX(X[B]); X[B+1]=EX(X[B+1]); PIN(X); SBAR(); }while(0)
  #define VRD2(i) do{ vlo[i]=vtr(vp_+((((i)>>2)+2)*4096+((i)&3)*1024)); vhi[i]=vtr(vp_+((((i)>>2)+2)*4096+((i)&3)*1024+512)); }while(0)
  #define VRD(i) do{ vlo[i]=vtr(vp_+(((i)>>2)*4096+((i)&3)*1024)); vhi[i]=vtr(vp_+(((i)>>2)*4096+((i)&3)*1024+512)); }while(0)
  #define KRD(G,j) do{ if(G){ kload2(kf,kp0+sl_next,j); SBAR(); } }while(0)
  #define STEP(C0,C1,P0,P1,t,GK,GV,GL) do{ SBAR(); \
    const lds_cptr vp_=vp0+2*sl_prev; \
    VRD(0); SBAR(); float sacc=(P0[0]+P0[1]); \
    GAPA(C0=__builtin_amdgcn_mfma_f32_32x32x16_bf16(kf[0],qr[0],negm,0,0,0), P0[2],P0[3],P0[4],P0[5],     pw0[0]=PKW(P0,0), pw0[1]=PKW(P0,2), pw0); \
    VRD(4); SBAR(); GAPA(C1=__builtin_amdgcn_mfma_f32_32x32x16_bf16(kf[1],qr[0],negm,0,0,0), P0[6],P0[7],P0[8],P0[9],     pw0[2]=PKW(P0,4), pw0[3]=PKW(P0,6), pw0); \
    VRD(1); SBAR(); GAPA(C0=__builtin_amdgcn_mfma_f32_32x32x16_bf16(kf[2],qr[1],C0,0,0,0),   P0[10],P0[11],P0[12],P0[13], pw1[0]=PKW(P0,8), pw1[1]=PKW(P0,10), pw1); \
    VRD(5); SBAR(); GAPA(C1=__builtin_amdgcn_mfma_f32_32x32x16_bf16(kf[3],qr[1],C1,0,0,0),   P0[14],P0[15],P1[0],P1[1],   pw1[2]=PKW(P0,12),pw1[3]=PKW(P0,14), pw1); \
    VRD(2); SBAR(); GAPA(C0=__builtin_amdgcn_mfma_f32_32x32x16_bf16(kf[4],qr[2],C0,0,0,0),   P1[2],P1[3],P1[4],P1[5],     pw2[0]=PKW(P1,0), pw2[1]=PKW(P1,2), pw2); \
    VRD(6); SBAR(); GAPA(C1=__builtin_amdgcn_mfma_f32_32x32x16_bf16(kf[5],qr[2],C1,0,0,0),   P1[6],P1[7],P1[8],P1[9],     pw2[2]=PKW(P1,4), pw2[3]=PKW(P1,6), pw2); \
    VRD(3); SBAR(); GAPA(C0=__builtin_amdgcn_mfma_f32_32x32x16_bf16(kf[6],qr[3],C0,0,0,0),   P1[10],P1[11],P1[12],P1[13], pw3[0]=PKW(P1,8), pw3[1]=PKW(P1,10), pw3); \
    VRD(7); SBAR(); GAPA(C1=__builtin_amdgcn_mfma_f32_32x32x16_bf16(kf[7],qr[3],C1,0,0,0),   P1[14],P1[15],0.f,0.f,       pw3[2]=PKW(P1,12),pw3[3]=PKW(P1,14), pw3); \
    l_reg+=sacc; \
    if(GK){DMA_K((t)+3,sl_cur);} if(GV){DMA_V((t)+1,sl_next);} \
    CMASK(C0,C1,t); \
    { float a=MX3(C0[0],C0[1],C1[0]),b=MX3(C0[2],C0[3],C1[1]); a=MX3(a,C1[2],C1[3]); \
      _Pragma("unroll") for(int r=4;r<16;r+=4){a=MX3(a,C0[r],C0[r+1]);b=MX3(b,C0[r+2],C0[r+3]);a=MX3(a,C1[r],C1[r+1]);b=MX3(b,C1[r+2],C1[r+3]);} \
      float rm=__builtin_fmaxf(a,b); { auto rr=__builtin_amdgcn_permlane32_swap(__float_as_uint(rm),__float_as_uint(rm),false,false); rm=__builtin_fmaxf(__uint_as_float(rr[0]),__uint_as_float(rr[1])); } \
      resc=false; \
      if(__builtin_expect(__any(rm>(float)THRL),0)){ const float dl=__builtin_fmaxf(rm,0.f); mhat+=dl; \
        _Pragma("unroll") for(int r=0;r<16;++r){C0[r]-=dl;C1[r]-=dl;} \
        _Pragma("unroll") for(int r=0;r<16;++r)negm[r]=-mhat; asm volatile("":"+v"(negm)); \
        const float f=__builtin_amdgcn_exp2f(-dl); l_reg*=f; if(hi==0)wsf[r32]=f; resc=true; } } \
    SBAR(); \
    GAPB2(o[0]=__builtin_amdgcn_mfma_f32_32x32x16_bf16(PAF(0),VFR(0),o[0],0,0,0), C0,0); VRD2(0); SBAR(); \
    GAPB2(o[1]=__builtin_amdgcn_mfma_f32_32x32x16_bf16(PAF(0),VFR(4),o[1],0,0,0), C0,2); VRD2(4); SBAR(); \
    KRD(GL,0); GAPB2(o[0]=__builtin_amdgcn_mfma_f32_32x32x16_bf16(PAF(1),VFR(1),o[0],0,0,0), C0,4); VRD2(1); SBAR(); \
    KRD(GL,1); GAPB2(o[1]=__builtin_amdgcn_mfma_f32_32x32x16_bf16(PAF(1),VFR(5),o[1],0,0,0), C0,6); VRD2(5); SBAR(); \
    KRD(GL,2); GAPB2(o[0]=__builtin_amdgcn_mfma_f32_32x32x16_bf16(PAF(2),VFR(2),o[0],0,0,0), C0,8); VRD2(2); SBAR(); \
    KRD(GL,3); GAPB2(o[1]=__builtin_amdgcn_mfma_f32_32x32x16_bf16(PAF(2),VFR(6),o[1],0,0,0), C0,10); VRD2(6); SBAR(); \
    GAPB2(o[0]=__builtin_amdgcn_mfma_f32_32x32x16_bf16(PAF(3),VFR(3),o[0],0,0,0), C0,12); VRD2(3); SBAR(); \
    GAPB2(o[1]=__builtin_amdgcn_mfma_f32_32x32x16_bf16(PAF(3),VFR(7),o[1],0,0,0), C0,14); VRD2(7); SBAR(); \
    GAPB2(o[2]=__builtin_amdgcn_mfma_f32_32x32x16_bf16(PAF(0),VFR(0),o[2],0,0,0), C1,0); \
    GAPB2(o[3]=__builtin_amdgcn_mfma_f32_32x32x16_bf16(PAF(0),VFR(4),o[3],0,0,0), C1,2); \
    GAPB2(o[2]=__builtin_amdgcn_mfma_f32_32x32x16_bf16(PAF(1),VFR(1),o[2],0,0,0), C1,4); \
    GAPB2(o[3]=__builtin_amdgcn_mfma_f32_32x32x16_bf16(PAF(1),VFR(5),o[3],0,0,0), C1,6); \
    GAPB2(o[2]=__builtin_amdgcn_mfma_f32_32x32x16_bf16(PAF(2),VFR(2),o[2],0,0,0), C1,8); \
    GAPB2(o[3]=__builtin_amdgcn_mfma_f32_32x32x16_bf16(PAF(2),VFR(6),o[3],0,0,0), C1,10); \
    GAPB2(o[2]=__builtin_amdgcn_mfma_f32_32x32x16_bf16(PAF(3),VFR(3),o[2],0,0,0), C1,12); \
    GAPB2(o[3]=__builtin_amdgcn_mfma_f32_32x32x16_bf16(PAF(3),VFR(7),o[3],0,0,0), C1,14); \
    }while(0)
  int t=1;
  #undef CMASK
  #define CMASK(P0,P1,t) do{}while(0)
  for(;t+5<NT;t+=2){
    STEP(pB0,pB1,pA0,pA1,t,true,true,true);     WAIT_BAR(3); RESC(); ROT();
    STEP(pA0,pA1,pB0,pB1,t+1,true,true,true);   WAIT_BAR(3); RESC(); ROT();
  }
  #undef CMASK
  #define CMASK(P0,P1,t) do{int jb_=(t)-(NT-4); if(jb_>=0)cmask(P0,P1,jb_,wid*QBLK+r32,hi);}while(0)
  #define ENDW(tt) do{ if((tt)+3<NT){WAIT_BAR(3);} else if((tt)+2<NT){WAIT_BAR(2);} else {WAIT_BAR(0);} }while(0)
  for(;t+1<NT;t+=2){
    STEP(pB0,pB1,pA0,pA1,t,(t+3<NT),(t+1<NT),(t+1<NT));       ENDW(t);   RESC(); ROT();
    STEP(pA0,pA1,pB0,pB1,t+1,(t+4<NT),(t+2<NT),(t+2<NT));     ENDW(t+1); RESC(); ROT();
  }
  STEP(pB0,pB1,pA0,pA1,NT-1,false,false,false); RESC();
  { float sacc=pB0[0]+pB0[1]; _Pragma("unroll") for(int r=2;r<16;++r)sacc+=pB0[r]; _Pragma("unroll") for(int r=0;r<16;++r)sacc+=pB1[r]; l_reg+=sacc;
    pw0=(u32x4){PKW(pB0,0),PKW(pB0,2),PKW(pB0,4),PKW(pB0,6)};pw1=(u32x4){PKW(pB0,8),PKW(pB0,10),PKW(pB0,12),PKW(pB0,14)};pw2=(u32x4){PKW(pB1,0),PKW(pB1,2),PKW(pB1,4),PKW(pB1,6)};pw3=(u32x4){PKW(pB1,8),PKW(pB1,10),PKW(pB1,12),PKW(pB1,14)};
    SBAR(); const int vb0=(int)(lds0+LDS_V2)+((lane>>4)&1)*32+(lane&3)*8+(4*hi+((lane&15)>>2))*64; pv128(o,vb0+2*sl_cur,PAF(0),PAF(1),PAF(2),PAF(3)); }
  #undef PKW
  #undef PAF
  #undef VFR
  #undef PIN
  #undef MX3
  #undef GAPA
  #undef GAPB
  #undef GAPB2
  #undef VRD2
  #undef EX
  #undef VRD
  #undef KRD
  #undef STEP
  #undef ENDW
  {auto rr=__builtin_amdgcn_permlane32_swap(__float_as_uint(l_reg),__float_as_uint(l_reg),false,false);l_reg=__uint_as_float(rr[0])+__uint_as_float(rr[1]);}
  if(hi==0)wsf[32+r32]=l_reg;asm volatile("s_waitcnt lgkmcnt(0)":::"memory");
  float rli[16];
  #pragma unroll
  for(int r=0;r<16;++r)rli[r]=__builtin_amdgcn_rcpf(wsf[32+crow(r,hi)]);
  bf16*Ow=Oc+(rowbase+q0+wid*QBLK)*PO;
  { bf16*stg=(bf16*)(shm+LDS_OST2)+wid*2048;
    #pragma unroll
    for(int hh=0;hh<2;++hh){
      #pragma unroll
      for(int r=0;r<16;++r){const int orow=crow(r,hi);
        #pragma unroll
        for(int d0=0;d0<2;++d0)stg[orow*64+d0*32+r32]=__float2bfloat16(o[2*hh+d0][r]*rli[r]);}
      asm volatile("s_waitcnt lgkmcnt(0)":::"memory");
      #pragma unroll
      for(int i=0;i<4;++i){const int row=i*8+(lane>>3),ch=lane&7; const u32x4 v=*(const u32x4*)(stg+row*64+ch*8); ATTN_STORE16(Ow+(long)row*PO+hh*64+ch*8,v);}
      asm volatile("s_waitcnt lgkmcnt(0)":::"memory"); } }
  asm volatile("s_waitcnt lgkmcnt(0)\n\ts_barrier":::"memory");
  #undef DMA_K
  #undef DMA_V
  #undef CMASK
  #undef START
  #undef RESC
  #undef ROT
}
constexpr int ATTN_LDS_BYTES=LDS_BYTES;
#undef SBAR
#undef WAIT_BAR
}
#define GAS __attribute__((address_space(1)))
#define LAS __attribute__((address_space(3)))
typedef unsigned v4u __attribute__((ext_vector_type(4)));
typedef float f32x4 __attribute__((ext_vector_type(4)));
typedef short bf16x8 __attribute__((ext_vector_type(8)));
typedef GAS unsigned gu32;
typedef GAS unsigned long long gu64;
#define RLX_AGENT __ATOMIC_RELAXED, __HIP_MEMORY_SCOPE_AGENT
#define LDS_WAIT() asm volatile("s_waitcnt lgkmcnt(0)" ::: "memory")
#define VM_WAIT() asm volatile("s_waitcnt vmcnt(0)" ::: "memory")
__device__ __forceinline__ int lane_id() { int l; asm volatile("v_mbcnt_lo_u32_b32 %0, -1, 0\n\tv_mbcnt_hi_u32_b32 %0, -1, %0" : "=v"(l)); return l; }
__device__ __forceinline__ unsigned long long rt() { return __builtin_amdgcn_s_memrealtime(); }
typedef float pk_f32x2 __attribute__((ext_vector_type(2))); typedef __bf16 pk_bf16x2 __attribute__((ext_vector_type(2)));
__device__ __forceinline__ unsigned pk2(float lo, float hi) { pk_f32x2 v = {lo, hi}; pk_bf16x2 b = __builtin_convertvector(v, pk_bf16x2); return __builtin_bit_cast(unsigned, b); }

#define XB_TMO      128
#define XB_XCNT(j)  (256  + 64 * (j))
#define XB_XSUB(j)  (1280 + 64 * (j))
#define XB_XGEN(j)  (2304 + 64 * (j))
#define XB_TOP      3328
#define XB_TOPGEN   3392
#define XCD_BAR_WORDS 3456
#define XB_SPIN_CAP (1u << 18)

__device__ __forceinline__ unsigned xb_ld(unsigned* p)              { return __hip_atomic_load(p, __ATOMIC_RELAXED, __HIP_MEMORY_SCOPE_AGENT); }
__device__ __forceinline__ unsigned xb_add(unsigned* p, unsigned v) { return __hip_atomic_fetch_add(p, v, __ATOMIC_RELAXED, __HIP_MEMORY_SCOPE_AGENT); }
__device__ __forceinline__ unsigned xb_xcc_id() { return (unsigned)__builtin_amdgcn_s_getreg((3 << 11) | 20) & 0xFu; }
#define XB_SPIN(cond, bar) do { unsigned _sp = 0; while (cond) { __builtin_amdgcn_s_sleep(1); \
    if ((++_sp & 255u) == 0u) { if (xb_ld(&(bar)[XB_TMO])) break; if (_sp > XB_SPIN_CAP) { atomicAdd(&(bar)[XB_TMO], 1u); break; } } } } while (0)

struct XcdBarrier {
    unsigned* bar; unsigned x;
    volatile LAS unsigned* st;
};

__device__ __forceinline__ XcdBarrier xcd_barrier_post(unsigned* bar, volatile LAS unsigned* st, const int tid0) {
    XcdBarrier b; b.bar = bar; b.x = xb_xcc_id(); b.st = st;
    if (tid0 == 0) (void)xb_add(&bar[XB_XCNT(b.x)], 1u);
    return b;
}
__device__ __forceinline__ void xcd_barrier_complete(unsigned* bar, unsigned x, unsigned& nloc, unsigned& nx) {
    const unsigned G = gridDim.x * gridDim.y * gridDim.z;
    unsigned sum, cnt, mine, sp = 0u;
    for (;;) {
        sum = 0u; cnt = 0u; mine = 0u;
#pragma unroll
        for (unsigned j = 0; j < 16; ++j) { const unsigned c = xb_ld(&bar[XB_XCNT(j)]); sum += c; cnt += (c > 0u) ? 1u : 0u; mine = (j == x) ? c : mine; }
        if (sum == G) break;
        __builtin_amdgcn_s_sleep(1);
        if ((++sp & 255u) == 0u) { if (xb_ld(&bar[XB_TMO])) break; if (sp > XB_SPIN_CAP) { atomicAdd(&bar[XB_TMO], 1u); break; } }
    }
    nloc = mine > 0u ? mine : 1u; nx = cnt > 0u ? cnt : 1u;
}

__device__ __forceinline__ void xcd_barrier(const XcdBarrier& b, const int tid0) {
    asm volatile("s_waitcnt vmcnt(0)" ::: "memory");
    __syncthreads();
    if (tid0 == 0) {
        unsigned* bar = b.bar;
        __builtin_amdgcn_s_waitcnt(0);
        unsigned nloc = b.st[0], nx = b.st[1];
        if (nloc == 0u) { xcd_barrier_complete(bar, b.x, nloc, nx); b.st[0] = nloc; b.st[1] = nx; }
        const unsigned old = xb_add(&bar[XB_XSUB(b.x)], 1u);
        const unsigned gen = old / nloc;
        if (old + 1u == (gen + 1u) * nloc) {
            __builtin_amdgcn_fence(__ATOMIC_RELEASE, "agent");
            asm volatile("s_waitcnt vmcnt(0)" ::: "memory");
            const unsigned og = xb_add(&bar[XB_TOP], 1u);
            const unsigned tg = og / nx;
            if (og + 1u == (tg + 1u) * nx) xb_add(&bar[XB_TOPGEN], 1u);
            else XB_SPIN(xb_ld(&bar[XB_TOPGEN]) == tg, bar);
            __builtin_amdgcn_fence(__ATOMIC_ACQUIRE, "agent");
            xb_add(&bar[XB_XGEN(b.x)], 1u);
            asm volatile("s_waitcnt vmcnt(0)" ::: "memory");
        } else {
            XB_SPIN(xb_ld(&bar[XB_XGEN(b.x)]) == gen, bar);
            __builtin_amdgcn_fence(__ATOMIC_ACQUIRE, "agent");
            asm volatile("s_waitcnt vmcnt(0)" ::: "memory");
        }
    }
    __syncthreads();
}
constexpr int NWAVES = 8;
constexpr int RING_OFF = 0, RING_BYTES = 131072;
constexpr int LDSCTL_OFF = RING_BYTES, MISC_OFF = LDSCTL_OFF + 320;
constexpr int LDS_BYTES = 147456;
constexpr int CW_TMO = 0, CW_CODE = 1, CW_BAR = 4096;
#ifndef I8_FROM_PN
#define I8_FROM_PN 0
#endif
constexpr float GATE_WSCALE = 32.f, H_SCALE = 16.f, WD_SCALE = 16.f;
constexpr int CW_CNT2 = 32768;
constexpr int CW_CNT = 16384;

struct Frame {
    LAS unsigned char* lds;
    volatile LAS unsigned* MISC;
    gu32* ctl;
    int tid, lane, wave;
    int vcu, G;
    unsigned char* ws;
    const float* in[30]; float* out;
};
__device__ __forceinline__ float wave_sum(float v) {
#pragma unroll
    for (int o = 1; o < 64; o <<= 1) v += __shfl_xor(v, o);
    return v;
}
__device__ __forceinline__ float fast_sigmoid(float v) { return __builtin_amdgcn_rcpf(1.f + __builtin_amdgcn_exp2f(-1.4426950408889634f * v)); }

__device__ __forceinline__ void p0_transpose_item(const float* W, int K, int N, bf16_t* WT, int dst_row0, const float* kscale, LAS float* scr, int k0, int n0, int lane) {
    const int c = lane & 7;
    f32x4 ks0 = (f32x4){1.f, 1.f, 1.f, 1.f}, ks1 = ks0;
    if (kscale) { ks0 = *(const f32x4*)(kscale + k0 + 8 * c); ks1 = *(const f32x4*)(kscale + k0 + 8 * c + 4); }
    float v[32];
#pragma unroll
    for (int i = 0; i < 32; ++i) v[i] = __builtin_nontemporal_load(W + (size_t)(k0 + 2 * i + (lane >> 5)) * N + n0 + (lane & 31));
#pragma unroll
    for (int i = 0; i < 32; ++i) scr[(2 * i + (lane >> 5)) * 33 + (lane & 31)] = v[i];
    LDS_WAIT(); asm volatile("" ::: "memory");
#pragma unroll
    for (int j = 0; j < 4; ++j) { const int n = (lane >> 3) + 8 * j; const LAS float* s = scr + (8 * c) * 33 + n;
        v4u o; o.x = pk2(s[0 * 33] * ks0.x, s[1 * 33] * ks0.y); o.y = pk2(s[2 * 33] * ks0.z, s[3 * 33] * ks0.w); o.z = pk2(s[4 * 33] * ks1.x, s[5 * 33] * ks1.y); o.w = pk2(s[6 * 33] * ks1.z, s[7 * 33] * ks1.w);
        st16(WT + (size_t)(dst_row0 + n) * K + k0 + 8 * c, o); }
    LDS_WAIT(); asm volatile("" ::: "memory");
}
__device__ __forceinline__ unsigned pk4_fp8(float a, float b, float c, float d) { unsigned r = 0u;
    a = __builtin_amdgcn_fmed3f(a, -448.f, 448.f); b = __builtin_amdgcn_fmed3f(b, -448.f, 448.f); c = __builtin_amdgcn_fmed3f(c, -448.f, 448.f); d = __builtin_amdgcn_fmed3f(d, -448.f, 448.f); r = (unsigned)__builtin_amdgcn_cvt_pk_fp8_f32(a, b, (int)r, false); r = (unsigned)__builtin_amdgcn_cvt_pk_fp8_f32(c, d, (int)r, true); return r; }
__device__ __forceinline__ void p0_transpose_item_fp8(const float* W, int K, int N, unsigned char* WT, int dst_row0, float scale, LAS float* scr, int k0, int n0, int lane, const float* kscale = nullptr) {
    const int c = lane & 7;
    f32x4 ks0 = (f32x4){scale, scale, scale, scale}, ks1 = ks0;
    if (kscale) { ks0 = *(const f32x4*)(kscale + k0 + 8 * c) * scale; ks1 = *(const f32x4*)(kscale + k0 + 8 * c + 4) * scale; }
    float v[32];
#pragma unroll
    for (int i = 0; i < 32; ++i) v[i] = __builtin_nontemporal_load(W + (size_t)(k0 + 2 * i + (lane >> 5)) * N + n0 + (lane & 31));
#pragma unroll
    for (int i = 0; i < 32; ++i) scr[(2 * i + (lane >> 5)) * 33 + (lane & 31)] = v[i];
    LDS_WAIT(); asm volatile("" ::: "memory");
#pragma unroll
    for (int j = 0; j < 4; ++j) { const int n = (lane >> 3) + 8 * j; const LAS float* s = scr + (8 * c) * 33 + n;
        wt_v2u o; o.x = pk4_fp8(s[0 * 33] * ks0.x, s[1 * 33] * ks0.y, s[2 * 33] * ks0.z, s[3 * 33] * ks0.w); o.y = pk4_fp8(s[4 * 33] * ks1.x, s[5 * 33] * ks1.y, s[6 * 33] * ks1.z, s[7 * 33] * ks1.w);
        st8(WT + (size_t)(dst_row0 + n) * K + k0 + 8 * c, o); }
    LDS_WAIT(); asm volatile("" ::: "memory");
}
__device__ __forceinline__ unsigned pk4_i8(float a, float b, float c, float d) {
    const int qa = __float2int_rn(a), qb = __float2int_rn(b), qc = __float2int_rn(c), qd = __float2int_rn(d);
    return ((unsigned)qa & 255u) | (((unsigned)qb & 255u) << 8) | (((unsigned)qc & 255u) << 16) | ((unsigned)qd << 24); }
__device__ __forceinline__ int perm_in(int n) { return (n & ~255) | (((n >> 5) & 1) << 7) | (((n >> 6) & 3) << 5) | (n & 31); }
__device__ __forceinline__ int perm_glu(int n) { const int bj = n >> 10, rem = n & 1023; return ((rem >> 7) << 8) | (bj << 7) | (rem & 127); }
template <int NR> __device__ __forceinline__ void rms_rows_to_bf16(Frame& F, const float* xrow, const float* g, bf16_t* orow, unsigned char* o8row, float* sa) {
    const GAS f32x4* xr = (const GAS f32x4*)xrow + F.lane; const GAS f32x4* gr = (const GAS f32x4*)g + F.lane;
    f32x4 v[NR][4]; float s[NR];
#pragma unroll
    for (int r = 0; r < NR; ++r)
#pragma unroll
        for (int j = 0; j < 4; ++j) v[r][j] = __builtin_nontemporal_load(xr + r * 256 + 64 * j);
#pragma unroll
    for (int r = 0; r < NR; ++r) { s[r] = 0.f;
#pragma unroll
        for (int j = 0; j < 4; ++j) s[r] += (v[r][j].x * v[r][j].x + v[r][j].y * v[r][j].y) + (v[r][j].z * v[r][j].z + v[r][j].w * v[r][j].w); }
#pragma unroll
    for (int o = 1; o < 64; o <<= 1)
#pragma unroll
        for (int r = 0; r < NR; ++r) s[r] += __shfl_xor(s[r], o);
    f32x4 gg[4];
#pragma unroll
    for (int j = 0; j < 4; ++j) gg[j] = gr[64 * j];
#pragma unroll
    for (int r = 0; r < NR; ++r) { const float rs = rsqrtf(s[r] * (1.f / DM) + EPS); GAS unsigned long long* o8 = (GAS unsigned long long*)(orow + (size_t)r * DM) + F.lane;
        float mx = 0.f;
#pragma unroll
        for (int j = 0; j < 4; ++j) { v[r][j] = v[r][j] * gg[j] * rs; mx = fmaxf(fmaxf(mx, fmaxf(fabsf(v[r][j].x), fabsf(v[r][j].y))), fmaxf(fabsf(v[r][j].z), fabsf(v[r][j].w))); }
#pragma unroll
        for (int o = 1; o < 64; o <<= 1) mx = fmaxf(mx, __shfl_xor(mx, o));
        const float qs = mx > 0.f ? 127.f / mx : 0.f; if (F.lane == 0) sa[r] = mx * (1.f / 127.f);
#pragma unroll
        for (int j = 0; j < 4; ++j) { const float a = v[r][j].x, b = v[r][j].y, c = v[r][j].z, d = v[r][j].w;
            if (I8_FROM_PN > 0) { wt_v2u w2; w2.x = pk2(a, b); w2.y = pk2(c, d); st8((void*)(o8 + 64 * j), w2); }
            ((GAS unsigned*)(o8row + (size_t)r * DM))[F.lane + 64 * j] = pk4_i8(a * qs, b * qs, c * qs, d * qs); } }
}
__device__ __forceinline__ void p0_quant_cols_wg(Frame& F, const float* W, int N, unsigned char* WT, int dst_row0, float* sw, int n0) {
    LAS unsigned* cmx = (LAS unsigned*)(F.lds + LDSCTL_OFF + 1024); LAS float* scr = (LAS float*)(F.lds + RING_OFF + F.wave * 16384);
    const int lane = F.lane, k0 = 128 * F.wave, c = lane & 7;
    if (F.tid < 32) cmx[F.tid] = 0u;
    __syncthreads();
    float v[64];
#pragma unroll
    for (int i = 0; i < 64; ++i) v[i] = __builtin_nontemporal_load(W + (size_t)(k0 + 2 * i + (lane >> 5)) * N + n0 + (lane & 31));
    float mx = 0.f;
#pragma unroll
    for (int i = 0; i < 64; ++i) mx = fmaxf(mx, fabsf(v[i]));
    mx = fmaxf(mx, __shfl_xor(mx, 32));
    if (lane < 32) __hip_atomic_fetch_max(cmx + lane, __float_as_uint(mx), __ATOMIC_RELAXED, __HIP_MEMORY_SCOPE_WORKGROUP);
    __syncthreads();
    const float cm = __uint_as_float(cmx[lane & 31]), qs = cm > 0.f ? 127.f / cm : 0.f;
    if (F.wave == 0 && lane < 32) sw[n0 + lane] = cm * (1.f / 127.f);
#pragma unroll
    for (int sb = 0; sb < 2; ++sb) {
#pragma unroll
        for (int i = 0; i < 32; ++i) scr[(2 * i + (lane >> 5)) * 33 + (lane & 31)] = v[sb * 32 + i] * qs;
        LDS_WAIT(); asm volatile("" ::: "memory");
#pragma unroll
        for (int j = 0; j < 4; ++j) { const int n = (lane >> 3) + 8 * j; const LAS float* sp = scr + (8 * c) * 33 + n;
            wt_v2u o; o.x = pk4_i8(sp[0 * 33], sp[1 * 33], sp[2 * 33], sp[3 * 33]); o.y = pk4_i8(sp[4 * 33], sp[5 * 33], sp[6 * 33], sp[7 * 33]);
            st8(WT + (size_t)(dst_row0 + n) * 1024 + k0 + 64 * sb + 8 * c, o); }
        LDS_WAIT(); asm volatile("" ::: "memory"); }
    __syncthreads();
}
__device__ __forceinline__ void p0_prologue(Frame& F) {
    LAS float* scr = (LAS float*)(F.lds + RING_OFF + F.wave * 16384);
    const int gw = F.vcu * NWAVES + F.wave, NGW = F.G * NWAVES;
    bf16_t* Win_t = (bf16_t*)(F.ws + WS_WIN); bf16_t* Wo_t = (bf16_t*)(F.ws + WS_WO); bf16_t* Wglu_t = (bf16_t*)(F.ws + WS_WGLU); bf16_t* Wout_t = (bf16_t*)(F.ws + WS_WOUT);
    constexpr int I_IN = 16 * 128, I_O = 8 * 32, I_GLU = 8 * 64, I_OUT = 16 * 32;
    constexpr int NITEMS = I_IN + I_O + I_GLU + I_OUT;
    for (int it = gw; it < NITEMS; it += NGW) {
        int r = it;
        if (r < I_IN) { const int kb = r / 128, nb = r % 128;
            if (nb < 8 * I8_FROM_PN) p0_transpose_item(F.in[3], DM, IN_COLS, Win_t, perm_in(32 * nb), nullptr, scr, 64 * kb, 32 * nb, F.lane);
            continue; } r -= I_IN;
        if (r < I_O) { const int kb = r / 32, nb = r % 32; p0_transpose_item(F.in[11], 512, DM, Wo_t, 32 * nb, nullptr, scr, 64 * kb, 32 * nb, F.lane); continue; } r -= I_O;
        if (r < I_GLU) { const int kb = r / 64, nb = r % 64; p0_transpose_item(F.in[20], 512, 2048, Wglu_t, perm_glu(32 * nb), nullptr, scr, 64 * kb, 32 * nb, F.lane); continue; } r -= I_GLU;
        { const int kb = r / 32, nb = r % 32; p0_transpose_item(F.in[21], DM, DM, Wout_t, 32 * nb, nullptr, scr, 64 * kb, 32 * nb, F.lane); }
    }
    for (int cb = 8 * I8_FROM_PN + F.vcu; cb < 128; cb += F.G)
        p0_quant_cols_wg(F, F.in[3], IN_COLS, F.ws + WS_WG8, perm_in(32 * cb) - 256 * I8_FROM_PN, (float*)(F.ws + WS_SW), 32 * cb);
    bf16_t* XN = (bf16_t*)(F.ws + WS_XN);
    {
        const int nitem = 128 - 8 * I8_FROM_PN, R1 = (nitem < F.G && nitem * 2 >= F.G) ? (T / 4) * 3 : T;
        for (int m = 4 * gw; m < R1; m += 4 * NGW) rms_rows_to_bf16<4>(F, F.in[0] + (size_t)m * DM, F.in[2], XN + (size_t)m * DM, F.ws + WS_XN8 + (size_t)m * DM, (float*)(F.ws + WS_SA) + m);
        if (R1 < T && F.vcu >= nitem) { const int gw2 = (F.vcu - nitem) * NWAVES + F.wave, NGW2 = (F.G - nitem) * NWAVES;
            for (int m = R1 + 4 * gw2; m < T; m += 4 * NGW2) rms_rows_to_bf16<4>(F, F.in[0] + (size_t)m * DM, F.in[2], XN + (size_t)m * DM, F.ws + WS_XN8 + (size_t)m * DM, (float*)(F.ws + WS_SA) + m); } }
    { float* rope = (float*)(F.ws + WS_ROPE); const int* pos = (const int*)F.in[1]; const int gt = (F.vcu * NWAVES + F.wave) * 64 + F.lane, NGT = NGW * 64;
        for (int i = gt; i < T * 8; i += NGT) { const int row = i >> 3, k = i & 7;
            double rv = (double)pos[row] * (0.15915494309189535 * exp2(-(double)k * 2.3664460711655217)); rv -= rint(rv);
            rope[row * 16 + k] = __builtin_amdgcn_cosf((float)rv); rope[row * 16 + 8 + k] = __builtin_amdgcn_sinf((float)rv); } }
    {   const float* lre = F.in[12]; const float* lim = F.in[13]; const float* ldt = F.in[14]; const float* bre = F.in[15]; const float* bim = F.in[16]; const float* cre = F.in[17]; const float* cim = F.in[18];
        bf16_t* Ft = (bf16_t*)(F.ws + WS_SSMF); bf16_t* Gt = (bf16_t*)(F.ws + WS_SSMG); bf16_t* Ht = (bf16_t*)(F.ws + WS_SSMH); float* A64 = (float*)(F.ws + WS_SSMA);
#define CPOW(lr_, li_, dt_, e_, outr, outi) do { const float m_ = __expf((lr_) * (dt_) * (float)(e_)); double rv_ = (double)(li_) * (double)(dt_) * (double)(e_) * 0.15915494309189535; rv_ -= rint(rv_); \
        outr = m_ * __builtin_amdgcn_cosf((float)rv_); outi = m_ * __builtin_amdgcn_sinf((float)rv_); } while (0)
#define CFAC(lr_, li_, dt_, fr_, fi_) do { float a1r_, a1i_; CPOW(lr_, li_, dt_, 1, a1r_, a1i_); const float nr_ = a1r_ - 1.f, ni_ = a1i_, den_ = (lr_) * (lr_) + (li_) * (li_); \
        fr_ = (nr_ * (lr_) + ni_ * (li_)) / den_; fi_ = (ni_ * (lr_) - nr_ * (li_)) / den_; } while (0)
        LAS float* sw = (LAS float*)(F.lds + RING_OFF + F.wave * 16384);
        for (int it = gw; it < 32 * 64; it += NGW) { const int g = it >> 6, d = it & 63; const int p = F.lane;
            { const float dt = __expf(ldt[g]); const float lr = lre[g * 64 + p], li = lim[g * 64 + p]; float fr, fi, wr, wi; CFAC(lr, li, dt, fr, fi); CPOW(lr, li, dt, d, wr, wi);
              sw[p * 2] = wr * fr - wi * fi; sw[p * 2 + 1] = wr * fi + wi * fr; }
            LDS_WAIT(); asm volatile("" ::: "memory");
            const int hp = F.lane >> 2, h0 = (F.lane & 3) * 4; float acc[4] = {0.f, 0.f, 0.f, 0.f};
#pragma unroll 16
            for (int q = 0; q < 64; ++q) { const float ur = sw[q * 2], ui = sw[q * 2 + 1]; const float cr = cre[(g * 16 + hp) * 64 + q], ci = cim[(g * 16 + hp) * 64 + q];
                const f32x4 br = *(const f32x4*)(bre + (g * 64 + q) * 16 + h0), bi = *(const f32x4*)(bim + (g * 64 + q) * 16 + h0);
                const float er = cr * ur - ci * ui, ei = cr * ui + ci * ur;
                acc[0] += er * br.x - ei * bi.x; acc[1] += er * br.y - ei * bi.y; acc[2] += er * br.z - ei * bi.z; acc[3] += er * br.w - ei * bi.w; }
#pragma unroll
            for (int i = 0; i < 4; ++i) { const int h = h0 + i; float v = acc[i]; if (d == 0 && h == hp) v += F.in[19][g * 16 + hp];
                Ft[((size_t)(g * 64 + d) * 64 + hp + 16 * (h >> 3)) * 8 + (h & 7)] = f2bf(v);
                if (d < 63) Ft[((size_t)(g * 64 + d + 1) * 64 + hp + 16 * (2 + (h >> 3))) * 8 + (h & 7)] = f2bf(v);
                if (d == 0) Ft[((size_t)(g * 64) * 64 + hp + 16 * (2 + (h >> 3))) * 8 + (h & 7)] = 0; }
            LDS_WAIT(); asm volatile("" ::: "memory");
        }
        const int gt = gw * 64 + F.lane, NGT = NGW * 64;
        for (int idx = gt; idx < 32 * 4 * 512; idx += NGT) { const int j = idx & 7, ln = (idx >> 3) & 63, kk = (idx >> 9) & 3, g = idx >> 11; const int hp = ln & 15, sidx = 32 * kk + 8 * (ln >> 4) + j;
            Gt[idx] = f2bf(sidx < 64 ? cre[(g * 16 + hp) * 64 + sidx] : -cim[(g * 16 + hp) * 64 + sidx - 64]); }
        for (int idx = gt; idx < 32 * 64; idx += NGT) { const int g = idx >> 6, p = idx & 63; const float dt = __expf(ldt[g]); const float lr = lre[idx], li = lim[idx]; f32x4 ab; CPOW(lr, li, dt, 1, ab.x, ab.y); CPOW(lr, li, dt, 2, ab.z, ab.w);
            ((f32x4*)(A64 + 16384))[idx] = ab; }
        for (int idx = gt; idx < 32 * 64 * 64; idx += NGT) { const int g = idx >> 12, t = (idx >> 6) & 63, p = idx & 63;
            const float dt = __expf(ldt[g]);
            { const int pp = t, jt = p;
              const float lr2 = lre[g * 64 + pp], li2 = lim[g * 64 + pp]; float fr, fi, wr0, wi0; CFAC(lr2, li2, dt, fr, fi); CPOW(lr2, li2, dt, 63 - jt, wr0, wi0);
              const float wr = wr0 * fr - wi0 * fi, wi = wr0 * fi + wi0 * fr;
              const int mt = pp >> 4, mrow = pp & 15, ks = jt >> 1;
              const f32x4* b4r = (const f32x4*)(bre + (g * 64 + pp) * 16); const f32x4* b4i = (const f32x4*)(bim + (g * 64 + pp) * 16);
#pragma unroll
              for (int hq = 0; hq < 2; ++hq) {
                  const f32x4 ra = b4r[2 * hq], rb = b4r[2 * hq + 1], ia = b4i[2 * hq], ib = b4i[2 * hq + 1]; const int kq = (jt & 1) * 2 + hq;
                  v4u o0, o1; o0.x = pk2(wr * ra.x - wi * ia.x, wr * ra.y - wi * ia.y); o0.y = pk2(wr * ra.z - wi * ia.z, wr * ra.w - wi * ia.w); o0.z = pk2(wr * rb.x - wi * ib.x, wr * rb.y - wi * ib.y); o0.w = pk2(wr * rb.z - wi * ib.z, wr * rb.w - wi * ib.w);
                  o1.x = pk2(wr * ia.x + wi * ra.x, wr * ia.y + wi * ra.y); o1.y = pk2(wr * ia.z + wi * ra.z, wr * ia.w + wi * ra.w); o1.z = pk2(wr * ib.x + wi * rb.x, wr * ib.y + wi * rb.y); o1.w = pk2(wr * ib.z + wi * rb.z, wr * ib.w + wi * rb.w);
                  st16(Ht + ((size_t)((g * 8 + mt) * 32 + ks) * 64 + mrow + 16 * kq) * 8, o0);
                  st16(Ht + ((size_t)((g * 8 + 4 + mt) * 32 + ks) * 64 + mrow + 16 * kq) * 8, o1); }
              if (jt == 0) { float ar, ai; CPOW(lr2, li2, dt, 64, ar, ai); A64[(g * 64 + pp) * 2] = ar; A64[(g * 64 + pp) * 2 + 1] = ai; } }
        }
#undef CPOW
#undef CFAC
    }
    { bf16_t* Wr = (bf16_t*)(F.ws + WS_WR); const int gt2 = gw * 64 + F.lane, NGT2 = NGW * 64;
      for (int idx = gt2; idx < 32 * 3 * 512; idx += NGT2) { const int ks = idx / 1536, rem = idx % 1536, ntl = rem >> 9, ln = (rem & 511) >> 3, j = rem & 7; const int k = 32 * ks + 8 * (ln >> 4) + j, ncol = 16 * ntl + (ln & 15);
          float v = 0.f; if (ncol < 4) v = F.in[23][k * 4 + ncol]; else if (ncol < 36) v = F.in[25][k * 32 + ncol - 4];
          Wr[idx] = f2bf(v * F.in[22][k]); } }
    if (blockIdx.x == 0 && F.wave == 0) { const float a = wave_sum(F.in[6][F.lane] * F.in[7][F.lane]), b = wave_sum(F.in[8][F.lane] * F.in[9][F.lane]);
        if (F.lane == 0) ((float*)(F.ws + WS_SCAL))[0] = expf(a) - expf(b) + LAM_INIT; }
}

__device__ __forceinline__ void expert_weights_items(Frame& F, int gwp, int ngwp) {
    LAS float* scr = (LAS float*)(F.lds + RING_OFF + F.wave * 16384);
    bf16_t* Wgu_t = (bf16_t*)(F.ws + WS_WGU); bf16_t* Wd_t = (bf16_t*)(F.ws + WS_WD);
    constexpr int I_GU = 32 * 2 * 16 * 8, I_D = 32 * 4 * 32;
    for (int it = gwp; it < I_GU + I_D; it += ngwp) { int r = it;
        if (r < I_GU) { const int e = r / 256, up = (r / 128) & 1, kb = (r % 128) / 8, nb = r % 8;
            const int n0 = 32 * nb, pn = n0 >> 7, j0 = n0 & 127;
            p0_transpose_item_fp8((up ? F.in[28] : F.in[27]) + (size_t)e * DM * 256, DM, 256, F.ws + WS_WGU + (size_t)e * 512 * DM, 256 * pn + 128 * up + j0, GATE_WSCALE, scr, 64 * kb, n0, F.lane, F.in[22]); continue; } r -= I_GU;
        { const int e = r / 128, kb = (r % 128) / 32, nb = r % 32; p0_transpose_item_fp8(F.in[29] + (size_t)e * 256 * DM, 256, DM, F.ws + WS_WD + (size_t)e * DM * 256, 32 * nb, WD_SCALE, scr, 64 * kb, 32 * nb, F.lane); } }
    __syncthreads();
}
__device__ __forceinline__ float sum_x16_x32(float s) {
    { auto rr = __builtin_amdgcn_permlane16_swap(__float_as_uint(s), __float_as_uint(s), false, false); s = __uint_as_float(rr[0]) + __uint_as_float(rr[1]); }
    { auto rr = __builtin_amdgcn_permlane32_swap(__float_as_uint(s), __float_as_uint(s), false, false); s = __uint_as_float(rr[0]) + __uint_as_float(rr[1]); }
    return s; }
__device__ __forceinline__ float from_x16(float v, int fq) {
    auto rr = __builtin_amdgcn_permlane16_swap(__float_as_uint(v), __float_as_uint(v), false, false); return __uint_as_float((fq & 1) ? rr[0] : rr[1]); }
typedef unsigned u32x2g __attribute__((ext_vector_type(2)));
__device__ __forceinline__ unsigned q8(float a, float b, float c, float d) { const unsigned x = (unsigned)(a * 255.f + 0.5f), y = (unsigned)(b * 255.f + 0.5f), z = (unsigned)(c * 255.f + 0.5f), w = (unsigned)(d * 255.f + 0.5f); return x | (y << 8) | (z << 16) | (w << 24); }
__device__ __forceinline__ void unq8(const u32x2g v, float (&f)[8]) { constexpr float k = 1.f / 255.f;
    f[0] = (float)(v.x & 255u) * k; f[1] = (float)((v.x >> 8) & 255u) * k; f[2] = (float)((v.x >> 16) & 255u) * k; f[3] = (float)(v.x >> 24) * k;
    f[4] = (float)(v.y & 255u) * k; f[5] = (float)((v.y >> 8) & 255u) * k; f[6] = (float)((v.y >> 16) & 255u) * k; f[7] = (float)(v.y >> 24) * k; }
template <int PN0, int PN1, bool I8> struct EpiInT {
    static constexpr bool PERM = true, AFTER_DRAIN = false;
    bf16_t *Qb, *Kb, *Vb, *Ub, *Gb; const float* rope; const float* qg; const float* kg; const float* sa; const float* sw;
    __device__ __forceinline__ void operator()(const pg8::f32x4 (&acc)[2][2][4][2], const pg8::Unit& u, int wr, int wc, int fr, int fq) const {
        const int row0 = u.pm * 256 + wr * 64 + fr; const int pn = u.pn + PN0;
        f32x4 cs[2][2]; float rsc[2][4];
        if constexpr (I8) {
#pragma unroll
            for (int bj = 0; bj < 2; ++bj)
#pragma unroll
                for (int n = 0; n < 2; ++n) cs[bj][n] = *(const f32x4*)(sw + 256 * pn + 64 * wc + 32 * bj + 8 * fq + 4 * n);
#pragma unroll
            for (int ai = 0; ai < 2; ++ai)
#pragma unroll
                for (int m = 0; m < 4; ++m) rsc[ai][m] = sa[row0 + ai * 128 + m * 16]; }
#define EPIIN_VAL(ai, bj, m, n) (I8 ? (f32x4){(float)__float_as_int(acc[ai][bj][m][n].x), (float)__float_as_int(acc[ai][bj][m][n].y), (float)__float_as_int(acc[ai][bj][m][n].z), (float)__float_as_int(acc[ai][bj][m][n].w)} * cs[bj][n] * rsc[ai][m] : acc[ai][bj][m][n])
        if (PN0 < 4 && pn < 4) {
            const bool isq = pn < 2; const float* g = isq ? qg : kg; bf16_t* O = isq ? Qb : Kb; const float sc = isq ? QSCALE : 1.f; const int gidx = (pn & 1) * 4 + wc;
            f32x4 gv[2][2];
#pragma unroll
            for (int bj = 0; bj < 2; ++bj)
#pragma unroll
                for (int n = 0; n < 2; ++n) gv[bj][n] = *(const f32x4*)(g + 32 * bj + 8 * fq + 4 * n);
#pragma unroll
            for (int ai = 0; ai < 2; ++ai)
#pragma unroll
                for (int m = 0; m < 4; ++m) { const int row = row0 + ai * 128 + m * 16; f32x4 v[2][2]; float s = 0.f;
#pragma unroll
                    for (int bj = 0; bj < 2; ++bj)
#pragma unroll
                        for (int n = 0; n < 2; ++n) { v[bj][n] = EPIIN_VAL(ai, bj, m, n); s += (v[bj][n].x * v[bj][n].x + v[bj][n].y * v[bj][n].y) + (v[bj][n].z * v[bj][n].z + v[bj][n].w * v[bj][n].w); }
                    s = sum_x16_x32(s);
                    const float r = rsqrtf(s * (1.f / 64.f) + EPS);
#pragma unroll
                    for (int bj = 0; bj < 2; ++bj)
#pragma unroll
                        for (int n = 0; n < 2; ++n) v[bj][n] = v[bj][n] * r * gv[bj][n];
#pragma unroll
                    for (int n = 0; n < 2; ++n) { f32x4 p; p.x = from_x16(v[0][n].x, fq); p.y = from_x16(v[0][n].y, fq); p.z = from_x16(v[0][n].z, fq); p.w = from_x16(v[0][n].w, fq);
                        if (fq < 2) { const f32x4 cs_ = *(const f32x4*)(rope + (size_t)row * 16 + 4 * n), sn = *(const f32x4*)(rope + (size_t)row * 16 + 8 + 4 * n);
                            v[0][n] = fq == 0 ? v[0][n] * cs_ - p * sn : v[0][n] * cs_ + p * sn; } }
#pragma unroll
                    for (int bj = 0; bj < 2; ++bj) { const f32x4 a = v[bj][0] * sc, b = v[bj][1] * sc; v4u w; w.x = pk2(a.x, a.y); w.y = pk2(a.z, a.w); w.z = pk2(b.x, b.y); w.w = pk2(b.z, b.w);
                        pst16(O + (size_t)row * 512 + gidx * 64 + 32 * bj + 8 * fq, w); }
                }
        } else if (PN0 < 8 && PN1 > 4 && pn < 8) {
            bf16_t* O = pn < 6 ? Vb : Ub; const int cbase = (pn & 1) * 256 + 64 * wc + 8 * fq;
#pragma unroll
            for (int ai = 0; ai < 2; ++ai)
#pragma unroll
                for (int m = 0; m < 4; ++m) { const int row = row0 + ai * 128 + m * 16;
#pragma unroll
                    for (int bj = 0; bj < 2; ++bj) { const f32x4 a = EPIIN_VAL(ai, bj, m, 0), b = EPIIN_VAL(ai, bj, m, 1); v4u w; w.x = pk2(a.x, a.y); w.y = pk2(a.z, a.w); w.z = pk2(b.x, b.y); w.w = pk2(b.z, b.w);
                        pst16(O + (size_t)row * 512 + cbase + 32 * bj, w); } }
        } else if (PN1 > 8) {
            const int cbase = (pn - 8) * 256 + 64 * wc + 8 * fq;
#pragma unroll
            for (int ai = 0; ai < 2; ++ai)
#pragma unroll
                for (int m = 0; m < 4; ++m) { const int row = row0 + ai * 128 + m * 16;
#pragma unroll
                    for (int bj = 0; bj < 2; ++bj) { const f32x4 a = EPIIN_VAL(ai, bj, m, 0), b = EPIIN_VAL(ai, bj, m, 1); u32x2g w;
                        w.x = q8(fast_sigmoid(a.x), fast_sigmoid(a.y), fast_sigmoid(a.z), fast_sigmoid(a.w)); w.y = q8(fast_sigmoid(b.x), fast_sigmoid(b.y), fast_sigmoid(b.z), fast_sigmoid(b.w));
                        pst8((unsigned char*)Gb + (size_t)row * 2048 + cbase + 32 * bj, w); } }
        }
#undef EPIIN_VAL
    }
};


__device__ __forceinline__ void unpack8(const v4u w, float (&f)[8]) { f[0] = __uint_as_float(w.x << 16); f[1] = __uint_as_float(w.x & 0xffff0000u); f[2] = __uint_as_float(w.y << 16); f[3] = __uint_as_float(w.y & 0xffff0000u);
    f[4] = __uint_as_float(w.z << 16); f[5] = __uint_as_float(w.z & 0xffff0000u); f[6] = __uint_as_float(w.w << 16); f[7] = __uint_as_float(w.w & 0xffff0000u); }
struct EpiOA {
    static constexpr bool PERM = true, AFTER_DRAIN = false;
    const bf16_t* Gb; bf16_t* MA;
    __device__ __forceinline__ void operator()(const pg8::f32x4 (&acc)[2][2][4][2], const pg8::Unit& u, int wr, int wc, int fr, int fq) const {
        const int row0 = u.pm * 256 + wr * 64 + fr, col0 = u.pn * 256 + wc * 32 + 8 * fq;
        u32x2g gv[2][4][2];
#pragma unroll
        for (int ai = 0; ai < 2; ++ai)
#pragma unroll
            for (int m = 0; m < 4; ++m)
#pragma unroll
                for (int bj = 0; bj < 2; ++bj) gv[ai][m][bj] = *(const u32x2g*)((const unsigned char*)Gb + (size_t)(row0 + ai * 128 + m * 16) * 2048 + col0 + bj * 128);
#pragma unroll
        for (int ai = 0; ai < 2; ++ai)
#pragma unroll
            for (int m = 0; m < 4; ++m) { const size_t row = row0 + ai * 128 + m * 16;
#pragma unroll
                for (int bj = 0; bj < 2; ++bj) { float gg[8]; unq8(gv[ai][m][bj], gg);
                    const f32x4 a = acc[ai][bj][m][0], b = acc[ai][bj][m][1]; v4u w; w.x = pk2(a.x * gg[0], a.y * gg[1]); w.y = pk2(a.z * gg[2], a.w * gg[3]); w.z = pk2(b.x * gg[4], b.y * gg[5]); w.w = pk2(b.z * gg[6], b.w * gg[7]);
                    pst16(MA + row * DM + col0 + bj * 128, w); } }
    }
};
struct EpiGlu {
    static constexpr bool PERM = true, AFTER_DRAIN = false;
    const bf16_t* Gb; const bf16_t* MA; bf16_t* MG;
    __device__ __forceinline__ void operator()(const pg8::f32x4 (&acc)[2][2][4][2], const pg8::Unit& u, int wr, int wc, int fr, int fq) const {
        const int row0 = u.pm * 256 + wr * 64 + fr, col = u.pn * 128 + wc * 32 + 8 * fq;
        u32x2g gv[2][4]; v4u mv[2][4];
#pragma unroll
        for (int ai = 0; ai < 2; ++ai)
#pragma unroll
            for (int m = 0; m < 4; ++m) { const size_t row = row0 + ai * 128 + m * 16; gv[ai][m] = *(const u32x2g*)((const unsigned char*)Gb + row * 2048 + 1024 + col); mv[ai][m] = *(const v4u*)(MA + row * DM + col); }
#pragma unroll
        for (int ai = 0; ai < 2; ++ai)
#pragma unroll
            for (int m = 0; m < 4; ++m) { const size_t row = row0 + ai * 128 + m * 16; float gg[8], ma[8]; unq8(gv[ai][m], gg); unpack8(mv[ai][m], ma);
                const f32x4 z1a = acc[ai][0][m][0], z1b = acc[ai][0][m][1], z2a = acc[ai][1][m][0], z2b = acc[ai][1][m][1]; v4u w;
                w.x = pk2(ma[0] + gg[0] * z1a.x * fast_sigmoid(z2a.x), ma[1] + gg[1] * z1a.y * fast_sigmoid(z2a.y)); w.y = pk2(ma[2] + gg[2] * z1a.z * fast_sigmoid(z2a.z), ma[3] + gg[3] * z1a.w * fast_sigmoid(z2a.w));
                w.z = pk2(ma[4] + gg[4] * z1b.x * fast_sigmoid(z2b.x), ma[5] + gg[5] * z1b.y * fast_sigmoid(z2b.y)); w.w = pk2(ma[6] + gg[6] * z1b.z * fast_sigmoid(z2b.z), ma[7] + gg[7] * z1b.w * fast_sigmoid(z2b.w));
                pst16(MG + row * DM + col, w); }
    }
};
struct EpiOut {
    static constexpr bool PERM = true, AFTER_DRAIN = false;
    const float* x; float* out; bf16_t* X1b; unsigned char* X1b8;
    __device__ __forceinline__ void operator()(const pg8::f32x4 (&acc)[2][2][4][2], const pg8::Unit& u, int wr, int wc, int fr, int fq) const {
        const int row0 = u.pm * 256 + wr * 64 + fr, col0 = u.pn * 256 + wc * 32 + 8 * fq;
        f32x4 xv[4][2][2], sv[4][2][2];
#pragma unroll
        for (int m = 0; m < 4; ++m)
#pragma unroll
            for (int bj = 0; bj < 2; ++bj) { const size_t o = (size_t)(row0 + m * 16) * DM + col0 + bj * 128; xv[m][bj][0] = __builtin_nontemporal_load((const f32x4*)(x + o)); xv[m][bj][1] = __builtin_nontemporal_load((const f32x4*)(x + o + 4)); }
#pragma unroll
        for (int m = 0; m < 4; ++m)
#pragma unroll
            for (int bj = 0; bj < 2; ++bj) { sv[m][bj][0] = acc[0][bj][m][0] + xv[m][bj][0]; sv[m][bj][1] = acc[0][bj][m][1] + xv[m][bj][1]; }
#pragma unroll
        for (int m = 0; m < 4; ++m)
#pragma unroll
            for (int bj = 0; bj < 2; ++bj) { const size_t o = (size_t)(row0 + 128 + m * 16) * DM + col0 + bj * 128; xv[m][bj][0] = __builtin_nontemporal_load((const f32x4*)(x + o)); xv[m][bj][1] = __builtin_nontemporal_load((const f32x4*)(x + o + 4)); }
#pragma unroll
        for (int ai = 0; ai < 2; ++ai) {
            if (ai == 1) {
#pragma unroll
                for (int m = 0; m < 4; ++m)
#pragma unroll
                    for (int bj = 0; bj < 2; ++bj) { sv[m][bj][0] = acc[1][bj][m][0] + xv[m][bj][0]; sv[m][bj][1] = acc[1][bj][m][1] + xv[m][bj][1]; } }
#pragma unroll
            for (int m = 0; m < 4; ++m)
#pragma unroll
                for (int bj = 0; bj < 2; ++bj) { const size_t o = (size_t)(row0 + ai * 128 + m * 16) * DM + col0 + bj * 128; const f32x4 a = sv[m][bj][0], b = sv[m][bj][1];
                    v4u w; w.x = pk2(a.x, a.y); w.y = pk2(a.z, a.w); w.z = pk2(b.x, b.y); w.w = pk2(b.z, b.w); pst16(X1b + o, w);
                    wt_v2u w8; w8.x = pk4_fp8(a.x, a.y, a.z, a.w); w8.y = pk4_fp8(b.x, b.y, b.z, b.w); pst8(X1b8 + o, w8); } }
    }
};

struct RotOrder {
    pg8::StaticOrder so; int n, rot;
    __device__ __forceinline__ bool next(int i, pg8::Unit& u) const { if (i >= n) return false; int j = i + rot; if (j >= n) j -= n; return so.next(j, u); }
    __device__ __forceinline__ void a_ready(const pg8::Unit&) const {}
    __device__ __forceinline__ void done(const pg8::Unit&) const {}
};

struct ChainOrder {
    pg8::StaticOrder so;
    __device__ __forceinline__ bool next(int i, pg8::Unit& u) const { pg8::Unit t; if (!so.next(i / 3, t)) return false; const int part = i % 3;
        if (part == 0) { u.pm = t.pm; u.pn = t.pn; } else { u.pm = t.pm + T / 256; u.pn = 4 + 2 * t.pn + (part - 1); } return true; }
    __device__ __forceinline__ void a_ready(const pg8::Unit&) const {}
    __device__ __forceinline__ void done(const pg8::Unit&) const {}
};
struct EpiOAGlu {
    static constexpr bool PERM = true, AFTER_DRAIN = false;
    EpiOA a; EpiGlu b;
    __device__ __forceinline__ void operator()(const pg8::f32x4 (&acc)[2][2][4][2], const pg8::Unit& u, int wr, int wc, int fr, int fq) const {
        if (u.pn < 4) a(acc, u, wr, wc, fr, fq);
        else { asm volatile("s_waitcnt vmcnt(0)" ::: "memory"); pg8::Unit v; v.pm = u.pm - T / 256; v.pn = u.pn - 4; b(acc, v, wr, wc, fr, fq); }
    }
};

__device__ __forceinline__ float gelu_tanh_f(float x) { const float u = 0.7978845608028654f * (x + 0.044715f * x * x * x); const float e = __builtin_amdgcn_exp2f(2.885390081777927f * u); return 0.5f * x * (2.f - 2.f * __builtin_amdgcn_rcpf(e + 1.f)); }
#define SSM_DMA(gsrc, ldsdst) __builtin_amdgcn_global_load_lds((const unsigned*)(gsrc), (LAS unsigned*)(ldsdst), 16, 0, 0)
__device__ __forceinline__ void ssm_phase(Frame& F) {
    for (int pair = F.vcu; pair < 256; pair += F.G) {
    int lane = F.lane; asm volatile("" : "+v"(lane));
    const int b = pair & 7, g = pair >> 3; const int w = F.wave, nt = w & 3, tp = w >> 2, n = lane & 15, kq = lane >> 4;
    LAS unsigned char* L = F.lds + RING_OFF;
    LAS float* ES = (LAS float*)(L + 65536);
    const bf16_t* up = (const bf16_t*)(F.ws + WS_U) + ((size_t)b * SEQ + (16 * nt + n) * 64 + (kq >> 1)) * 512 + g * 16 + 8 * (kq & 1);
    bf16x8 U[32];
#pragma unroll
    for (int jp = 0; jp < 32; ++jp) U[jp] = *(const GAS bf16x8*)(up + (size_t)(2 * jp) * 512);
    const GAS bf16x8* Hw = (const GAS bf16x8*)(F.ws + WS_SSMH) + ((size_t)(g * 8 + w) * 32) * 64 + lane;
#define SSM_HBATCH(kb, buf) do { _Pragma("unroll") for (int q_ = 0; q_ < 4; ++q_) SSM_DMA(Hw + (size_t)(4 * (kb) + q_) * 64, L + (buf) * 32768 + (4 * w + q_) * 1024); } while (0)
    SSM_HBATCH(0, 0); SSM_HBATCH(1, 1);
    f32x4 E[4];
#pragma unroll
    for (int mt = 0; mt < 4; ++mt) E[mt] = (f32x4){0.f, 0.f, 0.f, 0.f};
#pragma unroll
    for (int kb = 0; kb < 8; ++kb) {
        if (kb < 7) asm volatile("s_waitcnt vmcnt(4)\n\ts_barrier" ::: "memory"); else asm volatile("s_waitcnt vmcnt(0)\n\ts_barrier" ::: "memory");
        const LAS bf16x8* hb = (const LAS bf16x8*)(L + (kb & 1) * 32768) + (tp * 16) * 64 + lane;
#pragma unroll
        for (int k4 = 0; k4 < 4; ++k4)
#pragma unroll
            for (int mt = 0; mt < 4; ++mt) E[mt] = __builtin_amdgcn_mfma_f32_16x16x32_bf16(hb[(mt * 4 + k4) * 64], U[4 * kb + k4], E[mt], 0, 0, 0);
        if (kb < 6) { asm volatile("s_waitcnt lgkmcnt(0)\n\ts_barrier" ::: "memory"); SSM_HBATCH(kb + 2, kb & 1); }
    }
#pragma unroll
    for (int mt = 0; mt < 4; ++mt)
#pragma unroll
        for (int i = 0; i < 4; ++i) ES[(16 * (4 * tp + mt) + 4 * kq + i) * 65 + 16 * nt + n] = E[mt][i];
    asm volatile("s_waitcnt lgkmcnt(0)\n\ts_barrier" ::: "memory");
    { const GAS bf16x8* Fg = (const GAS bf16x8*)(F.ws + WS_SSMF + (size_t)g * 65536) + lane;
#pragma unroll
      for (int q = 0; q < 8; ++q) SSM_DMA(Fg + (size_t)(8 * w + q) * 64, L + (8 * w + q) * 1024); }
    if (w == 0) { const float* A64 = (const float*)(F.ws + WS_SSMA) + (g * 64 + lane) * 2; const float ar = A64[0], ai = A64[1]; float sr = 0.f, si = 0.f;
        for (int c = 0; c < 64; ++c) { const float er = ES[lane * 65 + c], ei = ES[(64 + lane) * 65 + c]; ES[lane * 65 + c] = sr; ES[(64 + lane) * 65 + c] = si;
            const float nr = ar * sr - ai * si + er, ni = ar * si + ai * sr + ei; sr = nr; si = ni; } }
    int ln3 = lane; asm volatile("" : "+v"(ln3));
    const int n3 = ln3 & 15, kq3 = ln3 >> 4;
    bf16x8 CF[4];
#pragma unroll
    for (int kk = 0; kk < 4; ++kk) CF[kk] = *((const GAS bf16x8*)(F.ws + WS_SSMG) + (size_t)(g * 4 + kk) * 64 + ln3);
    float zr[16], zi[16], a2r[16], a2i[16];
#pragma unroll
    for (int q = 0; q < 16; ++q) { const f32x4 ab = ((const GAS f32x4*)((const float*)(F.ws + WS_SSMA) + 16384))[g * 64 + 32 * (q >> 3) + 8 * kq3 + (q & 7)]; a2r[q] = ab.z; a2i[q] = ab.w; zr[q] = tp ? ab.z : ab.x; zi[q] = tp ? ab.w : ab.y; }
    asm volatile("s_waitcnt vmcnt(0) lgkmcnt(0)\n\ts_barrier" ::: "memory");
#pragma unroll
    for (int q = 0; q < 16; ++q) { const int p = 32 * (q >> 3) + 8 * kq3 + (q & 7); const float sr = ES[p * 65 + 16 * nt + n3], si = ES[(64 + p) * 65 + 16 * nt + n3];
        const float r0 = zr[q] * sr - zi[q] * si, i0 = zr[q] * si + zi[q] * sr; zr[q] = r0; zi[q] = i0; }
    const LAS bf16x8* Fl = (const LAS bf16x8*)L + tp * 64 + ln3;
    bf16_t* yp = (bf16_t*)(F.ws + WS_Y2) + ((size_t)b * SEQ + (16 * nt + n3) * 64 + tp) * 512 + g * 16 + 4 * kq3;
#pragma unroll
    for (int tt = 0; tt < 32; ++tt) {
        f32x4 acc = (f32x4){0.f, 0.f, 0.f, 0.f};
#pragma unroll
        for (int kk = 0; kk < 4; ++kk) { const float* z = (kk < 2) ? zr : zi; const int o8 = 8 * (kk & 1); v4u zw; zw.x = pk2(z[o8], z[o8 + 1]); zw.y = pk2(z[o8 + 2], z[o8 + 3]); zw.z = pk2(z[o8 + 4], z[o8 + 5]); zw.w = pk2(z[o8 + 6], z[o8 + 7]);
            acc = __builtin_amdgcn_mfma_f32_16x16x32_bf16(CF[kk], __builtin_bit_cast(bf16x8, zw), acc, 0, 0, 0); }
#pragma unroll
        for (int jp = 0; jp <= tt; ++jp) acc = __builtin_amdgcn_mfma_f32_16x16x32_bf16(Fl[128 * (tt - jp)], U[jp], acc, 0, 0, 0);
        typedef unsigned u32x2v __attribute__((ext_vector_type(2))); u32x2v o; o.x = pk2(gelu_tanh_f(acc.x), gelu_tanh_f(acc.y)); o.y = pk2(gelu_tanh_f(acc.z), gelu_tanh_f(acc.w));
        st8(yp + (size_t)(2 * tt) * 512, o);
        if (tt < 31) {
#pragma unroll
            for (int q = 0; q < 16; ++q) { const float r0 = zr[q] * a2r[q] - zi[q] * a2i[q], i0 = zr[q] * a2i[q] + zi[q] * a2r[q]; zr[q] = r0; zi[q] = i0; } }
        asm volatile("" ::: "memory"); }
    asm volatile("s_waitcnt lgkmcnt(0)\n\ts_barrier" ::: "memory");
    }
}
#undef SSM_HBATCH

__device__ __forceinline__ void attn_post(Frame& F, int b, int h, int qb, const bf16_t* Ob, bf16_t* OAb, float lam) {
    int ln = lane_id(); asm volatile("s_waitcnt vmcnt(0)" : "+v"(ln) :: "memory");
    const int row = b * SEQ + qb * 256 + F.wave * 32 + (ln >> 1), half = ln & 1;
    const bf16_t* p0 = Ob + (size_t)row * 1024 + h * 128 + half * 64; const bf16_t* p1 = p0 + 512;
    float o[64]; float ss = 0.f;
#pragma unroll
    for (int j = 0; j < 8; ++j) { const v4u a = *(const GAS v4u*)(p0 + 8 * j), c = *(const GAS v4u*)(p1 + 8 * j);
        const unsigned aw[4] = {a.x, a.y, a.z, a.w}, cw[4] = {c.x, c.y, c.z, c.w};
#pragma unroll
        for (int k = 0; k < 4; ++k) { const float x0 = __uint_as_float(aw[k] << 16) - lam * __uint_as_float(cw[k] << 16), x1 = __uint_as_float(aw[k] & 0xffff0000u) - lam * __uint_as_float(cw[k] & 0xffff0000u);
            o[8 * j + 2 * k] = x0; o[8 * j + 2 * k + 1] = x1; ss += x0 * x0 + x1 * x1; } }
    ss += __shfl_xor(ss, 1);
    const float r = rsqrtf(ss * (1.f / 128.f) + EPS) * (1.f - LAM_INIT);
    const float* sg = F.in[10] + half * 64; bf16_t* q = OAb + (size_t)row * 512 + h * 128 + half * 64;
#pragma unroll
    for (int j = 0; j < 8; ++j) { const f32x4 g0 = *(const f32x4*)(sg + 8 * j), g1 = *(const f32x4*)(sg + 8 * j + 4); v4u w;
        w.x = pk2(o[8 * j] * r * g0.x, o[8 * j + 1] * r * g0.y); w.y = pk2(o[8 * j + 2] * r * g0.z, o[8 * j + 3] * r * g0.w);
        w.z = pk2(o[8 * j + 4] * r * g1.x, o[8 * j + 5] * r * g1.y); w.w = pk2(o[8 * j + 6] * r * g1.z, o[8 * j + 7] * r * g1.w);
        st16(q + 8 * j, w); }
}
__device__ __forceinline__ void attn_phase(Frame& F, char* lds) {
    using abf = attn_body::bf16;
    const abf* Qb = (const abf*)(F.ws + WS_Q); const abf* Kb = (const abf*)(F.ws + WS_K); const abf* Vb = (const abf*)(F.ws + WS_V); abf* Ob = (abf*)(F.ws + WS_OB);
    const float lam = ((const float*)(F.ws + WS_SCAL))[0];
    for (int v = F.vcu; v < 256; v += F.G) {
    const int bh = v >> 3, s = v & 7, b = bh >> 2, h = bh & 3;
#pragma clang loop unroll(disable)
    for (int it = 0; it < 4; ++it) { const int qb = it < 2 ? s : 15 - s, c = it & 1;
        attn_body::attn_unit128<8>((long)b * SEQ, qb, Qb + (2 * h + c) * 64, Kb + (2 * h + c) * 64, Vb + h * 128, Ob + c * 512 + h * 128, lds, F.wave * 64 + lane_id());
        if (it & 1) attn_post(F, b, h, qb, (const bf16_t*)Ob, (bf16_t*)(F.ws + WS_OA), lam);
    }
    }
}

constexpr int LDS_TAB = LDSCTL_OFF + 1024;
__device__ __forceinline__ void router_phase(Frame& F) {
    LAS unsigned char* L = F.lds + RING_OFF; LAS unsigned* tab = (LAS unsigned*)(F.lds + LDS_TAB);
    { const GAS v4u* src = (const GAS v4u*)(F.ws + WS_WR);
#pragma unroll
      for (int i = 0; i < 12; ++i) ((LAS v4u*)L)[F.tid + 512 * i] = src[F.tid + 512 * i]; }
    const int lane = F.lane, m = lane & 15, kq = lane >> 4;
    LAS float* scr = (LAS float*)(L + 98304 + F.wave * 4096);
    const bf16_t* X1b = (const bf16_t*)(F.ws + WS_X1B); int* ltok = (int*)(F.ws + WS_LTOK); float* lw = (float*)(F.ws + WS_LW); float* lrs = (float*)(F.ws + WS_LR);
    for (int tile = F.vcu * NWAVES + F.wave; tile < T / 16; tile += F.G * NWAVES) {
        if (F.tid < 64) tab[192 + F.tid] = 0u; else if (F.tid < 176) tab[320 + F.tid - 64] = 0u;
        __syncthreads();
        const int row0 = tile * 16; const bf16_t* ap = X1b + (size_t)(row0 + m) * DM + 8 * kq;
        bf16x8 A[32];
#pragma unroll
        for (int ks = 0; ks < 32; ++ks) A[ks] = *(const GAS bf16x8*)(ap + 32 * ks);
        f32x4 acc[3]; float ss = 0.f;
#pragma unroll
        for (int q = 0; q < 3; ++q) acc[q] = (f32x4){0.f, 0.f, 0.f, 0.f};
#pragma unroll
        for (int ks = 0; ks < 32; ++ks) {
#pragma unroll
            for (int j = 0; j < 8; ++j) { const float v = bf2f((bf16_t)A[ks][j]); ss += v * v; }
#pragma unroll
            for (int q = 0; q < 3; ++q) acc[q] = __builtin_amdgcn_mfma_f32_16x16x32_bf16(A[ks], *(const LAS bf16x8*)(L + ((ks * 3 + q) * 64 + lane) * 16), acc[q], 0, 0, 0); }
        ss += __shfl_xor(ss, 16); ss += __shfl_xor(ss, 32);
        const float r = rsqrtf(ss * (1.f / DM) + EPS);
#pragma unroll
        for (int q = 0; q < 3; ++q)
#pragma unroll
            for (int i = 0; i < 4; ++i) scr[(4 * kq + i) * 49 + 16 * q + m] = acc[q][i];
        LDS_WAIT(); asm volatile("" ::: "memory");
        int l1 = 0, l2 = 0, rk1 = 0, rk2 = 0, pid = 0, rk3 = 0; float w1 = 0.f, w2 = 0.f;
        if (lane < 16) { const LAS float* lr = scr + lane * 49; const float* brg = F.in[24]; const float* bre = F.in[26];
            int grp = 0; float mx = lr[0] * r + brg[0]; float lg[4]; lg[0] = mx;
#pragma unroll
            for (int c = 1; c < 4; ++c) { lg[c] = lr[c] * r + brg[c]; if (lg[c] > mx) { mx = lg[c]; grp = c; } }
            float den = 0.f;
#pragma unroll
            for (int c = 0; c < 4; ++c) den += __expf(lg[c] - mx);
            const float pg = 1.f / den;
            const LAS float* le = lr + 4 + grp * 8; const float* be = bre + grp * 8;
            float v1 = -INFINITY, v2 = -INFINITY; int i1 = 0, i2 = 0;
#pragma unroll
            for (int e = 0; e < 8; ++e) { const float v = le[e] * r + be[e]; if (v > v1) { v2 = v1; i2 = i1; v1 = v; i1 = e; } else if (v > v2) { v2 = v; i2 = e; } }
            const float e2 = __expf(v2 - v1); w1 = pg / (1.f + e2); w2 = pg * e2 / (1.f + e2);
            l1 = grp * 8 + i1; l2 = 32 + grp * 8 + i2;
            rk1 = (int)__hip_atomic_fetch_add(tab + 192 + l1, 1u, __ATOMIC_RELAXED, __HIP_MEMORY_SCOPE_WORKGROUP); rk2 = (int)__hip_atomic_fetch_add(tab + 192 + l2, 1u, __ATOMIC_RELAXED, __HIP_MEMORY_SCOPE_WORKGROUP);
            { const int lo = i1 < i2 ? i1 : i2, hi = i1 < i2 ? i2 : i1; pid = grp * 28 + lo * 8 - (lo * (lo + 1)) / 2 + hi - lo - 1; }
            rk3 = (int)__hip_atomic_fetch_add(tab + 320 + pid, 1u, __ATOMIC_RELAXED, __HIP_MEMORY_SCOPE_WORKGROUP); }
        __syncthreads();
        if (F.tid < 64) { const unsigned c = tab[192 + F.tid]; tab[256 + F.tid] = c ? __hip_atomic_fetch_add(F.ctl + CW_CNT + 64 * F.tid, c, RLX_AGENT) : 0u; }
        else if (F.tid < 176) { const int q = F.tid - 64; const unsigned c = tab[320 + q]; tab[432 + q] = c ? __hip_atomic_fetch_add(F.ctl + CW_CNT2 + 64 * q, c, RLX_AGENT) : 0u; }
        __syncthreads();
        if (lane < 16) { const int row = row0 + lane; const size_t p1 = (size_t)l1 * T + tab[256 + l1] + rk1, p2 = (size_t)l2 * T + tab[256 + l2] + rk2;
            ltok[p1] = row; lw[p1] = w1; lrs[p1] = r; ltok[p2] = row; lw[p2] = w2; lrs[p2] = r;
            ((int*)(F.ws + WS_PTOK))[(size_t)pid * T + tab[432 + pid] + rk3] = row;
            ((int4*)(F.ws + WS_RINFO))[row] = make_int4(l1, (int)(tab[256 + l1] + rk1), l2, (int)(tab[256 + l2] + rk2)); }
        __syncthreads();
    }
}
struct MoeUnit { int mt, l, tl, pn, cnt, ord; };
template <bool GATHER_> struct MoeSched {
    using U = MoeUnit; static constexpr bool GATHER = GATHER_;
    const LAS unsigned* tab; const LAS unsigned* tokbuf; int G, c, npn, l_lo, l_hi, rowbytes; const int* ltok; const char* Bbase; size_t bexp, bpn; int u_lo, u_hi;
    __device__ __forceinline__ int rd(int i) const { return __builtin_amdgcn_readfirstlane((int)tab[i]); }
    __device__ __forceinline__ bool next(int i, U& u) const {
        const int mt_lo = rd(64 + l_lo), mt_hi = rd(64 + l_hi); long Lidx;
        if ((G & 15) == 0) { const int mr = (c >> 4) * 8 + (c & 7), pn_ = (c >> 3) & 1; Lidx = (long)u_lo + (long)i * G + 2 * mr + pn_; } else Lidx = (long)u_lo + (long)i * G + c;
        if (Lidx >= (long)(mt_hi - mt_lo) * npn || Lidx >= (long)u_hi) return false;
        const int mt = mt_lo + (int)(Lidx / npn); u.pn = (int)(Lidx % npn); u.mt = mt; const int l = rd(320 + mt);
        u.l = l; u.tl = mt - rd(64 + l); u.cnt = rd(l); u.ord = i; return true; }
    __device__ __forceinline__ unsigned a_off(const U& u, int r) const { return tokbuf[(u.ord & 7) * 256 + r] * (unsigned)rowbytes; }
    __device__ __forceinline__ size_t a_base(const U& u) const { return (size_t)u.mt * 256 * (size_t)rowbytes; }
    __device__ __forceinline__ const char* b_ptr(const U& u) const { return Bbase + (size_t)(u.l & 31) * bexp + (size_t)u.pn * bpn; }
};
__device__ __forceinline__ void moe_tables(Frame& F) {
    LAS unsigned* tab = (LAS unsigned*)(F.lds + LDS_TAB);
    if (F.tid < 64) { const unsigned c = __hip_atomic_load(F.ctl + CW_CNT + 64 * F.tid, RLX_AGENT), t = (c + 255u) >> 8; unsigned inc = t;
#pragma unroll
        for (int o = 1; o < 64; o <<= 1) { const unsigned v = __shfl_up(inc, o); if ((F.tid & 63) >= o) inc += v; }
        tab[F.tid] = c; tab[64 + F.tid] = inc - t; if (F.tid == 63) tab[128] = inc;
        for (unsigned mt = inc - t; mt < inc && mt < 336u; ++mt) tab[320 + mt] = (unsigned)F.tid; }
    __syncthreads();
}
constexpr int LDS_TOK = LDSCTL_OFF + 4096;
template <class S_> __device__ __forceinline__ void moe_stage_tokens(Frame& F, const S_& S) {
    LAS unsigned* tb = (LAS unsigned*)(F.lds + LDS_TOK);
#pragma unroll
    for (int base = 0; base < 8; base += 4) { const int i = base + (F.tid >> 7), r0 = F.tid & 127; MoeUnit u;
        if (S.next(i, u)) { const int p0 = u.tl * 256 + r0, p1 = p0 + 128; const int* lt = S.ltok + (size_t)u.l * T;
            const unsigned a = p0 < u.cnt ? (unsigned)lt[p0] : 0u, b = p1 < u.cnt ? (unsigned)lt[p1] : 0u; tb[i * 256 + r0] = a; tb[i * 256 + r0 + 128] = b; } }
    __syncthreads();
}
struct EpiMoe1 {
    static constexpr bool PERM = true, AFTER_DRAIN = false;
    const float* lw; const float* lrs; unsigned char* Hb; float wsc;
    __device__ __forceinline__ void operator()(const pg8::f32x4 (&acc)[2][2][4][2], const MoeUnit& u, int wr, int wc, int fr, int fq) const {
        int lane_ = fr + 16 * fq; asm volatile("" : "+v"(lane_)); fr = lane_ & 15; fq = lane_ >> 4;
        const int col = u.pn * 128 + wc * 32 + 8 * fq;
        float wv[2][4], rv[2][4];
#pragma unroll
        for (int ai = 0; ai < 2; ++ai)
#pragma unroll
            for (int m = 0; m < 4; ++m) { const size_t p = (size_t)u.l * T + u.tl * 256 + ai * 128 + wr * 64 + m * 16 + fr; wv[ai][m] = lw[p]; rv[ai][m] = lrs[p] * wsc; }
#pragma unroll
        for (int ai = 0; ai < 2; ++ai)
#pragma unroll
            for (int m = 0; m < 4; ++m) { const int r = ai * 128 + wr * 64 + m * 16 + fr; const float w = wv[ai][m], rs = rv[ai][m];
                const f32x4 ga = acc[ai][0][m][0] * rs, gb = acc[ai][0][m][1] * rs, ua = acc[ai][1][m][0] * (rs * w * H_SCALE), ub = acc[ai][1][m][1] * (rs * w * H_SCALE); wt_v2u o;
                o.x = pk4_fp8(ga.x * fast_sigmoid(ga.x) * ua.x, ga.y * fast_sigmoid(ga.y) * ua.y, ga.z * fast_sigmoid(ga.z) * ua.z, ga.w * fast_sigmoid(ga.w) * ua.w);
                o.y = pk4_fp8(gb.x * fast_sigmoid(gb.x) * ub.x, gb.y * fast_sigmoid(gb.y) * ub.y, gb.z * fast_sigmoid(gb.z) * ub.z, gb.w * fast_sigmoid(gb.w) * ub.w);
                pst8(Hb + ((size_t)u.mt * 256 + r) * 256 + col, o); }
    }
};
constexpr int P2_CNT = 130, P2_PREFIX = 242, P2_MAP = 356, P2_PAIR = 724;
__device__ __forceinline__ void moe_tables2(Frame& F) {
    LAS unsigned* tab = (LAS unsigned*)(F.lds + LDS_TAB);
    if (F.tid < 64) { const int ln = F.tid;
        const unsigned c0 = __hip_atomic_load(F.ctl + CW_CNT2 + 64 * ln, RLX_AGENT), c1 = ln < 48 ? __hip_atomic_load(F.ctl + CW_CNT2 + 64 * (64 + ln), RLX_AGENT) : 0u;
        const unsigned t0 = (c0 + 255u) >> 8, t1 = (c1 + 255u) >> 8; unsigned i0 = t0, i1 = t1;
#pragma unroll
        for (int o = 1; o < 64; o <<= 1) { const unsigned v0 = __shfl_up(i0, o), v1 = __shfl_up(i1, o); if (ln >= o) { i0 += v0; i1 += v1; } }
        const unsigned tot0 = __shfl(i0, 63), lo0 = i0 - t0, lo1 = tot0 + i1 - t1;
        tab[P2_CNT + ln] = c0; tab[P2_PREFIX + ln] = lo0;
        for (unsigned mt = lo0; mt < lo0 + t0 && mt < 368u; ++mt) tab[P2_MAP + mt] = (unsigned)ln;
        if (ln < 48) { tab[P2_CNT + 64 + ln] = c1; tab[P2_PREFIX + 64 + ln] = lo1; for (unsigned mt = lo1; mt < lo1 + t1 && mt < 368u; ++mt) tab[P2_MAP + mt] = (unsigned)(64 + ln); }
        if (ln == 47) tab[P2_PREFIX + 112] = lo1 + t1; }
    else if (F.tid >= 128 && F.tid < 156) { const int k = F.tid - 128; int lo = 0, off = 0; while (k >= off + 7 - lo) { off += 7 - lo; ++lo; } tab[P2_PAIR + k] = (unsigned)(lo | ((lo + 1 + k - off) << 8)); }
    __syncthreads();
}
struct PairUnit { int mt, pid, tl, pn, cnt, ord; };
struct PairSched {
    using U = PairUnit;
    const LAS unsigned* tab; const LAS unsigned* tokbuf; int G, c; const char* Wd;
    __device__ __forceinline__ int rd(int i) const { return __builtin_amdgcn_readfirstlane((int)tab[i]); }
    __device__ __forceinline__ bool next(int i, U& u) const {
        int mt, pn;
        if ((G & 31) == 0) { const int slot = c >> 3, per = G >> 2; int w = (slot >> 2) * 8 + (c & 7) + (i & 1); w = w >= per ? w - per : w; mt = i * per + w; pn = slot & 3; }
        else { const long idx = (long)i * G + c; mt = (int)(idx >> 2); pn = (int)(idx & 3); }
        if (i >= 4 || mt >= rd(P2_PREFIX + 112)) return false;
        u.mt = mt; u.pn = pn; const int pid = rd(P2_MAP + mt); u.pid = pid; u.tl = mt - rd(P2_PREFIX + pid); u.cnt = rd(P2_CNT + pid); u.ord = i; return true; }
    __device__ __forceinline__ unsigned a_off(const U& u, int set, int r) const { return tokbuf[((u.ord & 3) * 2 + set) * 256 + r]; }
    __device__ __forceinline__ const char* b_ptr(const U& u, int set) const { const int g = u.pid / 28, pe = rd(P2_PAIR + u.pid - g * 28), e = g * 8 + (set ? (pe >> 8) : (pe & 255));
        return Wd + (size_t)e * ((size_t)DM * 256) + (size_t)u.pn * ((size_t)256 * 256); }
};
__device__ __forceinline__ void moe_stage_pairs(Frame& F, const PairSched& S) {
    LAS unsigned* tb = (LAS unsigned*)(F.lds + LDS_TOK); const LAS unsigned* tab = (const LAS unsigned*)(F.lds + LDS_TAB);
    const int* ptok = (const int*)(F.ws + WS_PTOK); const int4* rinfo = (const int4*)(F.ws + WS_RINFO);
    const int i = F.tid >> 7, r0 = F.tid & 127; PairUnit u;
    if (S.next(i, u)) { int tk[2]; int4 ri[2];
#pragma unroll
        for (int h = 0; h < 2; ++h) { const int p = u.tl * 256 + r0 + 128 * h; tk[h] = p < u.cnt ? ptok[(size_t)u.pid * T + p] : -1; }
#pragma unroll
        for (int h = 0; h < 2; ++h) ri[h] = rinfo[tk[h] < 0 ? 0 : tk[h]];
#pragma unroll
        for (int h = 0; h < 2; ++h) { const unsigned r1 = (tab[64 + ri[h].x] * 256u + (unsigned)ri[h].y) * 256u, r2 = (tab[64 + ri[h].z] * 256u + (unsigned)ri[h].w) * 256u;     const bool f = (ri[h].x & 31) < (ri[h].z & 31), ok = tk[h] >= 0;
            const int r = r0 + 128 * h; tb[(i * 2 + 0) * 256 + r] = ok ? (f ? r1 : r2) : 0u; tb[(i * 2 + 1) * 256 + r] = ok ? (f ? r2 : r1) : 0u; tb[2048 + i * 256 + r] = (unsigned)tk[h]; } }
    __syncthreads();
}
struct EpiPair {
    static constexpr bool PERM = true, AFTER_DRAIN = false;
    const LAS int* toks; const bf16_t* X1b; float* out; float sc;
    __device__ __forceinline__ void operator()(const pg8::f32x4 (&acc)[2][2][4][2], const PairUnit& u, int wr, int wc, int fr, int fq) const {
        const int lane_ = lane_id(); fr = lane_ & 15; fq = lane_ >> 4;
        const int col0 = u.pn * 256 + wc * 32 + 8 * fq;
        int tok[2][4];
#pragma unroll
        for (int ai = 0; ai < 2; ++ai)
#pragma unroll
            for (int m = 0; m < 4; ++m) tok[ai][m] = toks[(u.ord & 3) * 256 + ai * 128 + wr * 64 + m * 16 + fr];
        v4u xv[2][4][2];
#pragma unroll
        for (int ai = 0; ai < 2; ++ai)
#pragma unroll
            for (int m = 0; m < 4; ++m)
#pragma unroll
                for (int bj = 0; bj < 2; ++bj) xv[ai][m][bj] = *(const v4u*)(X1b + (size_t)(tok[ai][m] < 0 ? 0 : tok[ai][m]) * DM + col0 + bj * 128);
#pragma unroll
        for (int ai = 0; ai < 2; ++ai) {
#pragma unroll
            for (int m = 0; m < 4; ++m) if (tok[ai][m] >= 0) {
#pragma unroll
                for (int bj = 0; bj < 2; ++bj) { const v4u x = xv[ai][m][bj]; f32x4 a = acc[ai][bj][m][0] * sc, b = acc[ai][bj][m][1] * sc;
                    a.x += __uint_as_float(x.x << 16); a.y += __uint_as_float(x.x & 0xffff0000u); a.z += __uint_as_float(x.y << 16); a.w += __uint_as_float(x.y & 0xffff0000u);
                    b.x += __uint_as_float(x.z << 16); b.y += __uint_as_float(x.z & 0xffff0000u); b.z += __uint_as_float(x.w << 16); b.w += __uint_as_float(x.w & 0xffff0000u);
                    float* o = out + (size_t)tok[ai][m] * DM + col0 + bj * 128; pst16(o, __builtin_bit_cast(v4u, a)); pst16(o + 4, __builtin_bit_cast(v4u, b)); } } }
    }
};
struct Args { const float* in[30]; float* out; unsigned char* ws; int ph_lo, ph_hi, li, use_bar; };
constexpr int N_PHASES = 12;
template <int LO, int HI> __global__ void __launch_bounds__(NWAVES * 64, 2) skel_fwd(Args args) {
    extern __shared__ __attribute__((aligned(16))) unsigned char lds[];
    Frame F;
    F.lds = (LAS unsigned char*)lds;
    F.MISC = (volatile LAS unsigned*)(F.lds + MISC_OFF);
    const int wave0 = __builtin_amdgcn_readfirstlane((int)threadIdx.x >> 6);
#define MKTID (wave0 * 64 + lane_id())
    F.tid = MKTID; F.lane = F.tid & 63; F.wave = wave0;
    F.G = gridDim.x; { const int bx = blockIdx.x; F.vcu = (F.G % 8 == 0) ? (bx % 8) * (F.G / 8) + bx / 8 : bx; }
    F.ws = args.ws; F.ctl = (gu32*)(args.ws + WS_CTL); F.out = args.out;
#pragma unroll
    for (int i = 0; i < 30; ++i) F.in[i] = args.in[i];
    for (int u = F.tid; u < (LDS_BYTES - LDSCTL_OFF) / 4; u += NWAVES * 64) ((LAS unsigned*)(F.lds + LDSCTL_OFF))[u] = 0u;
    __syncthreads();
    XcdBarrier bar; bar.bar = (unsigned*)(F.ctl + CW_BAR); bar.x = 0; bar.st = nullptr;
    if (args.use_bar) bar = xcd_barrier_post((unsigned*)(F.ctl + CW_BAR), F.MISC + 8, MKTID);
#define GRID_BAR() do { if (args.use_bar) xcd_barrier(bar, MKTID); } while (0)
    constexpr int lo = LO, hi = HI;
#define IN(k) (lo <= (k) && (k) < hi)
#define REFRESH() do { int t_ = MKTID; asm volatile("" : "+v"(t_)); F.tid = t_; F.lane = t_ & 63; F.wave = wave0; } while (0)
#define BOTH(k) (IN(k) && IN((k) + 1))

    if (IN(0)) { REFRESH(); p0_prologue(F); if (BOTH(0)) GRID_BAR(); }

    if (IN(1)) {
        const float* sa = (const float*)(F.ws + WS_SA); const float* sw = (const float*)(F.ws + WS_SW);
        if constexpr (I8_FROM_PN > 0) { const int nw = (T / 256) * I8_FROM_PN; pg8::Gemm g{(const bf16_t*)(F.ws + WS_XN), (const bf16_t*)(F.ws + WS_WIN), T, 256 * I8_FROM_PN, DM}; RotOrder S; S.so.init(T, 256 * I8_FROM_PN, F.G, (int)blockIdx.x);
          S.n = (nw % F.G == 0) ? nw / F.G : 0; S.rot = S.n ? (int)((blockIdx.x >> 3) % (unsigned)S.n) : 0; if (S.n == 0) S.n = 1 << 30;
          EpiInT<0, I8_FROM_PN, false> E{(bf16_t*)(F.ws + WS_Q), (bf16_t*)(F.ws + WS_K), (bf16_t*)(F.ws + WS_V), (bf16_t*)(F.ws + WS_U), (bf16_t*)(F.ws + WS_G), (const float*)(F.ws + WS_ROPE), F.in[4], F.in[5], sa, sw};
          pg8::gemm_phase<EpiInT<0, I8_FROM_PN, false>, RotOrder, PG8_ALIGN, PG8_SP2>(F.lds + RING_OFF, g, S, E, MKTID); }
        { const int nw = (T / 256) * (16 - I8_FROM_PN); pg8::Gemm g{(const bf16_t*)(F.ws + WS_XN8), (const bf16_t*)(F.ws + WS_WG8), T, 256 * (16 - I8_FROM_PN), DM / 2}; RotOrder S; S.so.init(T, 256 * (16 - I8_FROM_PN), F.G, (int)blockIdx.x);
          S.n = (nw % F.G == 0) ? nw / F.G : 0; S.rot = S.n ? (int)((blockIdx.x >> 3) % (unsigned)S.n) : 0; if (S.n == 0) S.n = 1 << 30;
          EpiInT<I8_FROM_PN, 16, true> E{(bf16_t*)(F.ws + WS_Q), (bf16_t*)(F.ws + WS_K), (bf16_t*)(F.ws + WS_V), (bf16_t*)(F.ws + WS_U), (bf16_t*)(F.ws + WS_G), (const float*)(F.ws + WS_ROPE), F.in[4], F.in[5], sa, sw};
          pg8::gemm_phase<EpiInT<I8_FROM_PN, 16, true>, RotOrder, PG8_ALIGN, PG8_SP2, false, true>(F.lds + RING_OFF, g, S, E, MKTID); }
        if (BOTH(1)) GRID_BAR();
    }
    if (IN(2)) { REFRESH(); ssm_phase(F); }
    if (IN(3)) { REFRESH(); attn_phase(F, (char*)lds + RING_OFF); if (BOTH(3)) GRID_BAR(); }
    if (IN(4)) {
        pg8::Gemm g{(const bf16_t*)(F.ws + WS_OA), (const bf16_t*)(F.ws + WS_WO), 2 * T, 3072, 512}; ChainOrder S; S.so.init(T, DM, F.G, (int)blockIdx.x);
        EpiOAGlu E{EpiOA{(const bf16_t*)(F.ws + WS_G), (bf16_t*)(F.ws + WS_MA)}, EpiGlu{(const bf16_t*)(F.ws + WS_G), (const bf16_t*)(F.ws + WS_MA), (bf16_t*)(F.ws + WS_MG)}};
        pg8::gemm_phase<EpiOAGlu, ChainOrder, PG8_ALIGN, PG8_SP2>(F.lds + RING_OFF, g, S, E, MKTID);
        if (IN(6)) GRID_BAR();
    }
    if (IN(6)) {
        pg8::Gemm g{(const bf16_t*)(F.ws + WS_MG), (const bf16_t*)(F.ws + WS_WOUT), T, DM, DM}; pg8::StaticOrder S; S.init(T, DM, F.G, (int)blockIdx.x);
        EpiOut E{F.in[0], F.out, (bf16_t*)(F.ws + WS_X1B), F.ws + WS_X1B8};
        REFRESH(); const int late = F.vcu & 1, gwp = (F.vcu >> 1) * NWAVES + F.wave, ngwp = (F.G >> 1) * NWAVES;
        if ((F.G & 1) == 0 && late) { expert_weights_items(F, 2 * gwp + 1, 2 * ngwp); }
        pg8::gemm_phase<EpiOut, pg8::StaticOrder, PG8_ALIGN, PG8_SP2>(F.lds + RING_OFF, g, S, E, MKTID);
        REFRESH();
        if ((F.G & 1) != 0) expert_weights_items(F, F.vcu * NWAVES + F.wave, F.G * NWAVES); else if (!late) expert_weights_items(F, 2 * gwp, 2 * ngwp);
        if (BOTH(6)) GRID_BAR();
    }
    if (IN(7)) { REFRESH(); router_phase(F); if (BOTH(7)) GRID_BAR(); }
    if (IN(8)) { REFRESH(); moe_tables(F);
        MoeSched<true> S{(const LAS unsigned*)(F.lds + LDS_TAB), (const LAS unsigned*)(F.lds + LDS_TOK), F.G, (int)blockIdx.x, 2, 0, 64, DM, (const int*)(F.ws + WS_LTOK), (const char*)(F.ws + WS_WGU), (size_t)512 * DM, (size_t)256 * DM, 0, 1 << 30};
        moe_stage_tokens(F, S);
        EpiMoe1 E{(const float*)(F.ws + WS_LW), (const float*)(F.ws + WS_LR), F.ws + WS_HB, 1.f / GATE_WSCALE};
        pg8::gemm_phase_x<EpiMoe1, MoeSched<true>, true, true>(F.lds + RING_OFF, (const char*)(F.ws + WS_X1B8), DM / 2, S, E, MKTID);
        if (BOTH(8)) GRID_BAR(); }
    if (IN(9)) { REFRESH(); moe_tables(F); moe_tables2(F);
        PairSched S{(const LAS unsigned*)(F.lds + LDS_TAB), (const LAS unsigned*)(F.lds + LDS_TOK), F.G, (int)blockIdx.x, (const char*)(F.ws + WS_WD)};
        moe_stage_pairs(F, S);
        EpiPair E{(const LAS int*)(F.lds + LDS_TOK + 8192), (const bf16_t*)(F.ws + WS_X1B), F.out, 1.f / (H_SCALE * WD_SCALE)};
        pg8::gemm_phase_pair<EpiPair, PairSched, true, true>(F.lds + RING_OFF, (const char*)(F.ws + WS_HB), S, E, MKTID); }
#undef IN
#undef BOTH
}
#ifndef MK_PER_PHASE
#define MK_PER_PHASE 0
#endif
template <int LO, int HI> static bool launch_phases(const Args& a, int grid, hipStream_t stream) {
    static bool attr = false;
    if (!attr) { if (hipFuncSetAttribute((const void*)skel_fwd<LO, HI>, hipFuncAttributeMaxDynamicSharedMemorySize, LDS_BYTES) != hipSuccess) { fprintf(stderr, "kernel_launch: hipFuncSetAttribute failed (%d bytes of dynamic LDS)\n", LDS_BYTES); return false; } attr = true; }
    hipLaunchKernelGGL((skel_fwd<LO, HI>), dim3(grid), dim3(NWAVES * 64), LDS_BYTES, stream, a);
    const hipError_t le = hipPeekAtLastError();
    if (le != hipSuccess) { fprintf(stderr, "kernel_launch: launch of phases [%d,%d) failed: %s\n", LO, HI, hipGetErrorName(le)); return false; }
    return true;
}
extern "C" void kernel_launch(void* const* d_in, const int* in_sizes, int n_in, void* d_out, int out_size, void* d_ws, size_t ws_size, hipStream_t stream) {
    static int grid = 0;
    if (grid == 0) {
        if (n_in != 30 || in_sizes[0] != T * DM || out_size != T * DM || ws_size < WS_END) { fprintf(stderr, "kernel_launch: unexpected shapes: n_in %d, out %d, ws %zu; nothing launched\n", n_in, out_size, ws_size); grid = -1; return; }
        int dev = 0, cus = 0;
        if (hipGetDevice(&dev) != hipSuccess || hipDeviceGetAttribute(&cus, hipDeviceAttributeMultiprocessorCount, dev) != hipSuccess || cus < 8) { fprintf(stderr, "kernel_launch: device query failed; nothing launched\n"); grid = -1; return; }
        grid = cus > 256 ? 256 : cus;
    }
    if (grid < 0) return;
    if (hipMemsetAsync((char*)d_ws + WS_CTL, 0, CTL_ZERO_BYTES, stream) != hipSuccess) { fprintf(stderr, "kernel_launch: hipMemsetAsync failed\n"); return; }
    Args a{};
    for (int i = 0; i < 30; ++i) a.in[i] = (const float*)d_in[i];
    a.out = (float*)d_out; a.ws = (unsigned char*)d_ws;
#if MK_PER_PHASE
    a.use_bar = 0;
    launch_phases<0, 1>(a, grid, stream) && launch_phases<1, 2>(a, grid, stream) && launch_phases<2, 4>(a, grid, stream) && launch_phases<4, 5>(a, grid, stream) && launch_phases<5, 6>(a, grid, stream) &&
        launch_phases<6, 7>(a, grid, stream) && launch_phases<7, 8>(a, grid, stream) && launch_phases<8, 9>(a, grid, stream) && launch_phases<9, 10>(a, grid, stream) && launch_phases<10, 11>(a, grid, stream);
#else
    a.use_bar = 1; a.ph_lo = 0; a.ph_hi = 11;
    launch_phases<0, 11>(a, grid, stream);
#endif
}
```
